# Optimizing an MI355X kernel written in HIP

```python
import jax, jax.numpy as jnp
from jax import lax
import numpy as np

D_MODEL = 1024
BATCH = 16
SEQ = 2048
DEPTH = 1

GRID_W = 64
CTX_LEN = 256

HGRN_HEADS = 4
HGRN_DK = 128
HGRN_DV = 128
HGRN_W = HGRN_HEADS * HGRN_DK
GLA_HEADS = 4
GLA_DK = 64
GLA_DV = 128
GLA_WK = GLA_HEADS * GLA_DK
GLA_WV = GLA_HEADS * GLA_DV
GLA_GATE_RANK = 16
GLA_GATE_NORMALIZER = 16.0

CHUNK = 64

IN_SIZES = (HGRN_W, HGRN_W, HGRN_W, HGRN_W, HGRN_W,
            GLA_WK, GLA_WK, GLA_WV, GLA_GATE_RANK, GLA_GATE_RANK, GLA_WV,
            D_MODEL, D_MODEL)
IN_DIM = sum(IN_SIZES)

N_EXPERTS = 32
TOP_K = 4
D_EXPERT = 1024
SWIGLU_LIMIT = 7.0
SWIGLU_ALPHA = 1.702
MOE_BLOCK = 256

NORM_EPS = 1e-6

kernel_name = "hybrid_hgrn2_gla_moe_prefix_dit"


def _rms_norm(x, w):
    xf = x.astype(jnp.float32)
    y = xf * lax.rsqrt(jnp.mean(xf * xf, axis=-1, keepdims=True) + NORM_EPS) * w.astype(jnp.float32)
    return y.astype(x.dtype)


def _split_points():
    pts, acc = [], 0
    for s in IN_SIZES[:-1]:
        acc += s
        pts.append(acc)
    return pts


def _heads(t, n_heads):
    b_, l_, w_ = t.shape
    return t.reshape(b_, l_, n_heads, w_ // n_heads).transpose(0, 2, 1, 3)


def _gated_chunk_scan(q, k, v, log_g, s0):
    b_, h_, l_, _ = q.shape
    dv = v.shape[-1]
    n = l_ // CHUNK

    def to_chunks(t):
        return jnp.moveaxis(t.astype(jnp.float32).reshape(b_, h_, n, CHUNK, t.shape[-1]), 2, 0)

    incl = jnp.tril(jnp.ones((CHUNK, CHUNK), dtype=bool))[:, :, None]

    def step(state, inp):
        qc, kc, vc, gc = inp
        cum = jnp.cumsum(gc, axis=2)
        rel = cum[:, :, :, None, :] - cum[:, :, None, :, :]
        decay = jnp.exp(jnp.where(incl, rel, -jnp.inf))
        scores = jnp.einsum('bhid,bhjd,bhijd->bhij', qc, kc, decay)
        o = (jnp.einsum('bhij,bhjv->bhiv', scores, vc)
             + jnp.einsum('bhid,bhdv->bhiv', qc * jnp.exp(cum), state))
        last = cum[:, :, -1:, :]
        k_dec = kc * jnp.exp(last - cum)
        state = jnp.exp(last[:, :, 0, :, None]) * state + jnp.einsum('bhjd,bhjv->bhdv', k_dec, vc)
        return state, o

    s_fin, o = lax.scan(step, s0, (to_chunks(q), to_chunks(k), to_chunks(v), to_chunks(log_g)))
    o = jnp.moveaxis(o, 0, 2).reshape(b_, h_, l_, dv)
    return o, s_fin


def _zero_state(seq):
    q, v = seq[0], seq[3]
    return jnp.zeros((q.shape[0], q.shape[1], q.shape[3], v.shape[3]), jnp.float32)


def _bidir_scan(seq, s0_f, s0_b):
    q, kf, kb, v, gf, gb = seq
    flip = lambda t: jnp.flip(t, axis=2)
    o_f, s_f = _gated_chunk_scan(q, kf, v, gf, s0_f)
    o_b, s_b = _gated_chunk_scan(flip(q), flip(kb), flip(v), flip(gb), s0_b)
    return o_f + flip(o_b), s_f, s_b


def _hgrn2_inputs(q, z_f, z_b, i, lb):
    def gates(z, lb_d):
        z = z.astype(jnp.float32)
        log_f = jnp.log(lb_d + (1.0 - lb_d) * jax.nn.sigmoid(z))
        key = (1.0 - lb_d) * jax.nn.sigmoid(-z)
        return _heads(key, HGRN_HEADS), _heads(log_f, HGRN_HEADS)
    kf, gf = gates(z_f, lb[0])
    kb, gb = gates(z_b, lb[1])
    return (_heads(q, HGRN_HEADS), kf, kb, _heads(i, HGRN_HEADS), gf, gb)


def _gla_inputs(q, k, v, r_f, r_b, gk_w2, gk_b):
    gf = jax.nn.log_sigmoid((r_f @ gk_w2[0] + gk_b[0]).astype(jnp.float32)) / GLA_GATE_NORMALIZER
    gb = jax.nn.log_sigmoid((r_b @ gk_w2[1] + gk_b[1]).astype(jnp.float32)) / GLA_GATE_NORMALIZER
    kh = _heads(k, GLA_HEADS)
    return (_heads(q * (GLA_DK ** -0.5), GLA_HEADS), kh, kh, _heads(v, GLA_HEADS),
            _heads(gf, GLA_HEADS), _heads(gb, GLA_HEADS))


def _head_readout(o, norm_w, gate):
    o = o * lax.rsqrt(jnp.mean(o * o, axis=-1, keepdims=True) + NORM_EPS) * norm_w.astype(jnp.float32)
    b_, h_, l_, dv = o.shape
    o = o.transpose(0, 2, 1, 3).reshape(b_, l_, h_ * dv)
    return (o * jax.nn.silu(gate.astype(jnp.float32))).astype(gate.dtype)


def _hybrid_mixer(h_lat, h_ctx, need_ctx_out, w_in, lb, hgrn_norm_w, gla_gk_w2, gla_gk_b,
                  gla_norm_w, w_up_a, w_up_b, w_o):
    split_at = _split_points()

    def prepare(h):
        (qa, za_f, za_b, ia, oga, qb, kb, vb, rb_f, rb_b, ogb, mga, mgb) = jnp.split(h @ w_in, split_at, axis=-1)
        seq_a = _hgrn2_inputs(qa, za_f, za_b, ia, lb)
        seq_b = _gla_inputs(qb, kb, vb, rb_f, rb_b, gla_gk_w2, gla_gk_b)
        return seq_a, seq_b, (oga, ogb, mga, mgb)

    def merge(o_a, o_b, gates):
        oga, ogb, mga, mgb = gates
        y_a = _head_readout(o_a, hgrn_norm_w, oga) @ w_up_a
        y_b = _head_readout(o_b, gla_norm_w, ogb) @ w_up_b
        return (jax.nn.sigmoid(mga) * y_a + jax.nn.sigmoid(mgb) * y_b) @ w_o

    ctx_a, ctx_b, ctx_gates = prepare(h_ctx)
    oc_a, sa_f, sa_b = _bidir_scan(ctx_a, _zero_state(ctx_a), _zero_state(ctx_a))
    oc_b, sb_f, sb_b = _bidir_scan(ctx_b, _zero_state(ctx_b), _zero_state(ctx_b))
    lat_a, lat_b, lat_gates = prepare(h_lat)
    ol_a, _, _ = _bidir_scan(lat_a, sa_f, sa_b)
    ol_b, _, _ = _bidir_scan(lat_b, sb_f, sb_b)
    out_lat = merge(ol_a, ol_b, lat_gates)
    out_ctx = merge(oc_a, oc_b, ctx_gates) if need_ctx_out else None
    return out_lat, out_ctx


def _moe(xt, w_router, b_router, w_gate, b_gate, w_up, b_up, w_down, b_down):
    t_ = xt.shape[0]
    logits = (xt @ w_router).astype(jnp.float32) + b_router.astype(jnp.float32)
    top_val, top_idx = lax.top_k(logits, TOP_K)
    probs = jax.nn.softmax(top_val, axis=-1)
    n_pairs = t_ * TOP_K
    flat_e = top_idx.reshape(-1)
    flat_tok = jnp.arange(n_pairs, dtype=jnp.int32) // TOP_K
    flat_w = probs.reshape(-1)
    order = jnp.argsort(flat_e)
    e_sorted, tok_sorted, w_sorted = flat_e[order], flat_tok[order], flat_w[order]
    counts = jnp.zeros((N_EXPERTS,), jnp.int32).at[flat_e].add(1)
    padded = (counts + MOE_BLOCK - 1) // MOE_BLOCK * MOE_BLOCK
    padded_end = jnp.cumsum(padded)
    padded_start = padded_end - padded
    start = jnp.cumsum(counts) - counts
    rank = jnp.arange(n_pairs, dtype=jnp.int32) - start[e_sorted]
    dest = padded_start[e_sorted] + rank
    n_blocks = -(-n_pairs // MOE_BLOCK) + N_EXPERTS
    p_len = n_blocks * MOE_BLOCK
    tok_pad = jnp.full((p_len,), t_, jnp.int32).at[dest].set(tok_sorted)
    w_pad = jnp.zeros((p_len,), jnp.float32).at[dest].set(w_sorted)
    block_expert = jnp.minimum(
        jnp.searchsorted(padded_end, jnp.arange(n_blocks, dtype=jnp.int32) * MOE_BLOCK, side='right'),
        N_EXPERTS - 1)
    xt_pad = jnp.concatenate([xt, jnp.zeros((1, xt.shape[1]), xt.dtype)], axis=0)

    def expert_block(args):
        tok_b, e = args
        xb = xt_pad[tok_b]
        g = jnp.minimum(xb @ w_gate[e] + b_gate[e], SWIGLU_LIMIT)
        u = jnp.clip(xb @ w_up[e] + b_up[e], -SWIGLU_LIMIT, SWIGLU_LIMIT)
        act = g * jax.nn.sigmoid(SWIGLU_ALPHA * g) * (u + 1.0)
        return act @ w_down[e] + b_down[e]

    ys = lax.map(expert_block, (tok_pad.reshape(n_blocks, MOE_BLOCK), block_expert))
    ys = ys.reshape(p_len, -1) * w_pad[:, None].astype(ys.dtype)
    return jax.ops.segment_sum(ys, tok_pad, num_segments=t_ + 1)[:t_]


def setup_inputs(seed: int = 0) -> dict:
    key = jax.random.key(seed)
    ks = jax.random.split(key, 27)
    nrm = lambda k, shape, s: jax.random.normal(k, shape, jnp.float32) * s
    gain = lambda k, shape: 1.0 + 0.02 * jax.random.normal(k, shape, jnp.float32)
    D, E, F = D_MODEL, N_EXPERTS, D_EXPERT
    return {
        "x": nrm(ks[0], (BATCH, SEQ, D), 1.0),
        "c": nrm(ks[1], (BATCH, D), 1.0),
        "ctx": nrm(ks[2], (BATCH, CTX_LEN, D), 1.0),
        "c_ctx": nrm(ks[3], (D,), 1.0),
        "w_ada": nrm(ks[4], (DEPTH, D, 6 * D), 0.5 * D ** -0.5),
        "b_ada": nrm(ks[5], (DEPTH, 6 * D), 0.01),
        "g_pre_mix": gain(ks[6], (DEPTH, D)),
        "g_post_mix": gain(ks[7], (DEPTH, D)),
        "g_pre_ffn": gain(ks[8], (DEPTH, D)),
        "g_post_ffn": gain(ks[9], (DEPTH, D)),
        "w_in": nrm(ks[10], (DEPTH, D, IN_DIM), D ** -0.5),
        "hgrn_lb": nrm(ks[11], (DEPTH + 1, 2, HGRN_W), 0.1),
        "hgrn_norm_w": gain(ks[12], (DEPTH, HGRN_DV)),
        "gla_gk_w2": nrm(ks[13], (DEPTH, 2, GLA_GATE_RANK, GLA_WK), GLA_GATE_RANK ** -0.5),
        "gla_gk_b": nrm(ks[14], (DEPTH, 2, GLA_WK), 0.1),
        "gla_norm_w": gain(ks[15], (DEPTH, GLA_DV)),
        "w_up_a": nrm(ks[16], (DEPTH, HGRN_W, D), HGRN_W ** -0.5),
        "w_up_b": nrm(ks[17], (DEPTH, GLA_WV, D), GLA_WV ** -0.5),
        "w_o": nrm(ks[18], (DEPTH, D, D), D ** -0.5),
        "w_router": nrm(ks[19], (DEPTH, D, E), D ** -0.5),
        "b_router": nrm(ks[20], (DEPTH, E), 0.01),
        "w_gate": nrm(ks[21], (DEPTH, E, D, F), D ** -0.5),
        "b_gate": nrm(ks[22], (DEPTH, E, F), 0.01),
        "w_up": nrm(ks[23], (DEPTH, E, D, F), D ** -0.5),
        "b_up": nrm(ks[24], (DEPTH, E, F), 0.01),
        "w_down": nrm(ks[25], (DEPTH, E, F, D), F ** -0.5),
        "b_down": nrm(ks[26], (DEPTH, E, D), 0.01),
    }


def reference(x, c, ctx, c_ctx, w_ada, b_ada, g_pre_mix, g_post_mix, g_pre_ffn, g_post_ffn,
              w_in, hgrn_lb, hgrn_norm_w, gla_gk_w2, gla_gk_b, gla_norm_w, w_up_a, w_up_b, w_o,
              w_router, b_router, w_gate, b_gate, w_up, b_up, w_down, b_down):
    lb_all = jnp.cumsum(jax.nn.softmax(hgrn_lb.astype(jnp.float32), axis=0), axis=0)
    b_, l_, d_ = x.shape
    for layer in range(DEPTH):
        last = layer == DEPTH - 1
        mod = jax.nn.silu(c) @ w_ada[layer] + b_ada[layer]
        sh1, sc1, gt1, sh2, sc2, gt2 = jnp.split(mod[:, None, :], 6, axis=-1)
        cmod = jnp.split(jax.nn.silu(c_ctx) @ w_ada[layer] + b_ada[layer], 6)

        h = _rms_norm(x, g_pre_mix[layer]) * (1.0 + sc1) + sh1
        hc = _rms_norm(ctx, g_pre_mix[layer]) * (1.0 + cmod[1]) + cmod[0]
        mix_l, mix_c = _hybrid_mixer(h, hc, not last, w_in[layer], lb_all[layer], hgrn_norm_w[layer],
                                     gla_gk_w2[layer], gla_gk_b[layer], gla_norm_w[layer],
                                     w_up_a[layer], w_up_b[layer], w_o[layer])
        x = x + gt1 * _rms_norm(mix_l, g_post_mix[layer])

        h2 = _rms_norm(x, g_pre_ffn[layer]) * (1.0 + sc2) + sh2
        ffn = _moe(h2.reshape(b_ * l_, d_), w_router[layer], b_router[layer], w_gate[layer], b_gate[layer],
                   w_up[layer], b_up[layer], w_down[layer], b_down[layer]).reshape(b_, l_, d_)
        x = x + gt2 * _rms_norm(ffn, g_post_ffn[layer])

        if not last:
            ctx = ctx + cmod[2] * _rms_norm(mix_c, g_post_mix[layer])
            hc2 = _rms_norm(ctx, g_pre_ffn[layer]) * (1.0 + cmod[4]) + cmod[3]
            lc = ctx.shape[1]
            ffn_c = _moe(hc2.reshape(b_ * lc, d_), w_router[layer], b_router[layer], w_gate[layer], b_gate[layer],
                         w_up[layer], b_up[layer], w_down[layer], b_down[layer]).reshape(b_, lc, d_)
            ctx = ctx + cmod[5] * _rms_norm(ffn_c, g_post_ffn[layer])
    return x
```

```cpp
#include <hip/hip_runtime.h>
#include <cstdio>
#include <cstdint>

#ifndef MK_N_LAUNCHES
#define MK_N_LAUNCHES 1
#endif

#ifndef REPEAT_PHASE
#define REPEAT_PHASE -1
#endif
#ifndef MOE_FP8
#define MOE_FP8 1
#endif
#ifndef INPROJ_FP8
#define INPROJ_FP8 1
#endif
#ifndef ACT_FP8
#define ACT_FP8 1
#endif
#ifndef USE_NAIVE_SCAN
#define USE_NAIVE_SCAN 0
#endif
#define LAS __attribute__((address_space(3)))
typedef unsigned short bf16;
typedef short bf16x8 __attribute__((ext_vector_type(8)));
typedef float f32x4 __attribute__((ext_vector_type(4)));
typedef float f32x2 __attribute__((ext_vector_type(2)));
typedef unsigned u32x4 __attribute__((ext_vector_type(4)));
typedef unsigned u32x2 __attribute__((ext_vector_type(2)));
typedef int i32x4 __attribute__((ext_vector_type(4)));
typedef int i32x8 __attribute__((ext_vector_type(8)));

constexpr int D = 1024, NB = 16, SEQ = 2048, CTX = 256;
constexpr int T = NB * SEQ, TC = NB * CTX, MALL = T + TC;
constexpr int NZ = 3072;
constexpr int ZC_OGA = 0, ZC_OGB = 512, ZC_MGA = 1024, ZC_MGB = 2048;
constexpr int NSTEP = 36;
constexpr int NT_HI = 14, NT_LO = 12;
constexpr int IN_DIM = 6176;
constexpr int NE = 32, TOPK = 4, FF = 1024;
constexpr int MAXSLOT = T * TOPK + NE * 256, MAXTILES = MAXSLOT / 256;
constexpr float EPS = 1e-6f;
constexpr int NWAVES = 8, NTHREADS = 512;

constexpr size_t MiB = 1u << 20;
constexpr size_t WS_CTL = 0, CTL_ZERO_BYTES = 1 * MiB;
constexpr size_t WS_MOD = 1 * MiB;
constexpr size_t WS_WRT = 1 * MiB + 512 * 1024;
constexpr size_t WS_WIN = 2 * MiB;
constexpr size_t WS_WUA = 15 * MiB, WS_WUB = 16 * MiB, WS_WO = 17 * MiB;
constexpr size_t WS_TOPI = 19 * MiB, WS_TOPP = WS_TOPI + 512 * 1024, WS_LRANK = 20 * MiB, WS_PSLOT = WS_LRANK + 512 * 1024, WS_BLKBASE = 21 * MiB, WS_TOKSLOT = 21 * MiB + 256 * 1024, WS_TILEE = 22 * MiB;
constexpr size_t WS_HBF = 24 * MiB;
constexpr size_t WS_RA = 24 * MiB, WS_RB = 56 * MiB;
constexpr size_t WS_H2 = 24 * MiB;
constexpr size_t WS_Z = 96 * MiB;
constexpr size_t WS_RQA = 288 * MiB;
constexpr size_t WS_RQB = 432 * MiB;
constexpr size_t WS_RVA = 504 * MiB;
constexpr size_t WS_RVB = 540 * MiB;
constexpr size_t WS_EL = 576 * MiB;
constexpr int NCG = MALL / 64;
constexpr size_t WS_WGU = 89 * MiB;
constexpr size_t WS_Y = 24 * MiB;
constexpr size_t WS_X1B = 160 * MiB;
constexpr size_t WS_MIXB = 296 * MiB;
constexpr size_t WS_WD = 360 * MiB;
constexpr size_t WS_HREST = (MOE_FP8 ? 392 : 424) * MiB;
constexpr size_t WS_END = 580 * MiB;
constexpr bool kInFp8 = (INPROJ_FP8 != 0);
constexpr int IN_KB = kInFp8 ? 1024 : 2048;
constexpr float IN_WSCALE = kInFp8 ? 32.f : 1.f;
constexpr size_t WS_WIN_LO = 12 * MiB;
constexpr bool kActFp8 = (ACT_FP8 != 0);
constexpr bool kMixFp8 = false;
constexpr bool kMoeFp8 = (MOE_FP8 != 0);
constexpr int MOE_KB = kMoeFp8 ? 1024 : 2048;
constexpr float MOE_WSCALE = kMoeFp8 ? 32.f : 1.f;
constexpr int H_SPLIT_TILES = kMoeFp8 ? 0 : 256;
constexpr int CW_BAR = 4096, CW_GCOUNT = 16384, CW_NT = 16384 + 64;

#define RLX_AGENT __ATOMIC_RELAXED, __HIP_MEMORY_SCOPE_AGENT
#define LDS_WAIT() asm volatile("s_waitcnt lgkmcnt(0)" ::: "memory")
#define VM_WAIT() asm volatile("s_waitcnt vmcnt(0)" ::: "memory")
__device__ __forceinline__ unsigned f2bf(float f) { unsigned u = __builtin_bit_cast(unsigned, f); return (u + 0x7fffu + ((u >> 16) & 1u)) >> 16; }
__device__ __forceinline__ unsigned pk2(float lo, float hi) { return f2bf(lo) | (f2bf(hi) << 16); }
__device__ __forceinline__ unsigned pk4_fp8(float a, float b, float c, float d) { int w = 0; w = __builtin_amdgcn_cvt_pk_fp8_f32(a, b, w, false); w = __builtin_amdgcn_cvt_pk_fp8_f32(c, d, w, true); return (unsigned)w; }
__device__ __forceinline__ float bf2f(unsigned short b) { return __builtin_bit_cast(float, ((unsigned)b) << 16); }
__device__ __forceinline__ float bflo(unsigned w) { return __builtin_bit_cast(float, w << 16); }
__device__ __forceinline__ float bfhi(unsigned w) { return __builtin_bit_cast(float, w & 0xffff0000u); }
__device__ __forceinline__ float sigmoidf_(float x) { return __builtin_amdgcn_rcpf(1.0f + __expf(-x)); }
template <int CTRL> __device__ __forceinline__ float dpp_mov(float v, float old) { return __builtin_bit_cast(float, __builtin_amdgcn_update_dpp(__builtin_bit_cast(int, old), __builtin_bit_cast(int, v), CTRL, 0xf, 0xf, false)); }
__device__ __forceinline__ float rdlane(float v, int l) { return __builtin_bit_cast(float, __builtin_amdgcn_readlane(__builtin_bit_cast(int, v), l)); }
__device__ __forceinline__ float wave_sum(float v) {
    v += dpp_mov<0x111>(v, 0.f); v += dpp_mov<0x112>(v, 0.f); v += dpp_mov<0x114>(v, 0.f); v += dpp_mov<0x118>(v, 0.f);
    return (rdlane(v, 15) + rdlane(v, 31)) + (rdlane(v, 47) + rdlane(v, 63));
}
__device__ __forceinline__ float wave_max(float v) {
    const float ninf = -INFINITY;
    v = fmaxf(v, dpp_mov<0x111>(v, ninf)); v = fmaxf(v, dpp_mov<0x112>(v, ninf)); v = fmaxf(v, dpp_mov<0x114>(v, ninf)); v = fmaxf(v, dpp_mov<0x118>(v, ninf));
    return fmaxf(fmaxf(rdlane(v, 15), rdlane(v, 31)), fmaxf(rdlane(v, 47), rdlane(v, 63)));
}

__device__ __forceinline__ int qperm(int d) { return (d & ~31) | (((d >> 2) & 3) << 3) | (((d >> 4) & 1) << 2) | (d & 3); }
namespace pg8 {
constexpr int BM = 256, BK = 64, HALF = 128, HTB = HALF * BK * 2, STAGE_BYTES = 8 * HTB;
__device__ __forceinline__ int lds_byte(int r, int c) { const int st = (r >> 4) * 2 + (c >> 5), rr = r & 15, cc = c & 31, ob = rr * 64 + cc * 2; return st * 1024 + (ob ^ (((ob >> 9) & 1) << 5)); }
__device__ __forceinline__ void stage_rc(int b, int& R, int& C) { const int st = b / 1024, sb = b % 1024, swz = sb ^ (((sb >> 9) & 1) << 5); R = (st >> 1) * 16 + swz / 64; C = (st & 1) * 32 + (swz % 64) / 2; }
__device__ __forceinline__ int perm32(int rho) { const int n = rho >> 4, i = rho & 15; return 8 * (i >> 2) + 4 * n + (i & 3); }
__device__ __forceinline__ unsigned cvt_pk_bf16(float lo, float hi) { unsigned r; asm volatile("v_cvt_pk_bf16_f32 %0, %1, %2" : "=v"(r) : "v"(lo), "v"(hi)); return r; }

struct Unit { int pm, pn, e; unsigned a, b; };

template <class E, class = void> struct EpiHasPre { static constexpr bool value = false; };
template <class E> struct EpiHasPre<E, decltype((void)E::PRE)> { static constexpr bool value = E::PRE; };
__device__ __forceinline__ void glds4(const void* g, LAS void* l) { __builtin_amdgcn_global_load_lds((const unsigned*)g, (LAS unsigned*)l, 4, 0, 0); }
template <class E, class = void> struct EpiHasMid { static constexpr bool value = false; };
template <class E> struct EpiHasMid<E, decltype((void)E::MID)> { static constexpr bool value = E::MID; };
template <class Epi, class Sched, int GATHER, bool ALIGN_EPI, bool FP8, int BPERM = 0>
__device__ __forceinline__ void gemm_phase(LAS unsigned char* lds, const int KB, const Sched& S, const Epi& E, const int* __restrict__ rowidx, const char* gatherA, const void* Abase, const void* Bbase) {
    const int tid = threadIdx.x, wid = __builtin_amdgcn_readfirstlane(tid >> 6), lane = tid & 63, wr = wid >> 2, wc = wid & 3, fr = lane & 15, fq = lane >> 4;
    const int nt = KB / (BK * 2);
    unsigned vA[2][2], voffB[2]; int Rr[2], Cc[2];
#pragma unroll
    for (int i = 0; i < 2; ++i) { int R, C; stage_rc(tid * 16 + i * 8192, R, C); Rr[i] = R; Cc[i] = C; const int Rb = (R & ~31) + perm32(R & 31);
        const int Rp = (R >> 5) * 64 + ((R >> 2) & 3) * 16 + ((R >> 4) & 1) * 4 + (R & 3);
        voffB[i] = (unsigned)((BPERM ? Rp : Rb) * KB + 2 * C); vA[0][i] = (unsigned)(R * KB + 2 * C); vA[1][i] = (unsigned)((R + HALF) * KB + 2 * C); }
    const unsigned kstep = (unsigned)(BK * 2);
    const unsigned hstep = (unsigned)(HALF * KB);
    const unsigned hstepB = BPERM ? (unsigned)(8 * KB) : hstep;
    const unsigned ldsw = (unsigned)wid * 1024u;
    const int aoff = lds_byte(wr * 64 + fr, FP8 ? fq * 16 : fq * 8), boff = lds_byte(wc * 32 + fr, FP8 ? fq * 16 : fq * 8);
    constexpr int KSTR = FP8 ? 16 : 1024;
#define PG8_SA(b, h) (((b) * 2 + (h)) * HTB)
#define PG8_SB(b, h) ((4 + (b) * 2 + (h)) * HTB)
#define PG8_STAGE(bufoff, rsrc, soff, voff) do { _Pragma("unroll") for (int _i = 0; _i < 2; ++_i) \
        __builtin_amdgcn_raw_ptr_buffer_load_lds(rsrc, (LAS void*)(lds + (bufoff) + ldsw + _i * 8192), 16, (int)(voff)[_i], (int)(soff), 0, 0); } while (0)
#define PG8_LDA(dst, b, h) do { _Pragma("unroll") for (int m = 0; m < 4; ++m) _Pragma("unroll") for (int k = 0; k < 2; ++k) dst[m][k] = *(const LAS i32x4*)(lds + PG8_SA(b, h) + aoff + m * 2048 + k * KSTR); } while (0)
#define PG8_LDB(dst, b, h) do { _Pragma("unroll") for (int n = 0; n < 2; ++n) _Pragma("unroll") for (int k = 0; k < 2; ++k) dst[n][k] = *(const LAS i32x4*)(lds + PG8_SB(b, h) + boff + n * 2048 + k * KSTR); } while (0)
#define PG8_V8(x) __builtin_shufflevector((x)[0], (x)[1], 0, 1, 2, 3, 4, 5, 6, 7)
#define PG8_MMA(ai, bj, At, Bt) do { __builtin_amdgcn_s_setprio(3); _Pragma("unroll") for (int m = 0; m < 4; ++m) _Pragma("unroll") for (int n = 0; n < 2; ++n) { \
        if constexpr (FP8) acc[ai][bj][m][n] = __builtin_amdgcn_mfma_scale_f32_16x16x128_f8f6f4(PG8_V8(Bt[n]), PG8_V8(At[m]), acc[ai][bj][m][n], 0, 0, 0, 0x7f7f7f7f, 0, 0x7f7f7f7f); \
        else { _Pragma("unroll") for (int k = 0; k < 2; ++k) acc[ai][bj][m][n] = __builtin_amdgcn_mfma_f32_16x16x32_bf16(__builtin_bit_cast(bf16x8, Bt[n][k]), __builtin_bit_cast(bf16x8, At[m][k]), acc[ai][bj][m][n], 0, 0, 0); } } \
        __builtin_amdgcn_s_setprio(0); } while (0)
#define PG8_WAIT_V(n) asm volatile("s_waitcnt vmcnt(" #n ")" ::: "memory")
#define PG8_WAIT_VN(pe) do { if constexpr (Epi::NSTORES >= 16) asm volatile("s_cmp_lg_u32 %0, 0\n\ts_cbranch_scc1 1f\n\ts_waitcnt vmcnt(8)\n1:\n\ts_waitcnt vmcnt(24)" :: "s"(__builtin_amdgcn_readfirstlane((int)(pe))) : "memory", "scc"); \
        else if constexpr (Epi::NSTORES >= 8) asm volatile("s_cmp_lg_u32 %0, 0\n\ts_cbranch_scc1 1f\n\ts_waitcnt vmcnt(8)\n1:\n\ts_waitcnt vmcnt(16)" :: "s"(__builtin_amdgcn_readfirstlane((int)(pe))) : "memory", "scc"); \
        else asm volatile("s_waitcnt vmcnt(8)" ::: "memory"); } while (0)
#define PG8_WAIT_L(n) asm volatile("s_waitcnt lgkmcnt(" #n ")" ::: "memory")
#define PG8_BAR __builtin_amdgcn_s_barrier()
#define PG8_SCHED __builtin_amdgcn_sched_barrier(0)
#define PG8_GATHER_OFFS(dst, unit) do { _Pragma("unroll") for (int _h = 0; _h < 2; ++_h) _Pragma("unroll") for (int _i = 0; _i < 2; ++_i) \
        dst[_h][_i] = (unsigned)((GATHER == 1 ? rowidx[(unit).pm * BM + _h * HALF + Rr[_i]] : (unit).pm * BM + _h * HALF + Rr[_i]) * KB + 2 * Cc[_i]); } while (0)
#define PG8_GATHER_OFFS_LDS(dst, unit) do { _Pragma("unroll") for (int _h = 0; _h < 2; ++_h) _Pragma("unroll") for (int _i = 0; _i < 2; ++_i) \
        dst[_h][_i] = (unsigned)((GATHER == 1 ? IDX[_h * HALF + Rr[_i]] : (unit).pm * BM + _h * HALF + Rr[_i]) * KB + 2 * Cc[_i]); } while (0)
    LAS int* const IDX = (LAS int*)(lds + STAGE_BYTES + 1024);
    LAS float* const EC = (LAS float*)(lds + STAGE_BYTES + 2048) + wid * 64;
    Unit cur, nxt; int ui = 0;
    if (!S.next(0, cur)) return;
    f32x4 acc[2][2][4][2];
#pragma unroll
    for (int a = 0; a < 2; ++a)
#pragma unroll
        for (int b = 0; b < 2; ++b)
#pragma unroll
            for (int m = 0; m < 4; ++m)
#pragma unroll
                for (int n = 0; n < 2; ++n) acc[a][b][m][n] = (f32x4){0.f, 0.f, 0.f, 0.f};
    i32x4 At[4][2], B0[2][2], B1[2][2];
    const __amdgpu_buffer_rsrc_t rA = __builtin_amdgcn_make_buffer_rsrc((void*)(GATHER ? gatherA : Abase), 0, 0x7fffffff, 0x00020000);
    const __amdgpu_buffer_rsrc_t rB = __builtin_amdgcn_make_buffer_rsrc((void*)Bbase, 0, 0x7fffffff, 0x00020000);
    unsigned cA = GATHER ? 0u : cur.a, cB = cur.b;
    if constexpr (GATHER) { PG8_GATHER_OFFS(vA, cur); }
    if constexpr (EpiHasPre<Epi>::value) E.pre(cur, EC, wc, lane);
    PG8_STAGE(PG8_SB(0, 0), rB, cB, voffB); PG8_STAGE(PG8_SB(0, 1), rB, cB + hstepB, voffB); PG8_STAGE(PG8_SA(0, 0), rA, cA, vA[0]); PG8_STAGE(PG8_SA(0, 1), rA, cA, vA[1]);
    if (wr == 1) PG8_BAR;
    PG8_WAIT_V(2); PG8_BAR;
    PG8_STAGE(PG8_SB(1, 0), rB, cB + kstep, voffB); PG8_STAGE(PG8_SA(1, 0), rA, cA + kstep, vA[0]); PG8_STAGE(PG8_SB(1, 1), rB, cB + hstepB + kstep, voffB);
    PG8_WAIT_V(6); PG8_BAR;
    for (;;) {
        const bool has_next = S.next(ui + 1, nxt);
        const unsigned nA = GATHER ? 0u : (has_next ? nxt.a : cA), nB = has_next ? nxt.b : cB;
        if constexpr (GATHER == 1) { if (has_next && wid < 4) glds4(rowidx + nxt.pm * BM + 64 * wid + lane, IDX + 64 * wid); }
#pragma nounroll
        for (int t = 0; t < nt; t += 2) {
            const bool last = (t == nt - 2);
            const unsigned a1 = cA + (unsigned)(t + 1) * kstep;
            const unsigned a2 = last ? nA : cA + (unsigned)(t + 2) * kstep, b2 = last ? nB : cB + (unsigned)(t + 2) * kstep;
            const unsigned a3 = a2 + kstep, b3 = b2 + kstep;
            if constexpr (EpiHasMid<Epi>::value) { if (t == nt / 2) E.mid(acc, cur, wr, wc, fr, fq); }
            unsigned vN[2][2];
            if constexpr (GATHER) { if (last && has_next) { PG8_GATHER_OFFS_LDS(vN, nxt); } }
            const bool post_epi = (t == 0) && (ui > 0);
            PG8_LDB(B0, 0, 0); PG8_LDB(B1, 0, 1); PG8_SCHED; PG8_LDA(At, 0, 0); PG8_STAGE(PG8_SA(1, 1), rA, a1, vA[1]);
            if constexpr (GATHER) { if (last && has_next) {
#pragma unroll
                for (int _h = 0; _h < 2; ++_h)
#pragma unroll
                    for (int _i = 0; _i < 2; ++_i) vA[_h][_i] = vN[_h][_i]; } }
            PG8_WAIT_VN(post_epi);
            PG8_WAIT_L(0); PG8_BAR; PG8_MMA(0, 0, At, B0); PG8_MMA(0, 1, At, B1); PG8_BAR; PG8_SCHED;
            PG8_LDA(At, 0, 1); PG8_STAGE(PG8_SB(0, 0), rB, b2, voffB); PG8_STAGE(PG8_SB(0, 1), rB, b2 + hstepB, voffB); PG8_STAGE(PG8_SA(0, 0), rA, a2, vA[0]);
            PG8_WAIT_VN(post_epi);
            PG8_WAIT_L(0); PG8_BAR; PG8_MMA(1, 0, At, B0); PG8_MMA(1, 1, At, B1); PG8_BAR; PG8_SCHED;
            PG8_LDB(B0, 1, 0); PG8_LDB(B1, 1, 1); PG8_SCHED; PG8_LDA(At, 1, 0); PG8_STAGE(PG8_SA(0, 1), rA, a2, vA[1]);
            PG8_WAIT_V(8); PG8_WAIT_L(0); PG8_BAR; PG8_MMA(0, 0, At, B0); PG8_MMA(0, 1, At, B1); PG8_BAR; PG8_SCHED;
            PG8_LDA(At, 1, 1); PG8_STAGE(PG8_SB(1, 0), rB, b3, voffB); PG8_STAGE(PG8_SB(1, 1), rB, b3 + hstepB, voffB); PG8_STAGE(PG8_SA(1, 0), rA, a3, vA[0]);
            PG8_WAIT_V(8); PG8_WAIT_L(0); PG8_BAR; PG8_MMA(1, 0, At, B0); PG8_MMA(1, 1, At, B1); PG8_BAR; PG8_SCHED;
        }
        if constexpr (ALIGN_EPI) { if (wr == 0) PG8_BAR; }
        if constexpr (EpiHasPre<Epi>::value) E(acc, cur, wr, wc, fr, fq, EC); else E(acc, cur, wr, wc, fr, fq);
        if (!has_next) break;
#pragma unroll
        for (int a = 0; a < 2; ++a)
#pragma unroll
            for (int b = 0; b < 2; ++b)
#pragma unroll
                for (int m = 0; m < 4; ++m)
#pragma unroll
                    for (int n = 0; n < 2; ++n) acc[a][b][m][n] = (f32x4){0.f, 0.f, 0.f, 0.f};
        cur = nxt; cA = nA; cB = nB; ++ui;
        if constexpr (EpiHasPre<Epi>::value) E.pre(cur, EC, wc, lane);
        if constexpr (ALIGN_EPI) { if (wr == 1) PG8_BAR; }
    }
    PG8_WAIT_V(0);
    if constexpr (!ALIGN_EPI) { if (wr == 0) PG8_BAR; }
    PG8_BAR;
#undef PG8_SA
#undef PG8_SB
#undef PG8_STAGE
#undef PG8_LDA
#undef PG8_LDB
#undef PG8_MMA
#undef PG8_V8
#undef PG8_WAIT_V
#undef PG8_WAIT_VN
#undef PG8_WAIT_L
#undef PG8_BAR
#undef PG8_SCHED
#undef PG8_GATHER_OFFS
#undef PG8_GATHER_OFFS_LDS
}

struct DenseOrder {
    int nM, nN, nwg, G, c, lo, hi; const char* A; const char* B; size_t tA, tB;
    __device__ void init(int M, int N, int KB, int G_, int c_, const void* A_, const void* B_) { nM = M / BM; nN = N / BM; nwg = nM * nN; G = G_; c = c_; lo = 0; hi = 1 << 20; A = (const char*)A_; B = (const char*)B_; tA = (size_t)BM * KB; tB = tA; }
    __device__ bool next(int i, Unit& u) const {
        if (i + lo >= hi) return false;
        const long L = (long)(i + lo) * G + c; if (L >= nwg) return false;
        int wgid = (int)L; { const int q = nwg / 8, r = nwg % 8, xcd = wgid % 8, off = wgid / 8; wgid = (xcd < r ? xcd * (q + 1) : r * (q + 1) + (xcd - r) * q) + off; }
        const int nig = 8 * nN, gid = wgid / nig, fm = gid * 8, gsz = (nM - fm) < 8 ? (nM - fm) : 8;
        u.pm = fm + ((wgid % nig) % gsz); u.pn = (wgid % nig) / gsz; u.e = 0; u.a = (unsigned)((size_t)u.pm * tA); u.b = (unsigned)((size_t)u.pn * tB); return true;
    }
};
struct InprojOrder {
    int G, c; const char* A; const char* B; size_t tA, tB;
    __device__ bool next(int i, Unit& u) const {
        const int L = i * G + c; constexpr int NLAT = 128 * NT_HI, NCTX = 16 * 14;
        if (L < NLAT) { const int xcd = L % 8, off = L / 8; const int wgid = xcd * (NLAT / 8) + off; constexpr int nig = 8 * NT_HI; const int gid = wgid / nig;
            u.pm = 16 + gid * 8 + ((wgid % nig) % 8); u.pn = (wgid % nig) / 8; }
        else if (L < NLAT + NCTX) { const int idx = L - NLAT; u.pm = idx / 14; u.pn = idx % 14; }
        else return false;
        u.e = 0; u.a = (unsigned)((size_t)u.pm * tA); u.b = (unsigned)((size_t)u.pn * tB); return true;
    }
};
struct MoeOrder {
    int nt, NPN, G, c; const int* tile_e; const char* B; size_t eB, tB; const char* A0; const char* A1; size_t tA;
    __device__ bool next(int i, Unit& u) const {
        const int nx = (G % 8 == 0) ? 8 : 1, per = G / nx, x = c % nx, j = c / nx;
        const int q = (nt + nx - 1) / nx, s = i * per + j, grp = 4 * NPN;
        const int rl = (s / grp) * 4 + (s & 3), pn = (s % grp) >> 2;
        if (rl >= q) return false;
        const int rt = x * q + rl; if (rt >= nt) return false;
        const int e = __builtin_amdgcn_readfirstlane(tile_e[rt]);
        u.pm = rt; u.pn = pn; u.e = e; u.b = (unsigned)((size_t)e * eB + (size_t)pn * tB); u.a = 0u; return true;
    }
};

#define EPI_LOOP_BEGIN \
    int rb_ = wr * 64 + fr; asm volatile("" : "+v"(rb_));     \
    _Pragma("unroll") for (int ai = 0; ai < 2; ++ai) _Pragma("unroll") for (int m = 0; m < 4; ++m) { const int row = u.pm * BM + ai * HALF + m * 16 + rb_; \
    _Pragma("unroll") for (int bj = 0; bj < 2; ++bj) { const int col = u.pn * BM + bj * HALF + wc * 32 + 8 * fq; f32x4 v0 = acc[ai][bj][m][0], v1 = acc[ai][bj][m][1];
#define EPI_LOOP_END } }
__device__ __forceinline__ u32x4 pack8(f32x4 v0, f32x4 v1) { u32x4 w; w.x = cvt_pk_bf16(v0[0], v0[1]); w.y = cvt_pk_bf16(v0[2], v0[3]); w.z = cvt_pk_bf16(v1[0], v1[1]); w.w = cvt_pk_bf16(v1[2], v1[3]); return w; }
__device__ __forceinline__ void unpack8(u32x4 w, f32x4& a, f32x4& b) { a = (f32x4){bflo(w.x), bfhi(w.x), bflo(w.y), bfhi(w.y)}; b = (f32x4){bflo(w.z), bfhi(w.z), bflo(w.w), bfhi(w.w)}; }

__device__ __forceinline__ float logsigmoidf_(float x) { return fminf(x, 0.f) - __logf(1.f + __expf(-fabsf(x))); }
__device__ __forceinline__ u32x2 pack4(f32x4 v) { u32x2 w; w.x = cvt_pk_bf16(v[0], v[1]); w.y = cvt_pk_bf16(v[2], v[3]); return w; }
struct EpiInproj {
    static constexpr bool PRE = true; static constexpr int NSTORES = 8;
    bf16* Z; unsigned char* WS; float* EL; const float* gkb; const float* hlb; int rowoff_tiles, tileoff; float scale;
    __device__ __forceinline__ void pre(const Unit& uu, LAS float* ec, int wc, int lane) const {
        const int t = uu.pn + tileoff, c = lane & 15, sd = lane >> 4;
        if (t < 8) glds4(hlb + (sd >> 1) * 1024 + (sd & 1) * 512 + (t >> 1) * 128 + (t & 1) * 64 + 16 * wc + c, ec);
        else if (t < 12) glds4(gkb + (sd & 1) * 256 + (t - 8) * 64 + 16 * wc + c, ec);
    }
    __device__ __forceinline__ void operator()(const f32x4 (&acc)[2][2][4][2], const Unit& uu, int wr, int wc, int fr, int fq, const LAS float* ec) const {
        const int pm = uu.pm + rowoff_tiles, t = uu.pn + tileoff;
        int fr_ = fr; asm volatile("" : "+v"(fr_));
        if (t < 14) {
#pragma unroll
            for (int ai = 0; ai < 2; ++ai) {
                const int cg = 4 * pm + 2 * ai + wr;
                const bool ctx = cg < TC / 64; const int b = ctx ? cg >> 2 : (cg - TC / 64) >> 5, mc = ctx ? cg & 3 : (cg - TC / 64) & 31, smem = ctx ? mc : 4 + mc;
                if (t < 12) {
                    const bool hg = t < 8; const int h = hg ? t >> 1 : t - 8, cc0 = 16 * wc + 4 * fq, chh = hg ? (t & 1) * 64 + cc0 : cc0, ch = (hg ? h * 128 : h * 64) + chh;
                    f32x4 c0[2];
#pragma unroll
                    for (int d = 0; d < 2; ++d) { if (hg) { const f32x4 a0 = *(const LAS f32x4*)(ec + 16 * d + 4 * fq), a1 = *(const LAS f32x4*)(ec + 32 + 16 * d + 4 * fq);
#pragma unroll
                            for (int j = 0; j < 4; ++j) c0[d][j] = __builtin_amdgcn_rcpf(1.f + __expf(a1[j] - a0[j])); }
                        else c0[d] = *(const LAS f32x4*)(ec + 16 * d + 4 * fq) * 1.44269504f; }
                    const int tsz = hg ? 16384 : 8192, wbase = ((hg ? (t & 1) * 4 : 0) + wc) * 2048 + 8 * (fq & 2) + 512 * (fq & 1);
                    unsigned char* const qkb = WS + (hg ? WS_RQA : WS_RQB);
#pragma unroll
                    for (int d = 0; d < 2; ++d) {
                        const int sd = d ? (ctx ? 3 - mc : 35 - mc) : smem, chain = (b * 4 + h) * 2 + d;
                        unsigned char* const tq = qkb + (size_t)((chain * NSTEP + sd) * 2) * tsz; unsigned char* const tk = tq + tsz;
                        const float id = hg ? 1.f : 0.f; f32x4 run = (f32x4){id, id, id, id};
                        u32x2 wq0 = (u32x2){0u, 0u}, wk0 = wq0;
#pragma unroll
                        for (int mm = 0; mm < 4; ++mm) { const int m = d ? 3 - mm : mm; f32x4 ky, e, ie;
                            if (hg) { const f32x4 z = acc[ai][d][m][1 - d] * (scale * -1.44269504f);
#pragma unroll
                                for (int j = 0; j < 4; ++j) { const float lb = c0[d][j], oml = 1.f - lb, s = __builtin_amdgcn_rcpf(1.f + __builtin_amdgcn_exp2f(z[j]));
                                    float v = __builtin_fmaf(oml, s, lb), tt = v; ky[j] = __builtin_fmaf(-oml, s, oml);
                                    if (d == 0) { v *= dpp_mov<0x111>(v, 1.f); v *= dpp_mov<0x112>(v, 1.f); v *= dpp_mov<0x114>(v, 1.f); v *= dpp_mov<0x118>(v, 1.f); }
                                    else        { v *= dpp_mov<0x101>(v, 1.f); v *= dpp_mov<0x102>(v, 1.f); v *= dpp_mov<0x104>(v, 1.f); v *= dpp_mov<0x108>(v, 1.f); }
                                    tt *= dpp_mov<0x128>(tt, 1.f); tt *= dpp_mov<0x124>(tt, 1.f); tt *= dpp_mov<0x122>(tt, 1.f); tt *= dpp_mov<0x121>(tt, 1.f);
                                    const float cm = run[j] * v; run[j] *= tt; e[j] = cm; ie[j] = __builtin_amdgcn_rcpf(cm); } }
                            else { const f32x4 x = acc[ai][1][m][d] * (scale * 1.44269504f); ky = acc[ai][0][m][1] * scale;
#pragma unroll
                                for (int j = 0; j < 4; ++j) { const float y2 = x[j] + c0[d][j];
                                    float v = (fminf(y2, 0.f) - __builtin_amdgcn_logf(1.f + __builtin_amdgcn_exp2f(-fabsf(y2)))) * 0.0625f, tt = v;
                                    if (d == 0) { v += dpp_mov<0x111>(v, 0.f); v += dpp_mov<0x112>(v, 0.f); v += dpp_mov<0x114>(v, 0.f); v += dpp_mov<0x118>(v, 0.f); }
                                    else        { v += dpp_mov<0x101>(v, 0.f); v += dpp_mov<0x102>(v, 0.f); v += dpp_mov<0x104>(v, 0.f); v += dpp_mov<0x108>(v, 0.f); }
                                    tt += dpp_mov<0x128>(tt, 0.f); tt += dpp_mov<0x124>(tt, 0.f); tt += dpp_mov<0x122>(tt, 0.f); tt += dpp_mov<0x121>(tt, 0.f);
                                    const float cm = run[j] + v; run[j] += tt; e[j] = __builtin_amdgcn_exp2f(cm); ie[j] = __builtin_amdgcn_exp2f(-cm); } }
                            u32x2 wq = (u32x2){0u, 0u}; const u32x2 wk = pack4(ky * ie);
                            if (!ctx) wq = pack4(acc[ai][0][m][0] * (hg ? scale : scale * 0.125f) * e);
                            if ((mm & 1) == 0) { wq0 = wq; wk0 = wk; }
                            else { const int roff = (16 * (mm - 1) + (d ? 15 - fr_ : fr_)) * 32;
                                if (!ctx) { const auto sx = __builtin_amdgcn_permlane16_swap(wq0.x, wq.x, false, false), sy = __builtin_amdgcn_permlane16_swap(wq0.y, wq.y, false, false);
                                    *(u32x4*)(tq + wbase + roff) = (u32x4){sx[0], sy[0], sx[1], sy[1]}; }
                                const auto sx = __builtin_amdgcn_permlane16_swap(wk0.x, wk.x, false, false), sy = __builtin_amdgcn_permlane16_swap(wk0.y, wk.y, false, false);
                                *(u32x4*)(tk + wbase + roff) = (u32x4){sx[0], sy[0], sx[1], sy[1]}; } }
                        if (fr == 0) { f32x4 el;
#pragma unroll
                            for (int j = 0; j < 4; ++j) el[j] = hg ? run[j] : __builtin_amdgcn_exp2f(run[j]);
                            *(f32x4*)(EL + ((size_t)d * NCG + cg) * 768 + (hg ? 0 : 512) + ch) = el; }
                    }
                    if (hg) { unsigned char* const tv = WS + WS_RVA + (size_t)((b * 4 + h) * NSTEP + smem) * 16384;
#pragma unroll
                        for (int m = 0; m < 4; m += 2) { const u32x2 w0 = pack4(acc[ai][1][m][1] * scale), w1 = pack4(acc[ai][1][m + 1][1] * scale);
                            const auto sx = __builtin_amdgcn_permlane16_swap(w0.x, w1.x, false, false), sy = __builtin_amdgcn_permlane16_swap(w0.y, w1.y, false, false);
                            *(u32x4*)(tv + wbase + (16 * m + fr_) * 32) = (u32x4){sx[0], sy[0], sx[1], sy[1]}; } }
                } else {
#pragma unroll
                    for (int bj = 0; bj < 2; ++bj) { const int col = 256 * (t - 12) + 128 * bj + 32 * wc + 8 * fq, hv = col >> 7, c = col & 127;
                        unsigned char* const tv = WS + WS_RVB + (size_t)((b * 4 + hv) * NSTEP + smem) * 16384;
#pragma unroll
                        for (int m = 0; m < 4; ++m) *(u32x4*)(tv + (16 * m + fr_) * 256 + 2 * c) = pack8(acc[ai][bj][m][0] * scale, acc[ai][bj][m][1] * scale); }
                }
            }
        } else {
            bf16* zb = Z + (size_t)(pm * BM - TC) * NZ;
            int rb_ = wr * 64 + fr_;
            const int cb = (t < 16) ? ZC_OGA + (t - 14) * 256 : (t < 18) ? ZC_OGB + (t - 16) * 256 : ZC_MGA + (t - 18) * 256;
#pragma unroll
            for (int ai = 0; ai < 2; ++ai)
#pragma unroll
                for (int m = 0; m < 4; ++m) { bf16* zr = zb + (size_t)(ai * HALF + m * 16 + rb_) * NZ;
#pragma unroll
                    for (int bj = 0; bj < 2; ++bj) *(u32x4*)(zr + cb + bj * HALF + wc * 32 + 8 * fq) = pack8(acc[ai][bj][m][0] * scale, acc[ai][bj][m][1] * scale); }
        }
    }
};
struct EpiMerge {
    static constexpr bool MID = true; static constexpr int NSTORES = 16;
    const bf16* Zlat; bf16* out;
    __device__ __forceinline__ void mid(f32x4 (&acc)[2][2][4][2], const Unit& u, int wr, int wc, int fr, int fq) const {
        int rb_ = wr * 64 + fr; asm volatile("" : "+v"(rb_));
#pragma unroll
        for (int ai = 0; ai < 2; ++ai)
#pragma unroll
            for (int m = 0; m < 4; ++m) { const int row = u.pm * BM + ai * HALF + m * 16 + rb_;
#pragma unroll
                for (int bj = 0; bj < 2; ++bj) { const int col = u.pn * BM + bj * HALF + wc * 32 + 8 * fq;
                    const u32x4 aw = *(const u32x4*)(Zlat + (size_t)row * NZ + ZC_MGA + col), bw = *(const u32x4*)(Zlat + (size_t)row * NZ + ZC_MGB + col);
                    f32x4 a0, a1, b0, b1; unpack8(aw, a0, a1); unpack8(bw, b0, b1);
#pragma unroll
                    for (int j = 0; j < 4; ++j) { acc[ai][bj][m][0][j] *= (1.f + __expf(-b0[j])) * __builtin_amdgcn_rcpf(1.f + __expf(-a0[j]));
                                                  acc[ai][bj][m][1][j] *= (1.f + __expf(-b1[j])) * __builtin_amdgcn_rcpf(1.f + __expf(-a1[j])); } } }
    }
    __device__ __forceinline__ void operator()(const f32x4 (&acc)[2][2][4][2], const Unit& u, int wr, int wc, int fr, int fq) const {
        EPI_LOOP_BEGIN
            const u32x4 gw = *(const u32x4*)(Zlat + (size_t)row * NZ + ZC_MGB + col); f32x4 g0, g1; unpack8(gw, g0, g1);
#pragma unroll
            for (int j = 0; j < 4; ++j) { v0[j] *= sigmoidf_(g0[j]); v1[j] *= sigmoidf_(g1[j]); }
            *(u32x4*)(out + (size_t)row * D + col) = pack8(v0, v1);
        EPI_LOOP_END
    }
};
template <bool F8> __device__ __forceinline__ void store8(void* base, size_t idx, f32x4 v0, f32x4 v1) {
    if constexpr (F8) { u32x2 w; w.x = pk4_fp8(v0[0], v0[1], v0[2], v0[3]); w.y = pk4_fp8(v1[0], v1[1], v1[2], v1[3]); *(u32x2*)((unsigned char*)base + idx) = w; }
    else *(u32x4*)((bf16*)base + idx) = pack8(v0, v1);
}
template <bool F8> struct EpiStore {
    static constexpr int NSTORES = 16;
    void* out; int ldc; float scale;
    __device__ __forceinline__ void operator()(const f32x4 (&acc)[2][2][4][2], const Unit& u, int wr, int wc, int fr, int fq) const {
        EPI_LOOP_BEGIN
            store8<F8>(out, (size_t)row * ldc + col, v0 * scale, v1 * scale);
        EPI_LOOP_END
    }
};
struct EpiGateUp {
    static constexpr bool PRE = true; static constexpr int NSTORES = 8;
    bf16* H0; bf16* H1; const float* bg; const float* bu;
    __device__ __forceinline__ void pre(const Unit& u, LAS float* ec, int wc, int lane) const {
        glds4((lane < 32 ? bg : bu) + (size_t)u.e * FF + u.pn * HALF + wc * 32 + (lane & 31), ec); }
    __device__ __forceinline__ void operator()(const f32x4 (&acc)[2][2][4][2], const Unit& u, int wr, int wc, int fr, int fq, const LAS float* ec) const {
        const int ocol = u.pn * HALF + wc * 32 + 8 * fq;
        const f32x4 bg0 = *(const LAS f32x4*)(ec + 8 * fq), bg1 = *(const LAS f32x4*)(ec + 8 * fq + 4), bu0 = *(const LAS f32x4*)(ec + 32 + 8 * fq), bu1 = *(const LAS f32x4*)(ec + 32 + 8 * fq + 4);
        int rb_ = wr * 64 + fr; asm volatile("" : "+v"(rb_));
#pragma unroll
        for (int ai = 0; ai < 2; ++ai)
#pragma unroll
            for (int m = 0; m < 4; ++m) { const int row = u.pm * BM + ai * HALF + m * 16 + rb_;
                constexpr float ws = 1.f / MOE_WSCALE;
                f32x4 g0 = acc[ai][0][m][0] * ws + bg0, g1 = acc[ai][0][m][1] * ws + bg1, u0 = acc[ai][1][m][0] * ws + bu0, u1 = acc[ai][1][m][1] * ws + bu1, o0, o1;
#pragma unroll
                for (int j = 0; j < 4; ++j) { g0[j] = fminf(g0[j], 7.f); g1[j] = fminf(g1[j], 7.f); u0[j] = fminf(fmaxf(u0[j], -7.f), 7.f); u1[j] = fminf(fmaxf(u1[j], -7.f), 7.f); }
                f32x4 e0 = g0 * (-1.702f * 1.44269504f), e1 = g1 * (-1.702f * 1.44269504f);
#pragma unroll
                for (int j = 0; j < 4; ++j) { e0[j] = __builtin_amdgcn_exp2f(e0[j]); e1[j] = __builtin_amdgcn_exp2f(e1[j]); }
                e0 = e0 + 1.f; e1 = e1 + 1.f;
#pragma unroll
                for (int j = 0; j < 4; ++j) { e0[j] = __builtin_amdgcn_rcpf(e0[j]); e1[j] = __builtin_amdgcn_rcpf(e1[j]); }
                o0 = (g0 * e0) * (u0 + 1.f); o1 = (g1 * e1) * (u1 + 1.f);
                if constexpr (kMoeFp8) { unsigned char* hp = (row < H_SPLIT_TILES * BM) ? (unsigned char*)H0 + (size_t)row * FF : (unsigned char*)H1 + (size_t)(row - H_SPLIT_TILES * BM) * FF;
                    u32x2 w; w.x = pk4_fp8(o0[0], o0[1], o0[2], o0[3]); w.y = pk4_fp8(o1[0], o1[1], o1[2], o1[3]); *(u32x2*)(hp + ocol) = w; }
                else { bf16* hp = (row < H_SPLIT_TILES * BM) ? H0 + (size_t)row * FF : H1 + (size_t)(row - H_SPLIT_TILES * BM) * FF;
                    *(u32x4*)(hp + ocol) = pack8(o0, o1); } }
    }
};
struct EpiDown {
    static constexpr bool PRE = true; static constexpr int NSTORES = 8;
    bf16* Y; const float* bd;
    __device__ __forceinline__ void pre(const Unit& u, LAS float* ec, int wc, int lane) const {
        glds4(bd + (size_t)u.e * D + u.pn * BM + wc * 64 + lane, ec); }
    __device__ __forceinline__ void operator()(const f32x4 (&acc)[2][2][4][2], const Unit& u, int wr, int wc, int fr, int fq, const LAS float* ec) const {
        static_assert(kActFp8, "Y rows are fp8");
        f32x4 b0[2], b1[2];
#pragma unroll
        for (int bj = 0; bj < 2; ++bj) { b0[bj] = *(const LAS f32x4*)(ec + 16 * fq + 8 * bj); b1[bj] = *(const LAS f32x4*)(ec + 16 * fq + 8 * bj + 4); }
        int rb_ = wr * 64 + fr; asm volatile("" : "+v"(rb_));
        unsigned char* const yb = (unsigned char*)Y + u.pn * BM + wc * 64 + 16 * fq;
#pragma unroll
        for (int ai = 0; ai < 2; ++ai)
#pragma unroll
            for (int m = 0; m < 4; ++m) { const int row = u.pm * BM + ai * HALF + m * 16 + rb_; u32x4 o;
                { const f32x4 v0 = acc[ai][0][m][0] * (1.f / MOE_WSCALE) + b0[0], v1 = acc[ai][0][m][1] * (1.f / MOE_WSCALE) + b1[0]; o.x = pk4_fp8(v0[0], v0[1], v0[2], v0[3]); o.y = pk4_fp8(v1[0], v1[1], v1[2], v1[3]); }
                { const f32x4 v0 = acc[ai][1][m][0] * (1.f / MOE_WSCALE) + b0[1], v1 = acc[ai][1][m][1] * (1.f / MOE_WSCALE) + b1[1]; o.z = pk4_fp8(v0[0], v0[1], v0[2], v0[3]); o.w = pk4_fp8(v1[0], v1[1], v1[2], v1[3]); }
                *(u32x4*)(yb + (size_t)row * D) = o; }
    }
};
}

constexpr int RING_BYTES = 131072;
constexpr int LDSCTL_OFF = RING_BYTES;
constexpr int LDS_BYTES = 163840;
constexpr int MISC_OFF = LDS_BYTES - 128;

#define XB_TMO      128
#define XB_XCNT(j)  (256  + 64 * (j))
#define XB_XSUB(j)  (1280 + 64 * (j))
#define XB_XGEN(j)  (2304 + 64 * (j))
#define XB_TOP      3328
#define XB_TOPGEN   3392
#define XCD_BAR_WORDS 3456
#define XB_SPIN_CAP (1u << 22)
__device__ __forceinline__ unsigned xb_ld(unsigned* p)              { return __hip_atomic_load(p, __ATOMIC_RELAXED, __HIP_MEMORY_SCOPE_AGENT); }
__device__ __forceinline__ unsigned xb_add(unsigned* p, unsigned v) { return __hip_atomic_fetch_add(p, v, __ATOMIC_RELAXED, __HIP_MEMORY_SCOPE_AGENT); }
__device__ __forceinline__ unsigned xb_xcc_id() { return (unsigned)__builtin_amdgcn_s_getreg((3 << 11) | 20) & 0xFu; }
#define XB_SPIN(cond, bar) do { unsigned _sp = 0; while (cond) { __builtin_amdgcn_s_sleep(1); \
    if ((++_sp & 255u) == 0u) { if (xb_ld(&(bar)[XB_TMO])) break; if (_sp > XB_SPIN_CAP) { atomicAdd(&(bar)[XB_TMO], 1u); break; } } } } while (0)
struct XcdBarrier { unsigned* bar; unsigned x; volatile LAS unsigned* st; };
__device__ __forceinline__ XcdBarrier xcd_barrier_post(unsigned* bar, volatile LAS unsigned* st) {
    XcdBarrier b; b.bar = bar; b.x = xb_xcc_id(); b.st = st;
    if (threadIdx.x == 0) (void)xb_add(&bar[XB_XCNT(b.x)], 1u);
    return b;
}
__device__ __forceinline__ void xcd_barrier_complete(unsigned* bar, unsigned x, unsigned& nloc, unsigned& nx) {
    const unsigned G = gridDim.x * gridDim.y * gridDim.z;
    unsigned sum, cnt, mine, sp = 0u;
    for (;;) {
        sum = 0u; cnt = 0u; mine = 0u;
#pragma unroll
        for (unsigned j = 0; j < 16; ++j) { const unsigned c = xb_ld(&bar[XB_XCNT(j)]); sum += c; cnt += (c > 0u) ? 1u : 0u; mine = (j == x) ? c : mine; }
        if (sum == G) break;
        __builtin_amdgcn_s_sleep(1);
        if ((++sp & 255u) == 0u) { if (xb_ld(&bar[XB_TMO])) break; if (sp > XB_SPIN_CAP) { atomicAdd(&bar[XB_TMO], 1u); break; } }
    }
    nloc = mine > 0u ? mine : 1u; nx = cnt > 0u ? cnt : 1u;
}
__device__ __forceinline__ void xcd_barrier(const XcdBarrier& b) {
    asm volatile("s_waitcnt vmcnt(0)" ::: "memory");
    __syncthreads();
    if (threadIdx.x == 0) {
        unsigned* bar = b.bar;
        __builtin_amdgcn_s_waitcnt(0);
        unsigned nloc = b.st[0], nx = b.st[1];
        if (nloc == 0u) { xcd_barrier_complete(bar, b.x, nloc, nx); b.st[0] = nloc; b.st[1] = nx; }
        const unsigned old = xb_add(&bar[XB_XSUB(b.x)], 1u);
        const unsigned gen = old / nloc;
        if (old + 1u == (gen + 1u) * nloc) {
            __builtin_amdgcn_fence(__ATOMIC_RELEASE, "agent");
            asm volatile("s_waitcnt vmcnt(0)" ::: "memory");
            const unsigned og = xb_add(&bar[XB_TOP], 1u);
            const unsigned tg = og / nx;
            if (og + 1u == (tg + 1u) * nx) xb_add(&bar[XB_TOPGEN], 1u);
            else XB_SPIN(xb_ld(&bar[XB_TOPGEN]) == tg, bar);
            __builtin_amdgcn_fence(__ATOMIC_ACQUIRE, "agent");
            xb_add(&bar[XB_XGEN(b.x)], 1u);
            asm volatile("s_waitcnt vmcnt(0)" ::: "memory");
        } else {
            XB_SPIN(xb_ld(&bar[XB_XGEN(b.x)]) == gen, bar);
            __builtin_amdgcn_fence(__ATOMIC_ACQUIRE, "agent");
            asm volatile("s_waitcnt vmcnt(0)" ::: "memory");
        }
    }
    __syncthreads();
}

struct Args { const float* in[27]; float* out; unsigned char* ws; int ph_lo, ph_hi; };
enum { I_X = 0, I_C, I_CTX, I_CCTX, I_WADA, I_BADA, I_GPREMIX, I_GPOSTMIX, I_GPREFFN, I_GPOSTFFN, I_WIN, I_HLB, I_HNW, I_GKW2, I_GKB, I_GNW, I_WUPA, I_WUPB, I_WO, I_WR, I_BR, I_WG, I_BG, I_WU, I_BU, I_WDN, I_BDN };
struct Frame { LAS unsigned char* lds; int tid, lane, wave, vcu, G; const Args* a; };

__device__ __forceinline__ void transpose_item(const float* src, int ld, bf16* dst, int dpitch, LAS float* scr, int lane) {
    float tv[32];
#pragma unroll
    for (int i = 0; i < 32; ++i) tv[i] = __builtin_nontemporal_load(src + (size_t)(2 * i + (lane >> 5)) * ld + (lane & 31));
#pragma unroll
    for (int i = 0; i < 32; ++i) scr[(2 * i + (lane >> 5)) * 33 + (lane & 31)] = tv[i];
    LDS_WAIT(); asm volatile("" ::: "memory");
    const int c = lane & 7;
#pragma unroll
    for (int j = 0; j < 4; ++j) { const int n = (lane >> 3) + 8 * j; const LAS float* s = scr + (8 * c) * 33 + n;
        u32x4 o; o.x = pk2(s[0 * 33], s[1 * 33]); o.y = pk2(s[2 * 33], s[3 * 33]); o.z = pk2(s[4 * 33], s[5 * 33]); o.w = pk2(s[6 * 33], s[7 * 33]);
        *(u32x4*)(dst + (size_t)n * dpitch + 8 * c) = o; }
    LDS_WAIT(); asm volatile("" ::: "memory");
}

__device__ __forceinline__ void transpose_item_fp8(const float* src, int ld, unsigned char* dst, int dpitch, LAS float* scr, int lane, float sc) {
    float tv[32];
#pragma unroll
    for (int i = 0; i < 32; ++i) tv[i] = __builtin_nontemporal_load(src + (size_t)(2 * i + (lane >> 5)) * ld + (lane & 31));
#pragma unroll
    for (int i = 0; i < 32; ++i) scr[(2 * i + (lane >> 5)) * 33 + (lane & 31)] = tv[i];
    LDS_WAIT(); asm volatile("" ::: "memory");
    const int c = lane & 7;
#pragma unroll
    for (int j = 0; j < 4; ++j) { const int n = (lane >> 3) + 8 * j; const LAS float* s = scr + (8 * c) * 33 + n;
        u32x2 o; o.x = pk4_fp8(s[0 * 33] * sc, s[1 * 33] * sc, s[2 * 33] * sc, s[3 * 33] * sc); o.y = pk4_fp8(s[4 * 33] * sc, s[5 * 33] * sc, s[6 * 33] * sc, s[7 * 33] * sc);
        *(u32x2*)(dst + (size_t)n * dpitch + 8 * c) = o; }
    LDS_WAIT(); asm volatile("" ::: "memory");
}

__device__ __forceinline__ int inproj_src_col(int n) {
    const int t = n >> 8, rho = n & 255;
    if (t < 12) { const int a = 2 * (rho >> 7) + ((rho >> 2) & 1), cc = 16 * ((rho >> 5) & 3) + 4 * ((rho >> 3) & 3) + (rho & 3);
        if (t < 8) return a * 512 + (t >> 1) * 128 + (t & 1) * 64 + cc;
        const int h = t - 8; if (a == 0) return 2560 + h * 64 + cc; if (a == 1) return 2816 + h * 64 + cc; return -1 - ((a - 2) * 256 + h * 64 + cc); }
    if (t < 14) return 3072 + (n - 12 * 256);
    if (t < 16) return 2048 + (n - 14 * 256);
    return 3616 + (n - 16 * 256);
}
__device__ __forceinline__ void transpose_item_cols(const float* Wk, int ld, int col, bf16* dst, int dpitch, LAS float* scr, int lane) {
    float tv[32];
#pragma unroll
    for (int i = 0; i < 32; ++i) tv[i] = Wk[(size_t)(2 * i + (lane >> 5)) * ld + col];
#pragma unroll
    for (int i = 0; i < 32; ++i) scr[(2 * i + (lane >> 5)) * 33 + (lane & 31)] = tv[i];
    LDS_WAIT(); asm volatile("" ::: "memory");
    const int c = lane & 7;
#pragma unroll
    for (int j = 0; j < 4; ++j) { const int n = (lane >> 3) + 8 * j; const LAS float* s = scr + (8 * c) * 33 + n;
        u32x4 o; o.x = pk2(s[0 * 33], s[1 * 33]); o.y = pk2(s[2 * 33], s[3 * 33]); o.z = pk2(s[4 * 33], s[5 * 33]); o.w = pk2(s[6 * 33], s[7 * 33]);
        *(u32x4*)(dst + (size_t)n * dpitch + 8 * c) = o; }
    LDS_WAIT(); asm volatile("" ::: "memory");
}

__device__ __forceinline__ void p0_mod(const Frame& F, int item) {
    const Args& A = *F.a;
    LAS float* sc = (LAS float*)F.lds; LAS float* part = sc + 17 * 1024;
    const float* wp = A.in[I_WADA] + (size_t)(F.wave * 128) * 6144 + item * 64 + F.lane;
    float wv[32], wn[32];
#pragma unroll
    for (int i = 0; i < 32; ++i) wv[i] = wp[(size_t)i * 6144];
    for (int i = F.tid; i < 17 * 1024; i += NTHREADS) { const int r = i >> 10, k = i & 1023; const float v = (r < 16) ? A.in[I_C][r * 1024 + k] : A.in[I_CCTX][k]; sc[i] = v * sigmoidf_(v); }
    __syncthreads();
    const int k0 = F.wave * 128;
    float acc[17];
#pragma unroll
    for (int r = 0; r < 17; ++r) acc[r] = 0.f;
#pragma unroll
    for (int bq = 0; bq < 4; ++bq) {
        if (bq < 3) {
#pragma unroll
            for (int i = 0; i < 32; ++i) wn[i] = wp[(size_t)(32 * (bq + 1) + i) * 6144]; }
#pragma unroll
        for (int i4 = 0; i4 < 8; ++i4) { const int k = k0 + 32 * bq + 4 * i4;
#pragma unroll
            for (int r = 0; r < 17; ++r) { const f32x4 s = *(const LAS f32x4*)(sc + r * 1024 + k); acc[r] += s.x * wv[4 * i4] + s.y * wv[4 * i4 + 1] + s.z * wv[4 * i4 + 2] + s.w * wv[4 * i4 + 3]; } }
        if (bq < 3) {
#pragma unroll
            for (int i = 0; i < 32; ++i) wv[i] = wn[i]; }
    }
#pragma unroll
    for (int r = 0; r < 17; ++r) part[(F.wave * 17 + r) * 64 + F.lane] = acc[r];
    __syncthreads();
    float* mod = (float*)(A.ws + WS_MOD);
    for (int i = F.tid; i < 17 * 64; i += NTHREADS) { const int r = i >> 6, l = i & 63; float s = A.in[I_BADA][item * 64 + l];
#pragma unroll
        for (int w = 0; w < 8; ++w) s += part[(w * 17 + r) * 64 + l];
        mod[r * 6144 + item * 64 + l] = s; }
    __syncthreads();
}

__device__ __forceinline__ void p0_prologue(const Frame& F) {
    const Args& A = *F.a;
    if (F.vcu < 96) p0_mod(F, F.vcu);
    LAS float* scr = (LAS float*)(F.lds + F.wave * 16384);
    const int gw = F.vcu * NWAVES + F.wave, NGW = F.G * NWAVES;
    bf16* win_t = (bf16*)(A.ws + WS_WIN);
    constexpr int I_WIN_ITEMS = 16 * 208, I_WU = 8 * 32, I_WO_ITEMS = 16 * 32;
    for (int it = gw; it < I_WIN_ITEMS + 2 * I_WU + I_WO_ITEMS; it += NGW) {
        int r = it;
        if (r < I_WIN_ITEMS) { const int kb = r / 208, nb = r % 208, n0 = nb * 32;
            if (n0 < NT_HI * 256) { const int col = inproj_src_col(n0 + (F.lane & 31)); if (col < 0) continue;
                transpose_item_cols(A.in[I_WIN] + (size_t)(64 * kb) * IN_DIM, IN_DIM, col, win_t + (size_t)n0 * D + 64 * kb, D, scr, F.lane); }
            else { const int jl = n0 - NT_HI * 256; const float* sp = A.in[I_WIN] + (size_t)(64 * kb) * IN_DIM + (jl < 512 ? 2048 + jl : jl < 1024 ? 3616 + (jl - 512) : 4128 + (jl - 1024));
                if constexpr (kInFp8) transpose_item_fp8(sp, IN_DIM, (unsigned char*)(A.ws + WS_WIN_LO) + (size_t)(n0 - NT_HI * 256) * D + 64 * kb, D, scr, F.lane, IN_WSCALE);
                else transpose_item(sp, IN_DIM, (bf16*)(A.ws + WS_WIN_LO) + (size_t)(n0 - NT_HI * 256) * D + 64 * kb, D, scr, F.lane); }
            continue; }
        r -= I_WIN_ITEMS;
        if (r < I_WU) { const int kb = r / 32, nb = r % 32; transpose_item(A.in[I_WUPA] + (size_t)(64 * kb) * D + 32 * nb, D, (bf16*)(A.ws + WS_WUA) + (size_t)(32 * nb) * 1024 + 64 * kb, 1024, scr, F.lane); continue; }
        r -= I_WU;
        if (r < I_WU) { const int kb = r / 32, nb = r % 32; transpose_item(A.in[I_WUPB] + (size_t)(64 * kb) * D + 32 * nb, D, (bf16*)(A.ws + WS_WUA) + (size_t)(32 * nb) * 1024 + 512 + 64 * kb, 1024, scr, F.lane); continue; }
        r -= I_WU;
        { const int kb = r / 32, nb = r % 32; transpose_item(A.in[I_WO] + (size_t)(64 * kb) * D + 32 * nb, D, (bf16*)(A.ws + WS_WO) + (size_t)(32 * nb) * D + 64 * kb, D, scr, F.lane); }
    }
    const int gt = F.vcu * NTHREADS + F.tid, NGT = F.G * NTHREADS;
    for (int it = gt; it < 2 * 256 * 128; it += NGT) {
        const int k8 = it & 127, n = (it >> 7) & 255, dir = it >> 15;
        float w2[16];
#pragma unroll
        for (int r = 0; r < 16; ++r) w2[r] = A.in[I_GKW2][(dir * 16 + r) * 256 + n];
        float o[8];
#pragma unroll
        for (int kk = 0; kk < 8; ++kk) { const float* wr = A.in[I_WIN] + (size_t)(k8 * 8 + kk) * IN_DIM + 3584 + 16 * dir; float s = 0.f;
#pragma unroll
            for (int r4 = 0; r4 < 4; ++r4) { const f32x4 w = *(const f32x4*)(wr + 4 * r4); s += w.x * w2[4 * r4] + w.y * w2[4 * r4 + 1] + w.z * w2[4 * r4 + 2] + w.w * w2[4 * r4 + 3]; }
            o[kk] = s; }
        { u32x4 pk; pk.x = pk2(o[0], o[1]); pk.y = pk2(o[2], o[3]); pk.z = pk2(o[4], o[5]); pk.w = pk2(o[6], o[7]);
            const int cc = n & 63, rho = 128 + 32 * (cc >> 4) + 8 * ((cc >> 2) & 3) + 4 * dir + (cc & 3);
            *(u32x4*)(win_t + (size_t)(256 * (8 + (n >> 6)) + rho) * D + k8 * 8) = pk; }
    }
    bf16* wrb = (bf16*)(A.ws + WS_WRT);
    for (int it = gt; it < NE * D; it += NGT) { const int e = it >> 10, k = it & 1023; wrb[it] = (bf16)f2bf(A.in[I_WR][k * NE + e]); }
}

template <int WHICH> __device__ __forceinline__ void convert_expert_weights(const Frame& F) {
    static_assert(kMoeFp8, "fp8 expert weights");
    const Args& A = *F.a;
    LAS float* scr = (LAS float*)(F.lds + F.wave * 16384);
    const int gw = F.vcu * NWAVES + F.wave, NGW = F.G * NWAVES, lane = F.lane;
    constexpr int PER_E = WHICH == 0 ? 16 * 64 : 16 * 32, NIT = NE * PER_E;
    auto item = [&](int it, const float*& src, unsigned char*& dst) { const int e = it / PER_E, r = it % PER_E;
        if (WHICH == 0) { const int kb = r / 64, nb = r % 64, n0 = 32 * nb, pn = n0 >> 8, rr = n0 & 255;
            src = (rr < 128 ? A.in[I_WG] : A.in[I_WU]) + (size_t)e * D * FF + (size_t)(64 * kb) * FF + 128 * pn + (rr & 127);
            dst = A.ws + WS_WGU + (size_t)e * 2048 * D + (size_t)n0 * D + 64 * kb; }
        else { const int kb = r / 32, nb = r % 32; src = A.in[I_WDN] + (size_t)e * FF * D + (size_t)(64 * kb) * D + 32 * nb;
            dst = A.ws + WS_WD + (size_t)e * D * FF + (size_t)(32 * nb) * FF + 64 * kb; } };
    constexpr int ld = 1024;
    float tv[32], tn[32]; const float* src; unsigned char* dst; int it = gw;
    if (it < NIT) { item(it, src, dst);
#pragma unroll
        for (int i = 0; i < 32; ++i) tv[i] = __builtin_nontemporal_load(src + (size_t)(2 * i + (lane >> 5)) * ld + (lane & 31)); }
    while (it < NIT) {
        const int itn = it + NGW; const float* srcn = src; unsigned char* dstn = dst;
        if (itn < NIT) { item(itn, srcn, dstn);
#pragma unroll
            for (int i = 0; i < 32; ++i) tn[i] = __builtin_nontemporal_load(srcn + (size_t)(2 * i + (lane >> 5)) * ld + (lane & 31)); }
#pragma unroll
        for (int i = 0; i < 32; ++i) scr[(2 * i + (lane >> 5)) * 33 + (lane & 31)] = tv[i];
        LDS_WAIT(); asm volatile("" ::: "memory");
        { const int c = lane & 7;
#pragma unroll
          for (int j = 0; j < 4; ++j) { const int n = (lane >> 3) + 8 * j; const LAS float* s = scr + (8 * c) * 33 + n;
              u32x2 o; o.x = pk4_fp8(s[0 * 33] * MOE_WSCALE, s[1 * 33] * MOE_WSCALE, s[2 * 33] * MOE_WSCALE, s[3 * 33] * MOE_WSCALE);
              o.y = pk4_fp8(s[4 * 33] * MOE_WSCALE, s[5 * 33] * MOE_WSCALE, s[6 * 33] * MOE_WSCALE, s[7 * 33] * MOE_WSCALE);
              *(u32x2*)(dst + (size_t)n * D + 8 * c) = o; } }
        LDS_WAIT(); asm volatile("" ::: "memory");
        if (itn < NIT) {
#pragma unroll
            for (int i = 0; i < 32; ++i) tv[i] = tn[i]; }
        src = srcn; dst = dstn; it = itn;
    }
}

__device__ __forceinline__ void p1_prenorm(const Frame& F) {
    const Args& A = *F.a;
    const int gw = F.vcu * NWAVES + F.wave, NGW = F.G * NWAVES;
    const float* mod = (const float*)(A.ws + WS_MOD); bf16* hbf = (bf16*)(A.ws + WS_HBF);
    for (int m = gw; m < MALL; m += NGW) {
        const float* xr = (m < TC) ? A.in[I_CTX] + (size_t)m * D : A.in[I_X] + (size_t)(m - TC) * D;
        const float* md = mod + (size_t)((m < TC) ? 16 : (m - TC) / SEQ) * 6144;
        f32x4 v[4]; float ss = 0.f;
#pragma unroll
        for (int j = 0; j < 4; ++j) { v[j] = *((const f32x4*)xr + F.lane + 64 * j); ss += (v[j].x * v[j].x + v[j].y * v[j].y) + (v[j].z * v[j].z + v[j].w * v[j].w); }
        const float rstd = rsqrtf(wave_sum(ss) * (1.f / D) + EPS);
#pragma unroll
        for (int j = 0; j < 4; ++j) { const int k = 4 * (F.lane + 64 * j);
            const f32x4 g = *(const f32x4*)(A.in[I_GPREMIX] + k), sh = *(const f32x4*)(md + k), sc = *(const f32x4*)(md + 1024 + k);
            const f32x4 h = v[j] * rstd * g * (sc + 1.f) + sh;
            { u32x2 o; o.x = pk2(h.x, h.y); o.y = pk2(h.z, h.w); *((u32x2*)(hbf + (size_t)m * D) + F.lane + 64 * j) = o; }
            if (m >= TC) { if constexpr (kInFp8) *((unsigned*)((unsigned char*)A.out + (size_t)(m - TC) * D) + F.lane + 64 * j) = pk4_fp8(h.x, h.y, h.z, h.w);
                           else { u32x2 o; o.x = pk2(h.x, h.y); o.y = pk2(h.z, h.w); *((u32x2*)((bf16*)A.out + (size_t)(m - TC) * D) + F.lane + 64 * j) = o; } } }
    }
}

typedef short v4i16_t __attribute__((ext_vector_type(4)));
typedef short s16x4 __attribute__((ext_vector_type(4)));
__device__ __forceinline__ s16x4 lds_tr16(const LAS unsigned char* p) { return __builtin_bit_cast(s16x4, __builtin_amdgcn_ds_read_tr16_b64_v4i16((LAS v4i16_t*)p)); }
#define LBAR() do { asm volatile("s_waitcnt lgkmcnt(0)" ::: "memory"); __builtin_amdgcn_s_barrier(); asm volatile("" ::: "memory"); } while (0)

template <int DK, bool HGRN> __device__ __forceinline__ void scan_chain(const Frame& F, LAS unsigned char* L, int hv, int wl, int tl, bf16* obase) {
    const Args& A = *F.a;
    const float* ELg = (const float*)(A.ws + WS_EL);
    const int b = hv >> 3, h = (hv >> 1) & 3, dir = hv & 1;
    const int lane = tl & 63, l15 = lane & 15, g = lane >> 4;
    constexpr int PQ = DK * 2 + 16;
    constexpr int PV = 272;
    constexpr int PP = 144;
    constexpr int NCH = DK / 8;
    constexpr int NLD = DK / 64;
    constexpr int KS = DK / 32;
    LAS unsigned char* RQ = L;
    LAS unsigned char* RK = RQ + 64 * PQ;
    LAS unsigned char* VI = RK + 64 * PQ;
    LAS unsigned char* PI = VI + 64 * PV;
    constexpr int TSZ = 64 * DK * 2;
    const unsigned char* const qk0 = A.ws + (HGRN ? WS_RQA : WS_RQB) + (size_t)hv * NSTEP * 2 * TSZ;
    const unsigned char* const v0 = A.ws + (HGRN ? WS_RVA : WS_RVB) + (size_t)(hv >> 1) * NSTEP * 16384;
    const float* elp = ELg + (size_t)dir * NCG * 768 + (HGRN ? 0 : 512) + h * DK;
    f32x4 S[DK / 16];
#pragma unroll
    for (int i = 0; i < DK / 16; ++i) S[i] = (f32x4){0.f, 0.f, 0.f, 0.f};
    u32x4 rq[2][NLD], rk[2][NLD], rv[2][2], rel[2];
    LAS unsigned char* ELs = PI + 64 * PP;
#define SCAN_ISSUE(set, s_) do { const int s__ = (s_); const unsigned char* qt = qk0 + (size_t)s__ * 2 * TSZ; \
        _Pragma("unroll") for (int q = 0; q < NLD; ++q) { const int ci = tl + 512 * q; \
            if (s__ >= 4) rq[set][q] = *(const u32x4*)(qt + 16 * ci); \
            rk[set][q] = *(const u32x4*)(qt + TSZ + 16 * ci); } \
        { const int sm = dir ? (s__ < 4 ? 3 - s__ : 39 - s__) : s__; const unsigned char* vt = v0 + (size_t)sm * 16384; \
          _Pragma("unroll") for (int q = 0; q < 2; ++q) rv[set][q] = *(const u32x4*)(vt + 16 * (tl + 512 * q)); } \
        { const int mc = (s__ < 4) ? (dir ? 3 - s__ : s__) : (dir ? 35 - s__ : s__ - 4), cg = (s__ < 4) ? 4 * b + mc : TC / 64 + 32 * b + mc; \
          if (tl < DK / 4) rel[set] = *(const u32x4*)(elp + (size_t)cg * 768 + 4 * tl); } } while (0)
    SCAN_ISSUE(0, 0); SCAN_ISSUE(1, 1);
#pragma nounroll
    for (int s2 = 0; s2 < 36; s2 += 2) {
#pragma unroll
      for (int par = 0; par < 2; ++par) {
        const int s = s2 + par;
        const bool lat = s >= 4;
#pragma unroll
        for (int q = 0; q < NLD; ++q) { const int ci = tl + 512 * q, h2 = ci >> 9, wcc = (ci >> 7) & 3, t = (ci >> 1) & 63, hf = ci & 1;
            if (lat) { LAS unsigned char* qd = RQ + t * PQ + 64 * (2 * h2 + (wcc >> 1)) + 32 * hf + 8 * (wcc & 1);
                *(LAS u32x2*)qd = (u32x2){rq[par][q].x, rq[par][q].y}; *(LAS u32x2*)(qd + 16) = (u32x2){rq[par][q].z, rq[par][q].w}; }
            *(LAS u32x4*)(RK + t * PQ + 2 * (64 * h2 + 16 * wcc + 8 * hf)) = rk[par][q]; }
#pragma unroll
        for (int q = 0; q < 2; ++q) { const int ci = tl + 512 * q;
            if constexpr (HGRN) { const int h2 = ci >> 9, wcc = (ci >> 7) & 3, tm = (ci >> 1) & 63, hf = ci & 1, t = dir ? 63 - tm : tm; *(LAS u32x4*)(VI + t * PV + 2 * (64 * h2 + 16 * wcc + 8 * hf)) = rv[par][q]; }
            else { const int tm = ci >> 4, t = dir ? 63 - tm : tm, cc = ci & 15; *(LAS u32x4*)(VI + t * PV + 16 * cc) = rv[par][q]; } }
        if (tl < DK / 4) *(LAS u32x4*)(ELs + 16 * tl) = rel[par];
        LBAR();
        if (s + 2 < 36) SCAN_ISSUE(par, s + 2);
        bf16x8 Vf[2];
#pragma unroll
        for (int ks2 = 0; ks2 < 2; ++ks2) { const int q = l15 >> 2, p = l15 & 3;
            const s16x4 lo = lds_tr16(VI + (32 * ks2 + 8 * g + q) * PV + 32 * wl + 8 * p), hi = lds_tr16(VI + (32 * ks2 + 8 * g + 4 + q) * PV + 32 * wl + 8 * p);
            Vf[ks2] = (bf16x8){lo[0], lo[1], lo[2], lo[3], hi[0], hi[1], hi[2], hi[3]}; }
        if (lat) {
            const int ib = (0x12333210 >> (4 * wl)) & 15, jlo = (0x00102110 >> (4 * wl)) & 15, jhi = (0x00103210 >> (4 * wl)) & 15;
            bf16x8 Bq[KS];
#pragma unroll
            for (int ks = 0; ks < KS; ++ks) Bq[ks] = *(const LAS bf16x8*)(RQ + (16 * ib + l15) * PQ + 64 * ks + 16 * g);
#pragma unroll
            for (int jt = 0; jt < 4; ++jt) { if (jt >= jlo && jt <= jhi) {
                f32x4 acc = (f32x4){0.f, 0.f, 0.f, 0.f};
#pragma unroll
                for (int ks = 0; ks < KS; ++ks) { const LAS unsigned char* kp = RK + (16 * jt + l15) * PQ + 64 * ks + 8 * g;
                    const s16x4 lo = *(const LAS s16x4*)kp, hi = *(const LAS s16x4*)(kp + 32);
                    const bf16x8 Ak = (bf16x8){lo[0], lo[1], lo[2], lo[3], hi[0], hi[1], hi[2], hi[3]};
                    acc = __builtin_amdgcn_mfma_f32_16x16x32_bf16(Ak, Bq[ks], acc, 0, 0, 0); }
                if (jt == ib) {
#pragma unroll
                    for (int r = 0; r < 4; ++r) if (4 * g + r > l15) acc[r] = 0.f; }
                u32x2 w; w.x = pk2(acc[0], acc[1]); w.y = pk2(acc[2], acc[3]);
                *(LAS u32x2*)(PI + (16 * ib + l15) * PP + 32 * jt + 8 * g) = w; } }
            if (wl == 0 || wl == 2) *(LAS u32x2*)(PI + (16 * wl + l15) * PP + 32 * (wl + 1) + 8 * g) = (u32x2){0u, 0u};
            LBAR();
            bf16x8 Sb[KS];
#pragma unroll
            for (int ks = 0; ks < KS; ++ks) { const f32x4 a = S[2 * ks], c = S[2 * ks + 1]; u32x4 w; w.x = pk2(a[0], a[1]); w.y = pk2(a[2], a[3]); w.z = pk2(c[0], c[1]); w.w = pk2(c[2], c[3]); Sb[ks] = __builtin_bit_cast(bf16x8, w); }
#pragma unroll
            for (int it = 0; it < 4; ++it) {
                f32x4 acc = (f32x4){0.f, 0.f, 0.f, 0.f};
                { const bf16x8 Pf = *(const LAS bf16x8*)(PI + (16 * it + l15) * PP + 16 * g); acc = __builtin_amdgcn_mfma_f32_16x16x32_bf16(Vf[0], Pf, acc, 0, 0, 0); }
                if (it >= 2) { const bf16x8 Pf = *(const LAS bf16x8*)(PI + (16 * it + l15) * PP + 64 + 16 * g); acc = __builtin_amdgcn_mfma_f32_16x16x32_bf16(Vf[1], Pf, acc, 0, 0, 0); }
#pragma unroll
                for (int ks = 0; ks < KS; ++ks) { const bf16x8 Bi = *(const LAS bf16x8*)(RQ + (16 * it + l15) * PQ + 64 * ks + 16 * g); acc = __builtin_amdgcn_mfma_f32_16x16x32_bf16(Sb[ks], Bi, acc, 0, 0, 0); }
                const int p = 64 * (s - 4) + 16 * it + l15, tok = dir ? SEQ - 1 - p : p;
                u32x2 w; w.x = pk2(acc[0], acc[1]); w.y = pk2(acc[2], acc[3]);
                *(u32x2*)(obase + ((size_t)dir * T + (size_t)b * SEQ + tok) * 512 + h * 128 + 16 * wl + 4 * g) = w;
            }
        }
#pragma unroll
        for (int dt = 0; dt < DK / 16; ++dt) {
#pragma unroll
            for (int ks2 = 0; ks2 < 2; ++ks2) { const int q = l15 >> 2, p = l15 & 3;
                const s16x4 lo = lds_tr16(RK + (32 * ks2 + 8 * g + q) * PQ + 32 * dt + 8 * p), hi = lds_tr16(RK + (32 * ks2 + 8 * g + 4 + q) * PQ + 32 * dt + 8 * p);
                const bf16x8 Kf = (bf16x8){lo[0], lo[1], lo[2], lo[3], hi[0], hi[1], hi[2], hi[3]};
                S[dt] = __builtin_amdgcn_mfma_f32_16x16x32_bf16(Kf, Vf[ks2], S[dt], 0, 0, 0); }
            S[dt] = S[dt] * *(const LAS f32x4*)(ELs + (16 * dt + 4 * g) * 4);
        }
        LBAR();
      }
    }
#undef SCAN_ISSUE
}

__device__ __forceinline__ void p4_readout(const Frame& F) {
    const Args& A = *F.a;
    const int gw = F.vcu * NWAVES + F.wave, NGW = F.G * NWAVES;
    const bf16* Z = (const bf16*)(A.ws + WS_Z); const bf16* O = (const bf16*)A.out;
    for (int it = gw; it < 2 * T; it += NGW) {
        const int br = it & 1, tok = it >> 1;
        const bf16* of = O + ((size_t)(br * 2 + 0) * T + tok) * 512 + 8 * F.lane; const bf16* ob = O + ((size_t)(br * 2 + 1) * T + tok) * 512 + 8 * F.lane;
        const u32x4 wf = *(const u32x4*)of, wb = *(const u32x4*)ob, wg = *(const u32x4*)(Z + (size_t)tok * NZ + (br ? ZC_OGB : ZC_OGA) + 8 * F.lane);
        f32x4 a0, a1, b0, b1, g0, g1; pg8::unpack8(wf, a0, a1); pg8::unpack8(wb, b0, b1); pg8::unpack8(wg, g0, g1);
        a0 += b0; a1 += b1;
        float ss = (a0.x * a0.x + a0.y * a0.y) + (a0.z * a0.z + a0.w * a0.w) + (a1.x * a1.x + a1.y * a1.y) + (a1.z * a1.z + a1.w * a1.w);
        ss += __shfl_xor(ss, 1); ss += __shfl_xor(ss, 2); ss += __shfl_xor(ss, 4); ss += __shfl_xor(ss, 8);
        const float rstd = rsqrtf(ss * (1.f / 128.f) + EPS);
        const float* nw = (br ? A.in[I_GNW] : A.in[I_HNW]) + (8 * F.lane & 127);
        const f32x4 n0 = *(const f32x4*)nw, n1 = *(const f32x4*)(nw + 4);
#pragma unroll
        for (int j = 0; j < 4; ++j) { a0[j] = a0[j] * rstd * n0[j] * (g0[j] * sigmoidf_(g0[j])); a1[j] = a1[j] * rstd * n1[j] * (g1[j] * sigmoidf_(g1[j])); }
        bf16* r = (bf16*)(A.ws + WS_RA) + (size_t)tok * 1024 + br * 512 + 8 * F.lane;
        *(u32x4*)r = pg8::pack8(a0, a1);
    }
}

__device__ __forceinline__ void load_row_bf16(const bf16* p, int lane, f32x4 (&v)[4]) {
#pragma unroll
    for (int j = 0; j < 4; ++j) { const u32x2 w = *((const u32x2*)p + lane + 64 * j); v[j] = (f32x4){bflo(w.x), bfhi(w.x), bflo(w.y), bfhi(w.y)}; }
}
__device__ __forceinline__ void load_row_fp8(const unsigned char* p, int lane, f32x4 (&v)[4]) {
#pragma unroll
    for (int j = 0; j < 4; ++j) { const int w = *((const int*)p + lane + 64 * j); const f32x2 a = __builtin_amdgcn_cvt_pk_f32_fp8(w, false), b = __builtin_amdgcn_cvt_pk_f32_fp8(w, true); v[j] = (f32x4){a.x, a.y, b.x, b.y}; }
}
template <bool F8> __device__ __forceinline__ void load_row_act(const void* base, size_t row, int lane, f32x4 (&v)[4]) {
    if constexpr (F8) load_row_fp8((const unsigned char*)base + row * D, lane, v); else load_row_bf16((const bf16*)base + row * D, lane, v);
}
__device__ __forceinline__ float sumsq4(const f32x4 (&v)[4]) { float s = 0.f;
#pragma unroll
    for (int j = 0; j < 4; ++j) s += (v[j].x * v[j].x + v[j].y * v[j].y) + (v[j].z * v[j].z + v[j].w * v[j].w);
    return s; }
__device__ __forceinline__ void compute_x1(const Args& A, int tok, int lane, const float* md, f32x4 (&x1)[4]) {
    f32x4 mx[4]; load_row_act<kMixFp8>(A.ws + WS_MIXB, (size_t)tok, lane, mx);
    const float rstd = rsqrtf(wave_sum(sumsq4(mx)) * (1.f / D) + EPS);
#pragma unroll
    for (int j = 0; j < 4; ++j) { const int k = 4 * (lane + 64 * j);
        const f32x4 xv = *(const f32x4*)(A.in[I_X] + (size_t)tok * D + k), g = *(const f32x4*)(A.in[I_GPOSTMIX] + k), gt = *(const f32x4*)(md + 2048 + k);
        x1[j] = xv + gt * (mx[j] * rstd * g); }
}

__device__ __forceinline__ void p8_router(const Frame& F) {
    const Args& A = *F.a;
    constexpr int WP = 2064;
    LAS unsigned char* WL = F.lds;
    LAS unsigned char* HB = WL + 32 * WP;
    LAS float* LG = (LAS float*)(HB + 16 * WP);
    int* hist = (int*)((unsigned char*)F.lds + 32 * WP + 16 * WP + 16 * 33 * 4);
    const u32x4* wrb = (const u32x4*)(A.ws + WS_WRT);
#pragma unroll
    for (int q = 0; q < 8; ++q) { const int i = F.tid + NTHREADS * q; *(LAS u32x4*)(WL + (i >> 7) * WP + 16 * (i & 127)) = wrb[i]; }
    if (F.tid < NE) hist[F.tid] = 0;
    __syncthreads();
    const float* mod = (const float*)(A.ws + WS_MOD); unsigned char* h2b = (unsigned char*)(A.ws + WS_H2);
    int* topi = (int*)(A.ws + WS_TOPI); float* topp = (float*)(A.ws + WS_TOPP); int* lrank = (int*)(A.ws + WS_LRANK);
    static_assert(kMoeFp8, "the router phase writes fp8 h2 rows");
    if (F.vcu == 0 && F.wave == 0) {
#pragma unroll
        for (int j = 0; j < 4; ++j) *((unsigned*)(h2b + (size_t)T * D) + F.lane + 64 * j) = 0u; }
    const int l15 = F.lane & 15, g = F.lane >> 4;
    for (int r = 0; r < 8; ++r) {
        const int base = 128 * F.vcu + 16 * r;
#pragma unroll
        for (int q = 0; q < 2; ++q) { const int row = 2 * F.wave + q, tok = base + row; const float* md = mod + (size_t)(tok / SEQ) * 6144;
            f32x4 x1[4]; compute_x1(A, tok, F.lane, md, x1);
            const float rstd = rsqrtf(wave_sum(sumsq4(x1)) * (1.f / D) + EPS);
#pragma unroll
            for (int j = 0; j < 4; ++j) { const int k = 4 * (F.lane + 64 * j);
                { u32x2 o; o.x = pk2(x1[j].x, x1[j].y); o.y = pk2(x1[j].z, x1[j].w); *((u32x2*)((bf16*)(A.ws + WS_X1B) + (size_t)tok * D) + F.lane + 64 * j) = o; }
                const f32x4 gg = *(const f32x4*)(A.in[I_GPREFFN] + k), sh = *(const f32x4*)(md + 3072 + k), sc = *(const f32x4*)(md + 4096 + k);
                const f32x4 h = x1[j] * rstd * gg * (sc + 1.f) + sh;
                *((unsigned*)(h2b + (size_t)tok * D) + F.lane + 64 * j) = pk4_fp8(h.x, h.y, h.z, h.w);
                u32x2 o; o.x = pk2(h.x, h.y); o.y = pk2(h.z, h.w); *(LAS u32x2*)(HB + row * WP + 8 * (F.lane + 64 * j)) = o; } }
        LBAR();
        if (F.wave < 2) { const int n = F.wave; f32x4 acc = (f32x4){0.f, 0.f, 0.f, 0.f};
#pragma unroll 8
            for (int ks = 0; ks < 32; ++ks) { const bf16x8 a = *(const LAS bf16x8*)(HB + l15 * WP + 64 * ks + 16 * g), bb = *(const LAS bf16x8*)(WL + (16 * n + l15) * WP + 64 * ks + 16 * g);
                acc = __builtin_amdgcn_mfma_f32_16x16x32_bf16(a, bb, acc, 0, 0, 0); }
            const float bias = A.in[I_BR][16 * n + l15];
#pragma unroll
            for (int rr = 0; rr < 4; ++rr) LG[(4 * g + rr) * 33 + 16 * n + l15] = acc[rr] + bias; }
        LBAR();
        if (F.wave == 2 && F.lane < 16) { const int tok = base + F.lane;
            float v0 = -INFINITY, v1 = -INFINITY, v2 = -INFINITY, v3 = -INFINITY; int i0 = 0, i1 = 0, i2 = 0, i3 = 0;
#pragma unroll 8
            for (int e = 0; e < NE; ++e) { const float x = LG[F.lane * 33 + e]; const bool c0 = x > v0, c1 = x > v1, c2 = x > v2, c3 = x > v3;
                v3 = c3 ? (c2 ? v2 : x) : v3; i3 = c3 ? (c2 ? i2 : e) : i3; v2 = c2 ? (c1 ? v1 : x) : v2; i2 = c2 ? (c1 ? i1 : e) : i2;
                v1 = c1 ? (c0 ? v0 : x) : v1; i1 = c1 ? (c0 ? i0 : e) : i1; v0 = c0 ? x : v0; i0 = c0 ? e : i0; }
            const float e1 = __expf(v1 - v0), e2 = __expf(v2 - v0), e3 = __expf(v3 - v0), inv = 1.f / (1.f + e1 + e2 + e3);
            *(i32x4*)(topi + tok * 4) = (i32x4){i0, i1, i2, i3}; *(f32x4*)(topp + tok * 4) = (f32x4){inv, e1 * inv, e2 * inv, e3 * inv};
            i32x4 lr; lr.x = __hip_atomic_fetch_add(hist + i0, 1, __ATOMIC_RELAXED, __HIP_MEMORY_SCOPE_WORKGROUP); lr.y = __hip_atomic_fetch_add(hist + i1, 1, __ATOMIC_RELAXED, __HIP_MEMORY_SCOPE_WORKGROUP);
            lr.z = __hip_atomic_fetch_add(hist + i2, 1, __ATOMIC_RELAXED, __HIP_MEMORY_SCOPE_WORKGROUP); lr.w = __hip_atomic_fetch_add(hist + i3, 1, __ATOMIC_RELAXED, __HIP_MEMORY_SCOPE_WORKGROUP);
            *(i32x4*)(lrank + tok * 4) = lr; }
    }
    __syncthreads();
    if (F.tid < NE) { unsigned* gc = (unsigned*)(A.ws + WS_CTL) + CW_GCOUNT; const int basec = (int)__hip_atomic_fetch_add(gc + F.tid, (unsigned)hist[F.tid], RLX_AGENT);
        ((int*)(A.ws + WS_BLKBASE))[F.vcu * NE + F.tid] = basec; }
    __syncthreads();
}

__device__ __forceinline__ void p9_slots(const Frame& F) {
    const Args& A = *F.a;
    int* ps = (int*)((unsigned char*)F.lds); int* cn = ps + 64;
    const unsigned* gc = (const unsigned*)(A.ws + WS_CTL) + CW_GCOUNT;
    if (F.tid < NE) cn[F.tid] = (int)__hip_atomic_load(gc + F.tid, RLX_AGENT);
    __syncthreads();
    if (F.tid == 0) { int acc = 0; for (int e = 0; e < NE; ++e) { ps[e] = acc; acc += (cn[e] + 255) & ~255; } ps[NE] = acc; }
    __syncthreads();
    const int* topi = (const int*)(A.ws + WS_TOPI); const int* lrank = (const int*)(A.ws + WS_LRANK); const int* blkbase = (const int*)(A.ws + WS_BLKBASE);
    int* pslot = (int*)(A.ws + WS_PSLOT); int* tokslot = (int*)(A.ws + WS_TOKSLOT);
    for (int p = F.vcu * NTHREADS + F.tid; p < T * TOPK; p += F.G * NTHREADS) {
        const int tok = p >> 2, e = topi[p], slot = ps[e] + blkbase[(tok >> 7) * NE + e] + lrank[p];
        tokslot[slot] = tok; pslot[p] = slot; }
    if (F.vcu < NE) { const int e = F.vcu, pad = ((cn[e] + 255) & ~255); for (int i = cn[e] + F.tid; i < pad; i += NTHREADS) tokslot[ps[e] + i] = T; }
    if (F.vcu == NE) { const int ntile = ps[NE] >> 8; int* tile_e = (int*)(A.ws + WS_TILEE);
        for (int t = F.tid; t < MAXTILES; t += NTHREADS) { int e = 0; for (int q = 0; q < NE; ++q) if (t * 256 >= ps[q]) e = q; tile_e[t] = (t < ntile) ? e : 0; }
        if (F.tid == 0) ((int*)(A.ws + WS_CTL))[CW_NT] = ntile; }
    __syncthreads();
}

__device__ __forceinline__ void p12_final(const Frame& F) {
    const Args& A = *F.a;
    const int gw = F.vcu * NWAVES + F.wave, NGW = F.G * NWAVES;
    const float* mod = (const float*)(A.ws + WS_MOD); const bf16* Y = (const bf16*)(A.ws + WS_Y);
    const int* pslot = (const int*)(A.ws + WS_PSLOT); const float* topp = (const float*)(A.ws + WS_TOPP);
    constexpr int NTK = 4;
    for (int tok0 = gw; tok0 < T; tok0 += NTK * NGW) {
        int tok[NTK]; i32x4 sl[NTK]; f32x4 pw[NTK];
#pragma unroll
        for (int q = 0; q < NTK; ++q) { tok[q] = tok0 + q * NGW; sl[q] = *(const i32x4*)(pslot + tok[q] * 4); pw[q] = *(const f32x4*)(topp + tok[q] * 4); }
        f32x4 x1[NTK][4], f[NTK][4];
#pragma unroll
        for (int q = 0; q < NTK; ++q) { load_row_bf16((const bf16*)(A.ws + WS_X1B) + (size_t)tok[q] * D, F.lane, x1[q]);
#pragma unroll
            for (int j = 0; j < 4; ++j) f[q][j] = (f32x4){0.f, 0.f, 0.f, 0.f};
#pragma unroll
            for (int k = 0; k < 4; ++k) { f32x4 y[4]; load_row_act<kActFp8>(Y, (size_t)sl[q][k], F.lane, y);
#pragma unroll
                for (int j = 0; j < 4; ++j) f[q][j] += y[j] * pw[q][k]; } }
#pragma unroll
        for (int q = 0; q < NTK; ++q) { const float* md = mod + (size_t)(tok[q] / SEQ) * 6144;
            const float rstd = rsqrtf(wave_sum(sumsq4(f[q])) * (1.f / D) + EPS);
#pragma unroll
            for (int j = 0; j < 4; ++j) { const int k = 4 * (F.lane + 64 * j);
                const f32x4 g = *(const f32x4*)(A.in[I_GPOSTFFN] + k), gt = *(const f32x4*)(md + 5120 + k);
                *(f32x4*)(A.out + (size_t)tok[q] * D + k) = x1[q][j] + gt * (f[q][j] * rstd * g); } }
    }
}

constexpr int NPHASES = 12;
__global__ void __launch_bounds__(NTHREADS, 2) fwd_kernel(Args args) {
    extern __shared__ __attribute__((aligned(16))) unsigned char lds_raw[];
    Frame F; F.lds = (LAS unsigned char*)lds_raw; F.tid = threadIdx.x; F.lane = F.tid & 63; F.wave = __builtin_amdgcn_readfirstlane(F.tid >> 6);
    F.G = gridDim.x; { const int bx = blockIdx.x; F.vcu = (F.G % 8 == 0) ? (bx % 8) * (F.G / 8) + bx / 8 : bx; } F.a = &args;
    volatile LAS unsigned* MISC = (volatile LAS unsigned*)(F.lds + MISC_OFF);
    for (int u = F.tid; u < (LDS_BYTES - LDSCTL_OFF) / 4; u += NTHREADS) ((LAS unsigned*)(F.lds + LDSCTL_OFF))[u] = 0u;
    __syncthreads();
    unsigned char* ws = args.ws;
    unsigned* ctl = (unsigned*)(ws + WS_CTL);
    const int lo = args.ph_lo, hi = args.ph_hi;
    XcdBarrier bar; bar.bar = ctl + CW_BAR; bar.x = 0; bar.st = nullptr;
    if (hi - lo > 1) bar = xcd_barrier_post(ctl + CW_BAR, MISC + 8);
#define IN(k) (lo <= (k) && (k) < hi)
#define SEAM(k) do { if (IN(k) && IN((k) + 1)) xcd_barrier(bar); } while (0)
    const int bx = (int)blockIdx.x;

    if (IN(0)) { p0_prologue(F); } SEAM(0);
    if (IN(1)) { p1_prenorm(F); } SEAM(1);
    if (IN(2)) {
        const int nfirst = F.vcu & 3;
#pragma nounroll
        for (int pass = 0; pass < 3; ++pass) {
            if (pass == 1) { pg8::InprojOrder S{F.G, bx, (const char*)(ws + WS_HBF), (const char*)(ws + WS_WIN), (size_t)256 * 2048, (size_t)256 * 2048};
                pg8::EpiInproj E{(bf16*)(ws + WS_Z), ws, (float*)(ws + WS_EL), args.in[I_GKB], args.in[I_HLB], 0, 0, 1.f};
                pg8::gemm_phase<pg8::EpiInproj, pg8::InprojOrder, 0, true, false>(F.lds, 2048, S, E, nullptr, nullptr, S.A, S.B); }
            else { pg8::DenseOrder S; S.init(T, NT_LO * 256, IN_KB, F.G, bx, args.out, ws + WS_WIN_LO);
                if (pass == 0) S.hi = nfirst; else S.lo = nfirst;
                pg8::EpiInproj E{(bf16*)(ws + WS_Z), ws, (float*)(ws + WS_EL), args.in[I_GKB], args.in[I_HLB], TC / 256, NT_HI, 1.f / IN_WSCALE};
                pg8::gemm_phase<pg8::EpiInproj, pg8::DenseOrder, kInFp8 ? 2 : 0, true, kInFp8>(F.lds, IN_KB, S, E, nullptr, (const char*)args.out, S.A, S.B); }
        }
    } SEAM(2);
    if (IN(3)) {
        if (F.vcu < 128) scan_chain<128, true>(F, F.lds, F.vcu, F.wave, F.tid, (bf16*)args.out);
        else scan_chain<64, false>(F, F.lds, F.vcu - 128, F.wave, F.tid, (bf16*)args.out + (size_t)2 * T * 512);
    } SEAM(3);
    if (IN(4)) { p4_readout(F); } SEAM(4);
    if (IN(5)) {
        pg8::DenseOrder S; S.init(T, D, 2048, F.G, bx, ws + WS_RA, ws + WS_WUA);
        pg8::EpiMerge E{(const bf16*)(ws + WS_Z), (bf16*)args.out};
        pg8::gemm_phase<pg8::EpiMerge, pg8::DenseOrder, 0, true, false>(F.lds, 2048, S, E, nullptr, nullptr, S.A, S.B);
    } SEAM(5);
    if (IN(6)) {
        pg8::DenseOrder S; S.init(T, D, D * 2, F.G, bx, (const bf16*)args.out, ws + WS_WO);
        pg8::EpiStore<kMixFp8> E{(void*)(ws + WS_MIXB), D, 1.f};
        const bool conv_first = (F.vcu & 1) != 0;
        if (conv_first) { convert_expert_weights<0>(F); __syncthreads(); }
        pg8::gemm_phase<pg8::EpiStore<kMixFp8>, pg8::DenseOrder, 0, true, false>(F.lds, D * 2, S, E, nullptr, nullptr, S.A, S.B);
        if (!conv_first) { __syncthreads(); convert_expert_weights<0>(F); }
    } SEAM(6);
    if (IN(7)) { p8_router(F); } SEAM(7);
    if (IN(8)) { p9_slots(F); } SEAM(8);
    if (IN(9)) {
        const int ntile = __builtin_amdgcn_readfirstlane(((const int*)ctl)[CW_NT]);
        pg8::MoeOrder S{ntile, 8, F.G, bx, (const int*)(ws + WS_TILEE), (const char*)(ws + WS_WGU), (size_t)2048 * MOE_KB, (size_t)256 * MOE_KB, nullptr, nullptr, 0};
        pg8::EpiGateUp E{(bf16*)args.out, (bf16*)(ws + WS_HREST), args.in[I_BG], args.in[I_BU]};
        const bool conv_first = (F.vcu & 1) != 0;
        if (conv_first) { convert_expert_weights<1>(F); __syncthreads(); }
        pg8::gemm_phase<pg8::EpiGateUp, pg8::MoeOrder, 1, true, kMoeFp8>(F.lds, MOE_KB, S, E, (const int*)(ws + WS_TOKSLOT), (const char*)(ws + WS_H2), nullptr, S.B);
        if (!conv_first) { __syncthreads(); convert_expert_weights<1>(F); }
    } SEAM(9);
    if (IN(10)) {
        const int ntile = __builtin_amdgcn_readfirstlane(((const int*)ctl)[CW_NT]);
        pg8::MoeOrder S{ntile, 4, F.G, bx, (const int*)(ws + WS_TILEE), (const char*)(ws + WS_WD), (size_t)D * MOE_KB, (size_t)256 * MOE_KB, (const char*)args.out, (const char*)(ws + WS_HREST), (size_t)256 * MOE_KB};
        pg8::EpiDown E{(bf16*)(ws + WS_Y), args.in[I_BDN]};
        static_assert(kMoeFp8, "MoE operands are fp8");
        pg8::gemm_phase<pg8::EpiDown, pg8::MoeOrder, 2, true, true, 1>(F.lds, MOE_KB, S, E, nullptr, (const char*)(ws + WS_HREST), nullptr, S.B);
    } SEAM(10);
    if (IN(11)) { p12_final(F); }
#undef IN
#undef SEAM
}

extern "C" void kernel_launch(void* const* d_in, const int* in_sizes, int n_in, void* d_out, int out_size, void* d_ws, size_t ws_size, hipStream_t stream) {
    static int grid = 0;
    if (grid == 0) {
        if (n_in != 27 || out_size != T * D || ws_size < WS_END) { fprintf(stderr, "kernel_launch: unexpected shapes: n_in %d out %d ws %zu (need %zu)\n", n_in, out_size, ws_size, (size_t)WS_END); grid = -1; return; }
        int dev = 0, cus = 0, per_cu = 0;
        if (hipGetDevice(&dev) != hipSuccess || hipDeviceGetAttribute(&cus, hipDeviceAttributeMultiprocessorCount, dev) != hipSuccess) { grid = -1; return; }
        if (hipFuncSetAttribute((const void*)fwd_kernel, hipFuncAttributeMaxDynamicSharedMemorySize, LDS_BYTES) != hipSuccess) { fprintf(stderr, "kernel_launch: hipFuncSetAttribute failed\n"); grid = -1; return; }
        if (hipOccupancyMaxActiveBlocksPerMultiprocessor(&per_cu, (const void*)fwd_kernel, NTHREADS, LDS_BYTES) != hipSuccess || per_cu < 1) { fprintf(stderr, "kernel_launch: occupancy query says %d blocks per CU\n", per_cu); (void)hipGetLastError(); grid = -1; return; }
        grid = cus;
        if (grid > 256) grid = 256;
        if (grid % 8 != 0) grid -= grid % 8;
    }
    if (grid < 0) return;
    (void)hipMemsetAsync((char*)d_ws + WS_CTL, 0, CTL_ZERO_BYTES, stream);
    Args a{};
    for (int i = 0; i < 27; ++i) a.in[i] = (const float*)d_in[i];
    a.out = (float*)d_out; a.ws = (unsigned char*)d_ws;
    if (REPEAT_PHASE >= 0) {
        a.ph_lo = 0; a.ph_hi = REPEAT_PHASE + 1; hipLaunchKernelGGL(fwd_kernel, dim3(grid), dim3(NTHREADS), LDS_BYTES, stream, a);
        (void)hipMemsetAsync((char*)d_ws + WS_CTL + CW_BAR * 4, 0, XCD_BAR_WORDS * 4, stream);
        if (REPEAT_PHASE == 7) (void)hipMemsetAsync((char*)d_ws + WS_CTL + CW_GCOUNT * 4, 0, 256, stream);
        a.ph_lo = REPEAT_PHASE; a.ph_hi = NPHASES; hipLaunchKernelGGL(fwd_kernel, dim3(grid), dim3(NTHREADS), LDS_BYTES, stream, a); }
    else if (MK_N_LAUNCHES == 1) { a.ph_lo = 0; a.ph_hi = NPHASES; hipLaunchKernelGGL(fwd_kernel, dim3(grid), dim3(NTHREADS), LDS_BYTES, stream, a); }
    else for (int p = 0; p < NPHASES; ++p) { a.ph_lo = p; a.ph_hi = p + 1; hipLaunchKernelGGL(fwd_kernel, dim3(grid), dim3(NTHREADS), LDS_BYTES, stream, a); }
}
```

```cpp
#include <hip/hip_runtime.h>
#include <cstdio>
#include <cstdint>

#ifndef MK_N_LAUNCHES
#define MK_N_LAUNCHES 1
#endif

#ifndef REPEAT_PHASE
#define REPEAT_PHASE -1
#endif
#ifndef MOE_FP8
#define MOE_FP8 1
#endif
#ifndef INPROJ_FP8
#define INPROJ_FP8 1
#endif
#ifndef ACT_FP8
#define ACT_FP8 1
#endif
#ifndef USE_NAIVE_SCAN
#define USE_NAIVE_SCAN 0
#endif
#define LAS __attribute__((address_space(3)))
typedef unsigned short bf16;
typedef short bf16x8 __attribute__((ext_vector_type(8)));
typedef float f32x4 __attribute__((ext_vector_type(4)));
typedef float f32x2 __attribute__((ext_vector_type(2)));
typedef unsigned u32x4 __attribute__((ext_vector_type(4)));
typedef unsigned u32x2 __attribute__((ext_vector_type(2)));
typedef int i32x4 __attribute__((ext_vector_type(4)));
typedef int i32x8 __attribute__((ext_vector_type(8)));

constexpr int D = 1024, NB = 16, SEQ = 2048, CTX = 256;
constexpr int T = NB * SEQ, TC = NB * CTX, MALL = T + TC;
constexpr int NZ = 3072;
constexpr int ZC_OGA = 0, ZC_OGB = 512, ZC_MGA = 1024, ZC_MGB = 2048;
constexpr int NSTEP = 36;
constexpr int NT_HI = 14, NT_LO = 12;
constexpr int IN_DIM = 6176;
constexpr int NE = 32, TOPK = 4, FF = 1024;
constexpr int MAXSLOT = T * TOPK + NE * 256, MAXTILES = MAXSLOT / 256;
constexpr float EPS = 1e-6f;
constexpr int NWAVES = 8, NTHREADS = 512;

constexpr size_t MiB = 1u << 20;
constexpr size_t WS_CTL = 0, CTL_ZERO_BYTES = 1 * MiB;
constexpr size_t WS_MOD = 1 * MiB;
constexpr size_t WS_WRT = 1 * MiB + 512 * 1024;
constexpr size_t WS_WIN = 2 * MiB;
constexpr size_t WS_WUA = 15 * MiB, WS_WUB = 16 * MiB, WS_WO = 17 * MiB;
constexpr size_t WS_TOPI = 19 * MiB, WS_TOPP = WS_TOPI + 512 * 1024, WS_LRANK = 20 * MiB, WS_PSLOT = WS_LRANK + 512 * 1024, WS_BLKBASE = 21 * MiB, WS_TOKSLOT = 21 * MiB + 256 * 1024, WS_TILEE = 22 * MiB;
constexpr size_t WS_HBF = 24 * MiB;
constexpr size_t WS_RA = 24 * MiB, WS_RB = 56 * MiB;
constexpr size_t WS_H2 = 24 * MiB;
constexpr size_t WS_Z = 96 * MiB;
constexpr size_t WS_RQA = 288 * MiB;
constexpr size_t WS_RQB = 432 * MiB;
constexpr size_t WS_RVA = 504 * MiB;
constexpr size_t WS_RVB = 540 * MiB;
constexpr size_t WS_EL = 576 * MiB;
constexpr int NCG = MALL / 64;
constexpr size_t WS_WGU = 89 * MiB;
constexpr size_t WS_Y = 24 * MiB;
constexpr size_t WS_X1B = 160 * MiB;
constexpr size_t WS_MIXB = 296 * MiB;
constexpr size_t WS_WD = 360 * MiB;
constexpr size_t WS_HREST = (MOE_FP8 ? 392 : 424) * MiB;
constexpr size_t WS_END = 580 * MiB;
constexpr bool kInFp8 = (INPROJ_FP8 != 0);
constexpr int IN_KB = kInFp8 ? 1024 : 2048;
constexpr float IN_WSCALE = kInFp8 ? 32.f : 1.f;
constexpr size_t WS_WIN_LO = 12 * MiB;
constexpr bool kActFp8 = (ACT_FP8 != 0);
constexpr bool kMixFp8 = false;
constexpr bool kMoeFp8 = (MOE_FP8 != 0);
constexpr int MOE_KB = kMoeFp8 ? 1024 : 2048;
constexpr float MOE_WSCALE = kMoeFp8 ? 32.f : 1.f;
constexpr int H_SPLIT_TILES = kMoeFp8 ? 0 : 256;
constexpr int CW_BAR = 4096, CW_GCOUNT = 16384, CW_NT = 16384 + 64;

#define RLX_AGENT __ATOMIC_RELAXED, __HIP_MEMORY_SCOPE_AGENT
#define LDS_WAIT() asm volatile("s_waitcnt lgkmcnt(0)" ::: "memory")
#define VM_WAIT() asm volatile("s_waitcnt vmcnt(0)" ::: "memory")
__device__ __forceinline__ unsigned f2bf(float f) { unsigned u = __builtin_bit_cast(unsigned, f); return (u + 0x7fffu + ((u >> 16) & 1u)) >> 16; }
__device__ __forceinline__ unsigned pk2(float lo, float hi) { return f2bf(lo) | (f2bf(hi) << 16); }
__device__ __forceinline__ unsigned pk4_fp8(float a, float b, float c, float d) { int w = 0; w = __builtin_amdgcn_cvt_pk_fp8_f32(a, b, w, false); w = __builtin_amdgcn_cvt_pk_fp8_f32(c, d, w, true); return (unsigned)w; }
__device__ __forceinline__ float bf2f(unsigned short b) { return __builtin_bit_cast(float, ((unsigned)b) << 16); }
__device__ __forceinline__ float bflo(unsigned w) { return __builtin_bit_cast(float, w << 16); }
__device__ __forceinline__ float bfhi(unsigned w) { return __builtin_bit_cast(float, w & 0xffff0000u); }
__device__ __forceinline__ float sigmoidf_(float x) { return __builtin_amdgcn_rcpf(1.0f + __expf(-x)); }
template <int CTRL> __device__ __forceinline__ float dpp_mov(float v, float old) { return __builtin_bit_cast(float, __builtin_amdgcn_update_dpp(__builtin_bit_cast(int, old), __builtin_bit_cast(int, v), CTRL, 0xf, 0xf, false)); }
__device__ __forceinline__ float rdlane(float v, int l) { return __builtin_bit_cast(float, __builtin_amdgcn_readlane(__builtin_bit_cast(int, v), l)); }
__device__ __forceinline__ float wave_sum(float v) {
    v += dpp_mov<0x111>(v, 0.f); v += dpp_mov<0x112>(v, 0.f); v += dpp_mov<0x114>(v, 0.f); v += dpp_mov<0x118>(v, 0.f);
    return (rdlane(v, 15) + rdlane(v, 31)) + (rdlane(v, 47) + rdlane(v, 63));
}
__device__ __forceinline__ float wave_max(float v) {
    const float ninf = -INFINITY;
    v = fmaxf(v, dpp_mov<0x111>(v, ninf)); v = fmaxf(v, dpp_mov<0x112>(v, ninf)); v = fmaxf(v, dpp_mov<0x114>(v, ninf)); v = fmaxf(v, dpp_mov<0x118>(v, ninf));
    return fmaxf(fmaxf(rdlane(v, 15), rdlane(v, 31)), fmaxf(rdlane(v, 47), rdlane(v, 63)));
}

__device__ __forceinline__ int qperm(int d) { return (d & ~31) | (((d >> 2) & 3) << 3) | (((d >> 4) & 1) << 2) | (d & 3); }
namespace pg8 {
constexpr int BM = 256, BK = 64, HALF = 128, HTB = HALF * BK * 2, STAGE_BYTES = 8 * HTB;
__device__ __forceinline__ int lds_byte(int r, int c) { const int st = (r >> 4) * 2 + (c >> 5), rr = r & 15, cc = c & 31, ob = rr * 64 + cc * 2; return st * 1024 + (ob ^ (((ob >> 9) & 1) << 5)); }
__device__ __forceinline__ void stage_rc(int b, int& R, int& C) { const int st = b / 1024, sb = b % 1024, swz = sb ^ (((sb >> 9) & 1) << 5); R = (st >> 1) * 16 + swz / 64; C = (st & 1) * 32 + (swz % 64) / 2; }
__device__ __forceinline__ int perm32(int rho) { const int n = rho >> 4, i = rho & 15; return 8 * (i >> 2) + 4 * n + (i & 3); }
__device__ __forceinline__ unsigned cvt_pk_bf16(float lo, float hi) { unsigned r; asm volatile("v_cvt_pk_bf16_f32 %0, %1, %2" : "=v"(r) : "v"(lo), "v"(hi)); return r; }

struct Unit { int pm, pn, e; unsigned a, b; };

template <class E, class = void> struct EpiHasPre { static constexpr bool value = false; };
template <class E> struct EpiHasPre<E, decltype((void)E::PRE)> { static constexpr bool value = E::PRE; };
__device__ __forceinline__ void glds4(const void* g, LAS void* l) { __builtin_amdgcn_global_load_lds((const unsigned*)g, (LAS unsigned*)l, 4, 0, 0); }
template <class E, class = void> struct EpiHasMid { static constexpr bool value = false; };
template <class E> struct EpiHasMid<E, decltype((void)E::MID)> { static constexpr bool value = E::MID; };
template <class Epi, class Sched, int GATHER, bool ALIGN_EPI, bool FP8, int BPERM = 0>
__device__ __forceinline__ void gemm_phase(LAS unsigned char* lds, const int KB, const Sched& S, const Epi& E, const int* __restrict__ rowidx, const char* gatherA, const void* Abase, const void* Bbase) {
    const int tid = threadIdx.x, wid = __builtin_amdgcn_readfirstlane(tid >> 6), lane = tid & 63, wr = wid >> 2, wc = wid & 3, fr = lane & 15, fq = lane >> 4;
    const int nt = KB / (BK * 2);
    unsigned vA[2][2], voffB[2]; int Rr[2], Cc[2];
#pragma unroll
    for (int i = 0; i < 2; ++i) { int R, C; stage_rc(tid * 16 + i * 8192, R, C); Rr[i] = R; Cc[i] = C; const int Rb = (R & ~31) + perm32(R & 31);
        const int Rp = (R >> 5) * 64 + ((R >> 2) & 3) * 16 + ((R >> 4) & 1) * 4 + (R & 3);
        voffB[i] = (unsigned)((BPERM ? Rp : Rb) * KB + 2 * C); vA[0][i] = (unsigned)(R * KB + 2 * C); vA[1][i] = (unsigned)((R + HALF) * KB + 2 * C); }
    const unsigned kstep = (unsigned)(BK * 2);
    const unsigned hstep = (unsigned)(HALF * KB);
    const unsigned hstepB = BPERM ? (unsigned)(8 * KB) : hstep;
    const unsigned ldsw = (unsigned)wid * 1024u;
    const int aoff = lds_byte(wr * 64 + fr, FP8 ? fq * 16 : fq * 8), boff = lds_byte(wc * 32 + fr, FP8 ? fq * 16 : fq * 8);
    constexpr int KSTR = FP8 ? 16 : 1024;
#define PG8_SA(b, h) (((b) * 2 + (h)) * HTB)
#define PG8_SB(b, h) ((4 + (b) * 2 + (h)) * HTB)
#define PG8_STAGE(bufoff, rsrc, soff, voff) do { _Pragma("unroll") for (int _i = 0; _i < 2; ++_i) \
        __builtin_amdgcn_raw_ptr_buffer_load_lds(rsrc, (LAS void*)(lds + (bufoff) + ldsw + _i * 8192), 16, (int)(voff)[_i], (int)(soff), 0, 0); } while (0)
#define PG8_LDA(dst, b, h) do { _Pragma("unroll") for (int m = 0; m < 4; ++m) _Pragma("unroll") for (int k = 0; k < 2; ++k) dst[m][k] = *(const LAS i32x4*)(lds + PG8_SA(b, h) + aoff + m * 2048 + k * KSTR); } while (0)
#define PG8_LDB(dst, b, h) do { _Pragma("unroll") for (int n = 0; n < 2; ++n) _Pragma("unroll") for (int k = 0; k < 2; ++k) dst[n][k] = *(const LAS i32x4*)(lds + PG8_SB(b, h) + boff + n * 2048 + k * KSTR); } while (0)
#define PG8_V8(x) __builtin_shufflevector((x)[0], (x)[1], 0, 1, 2, 3, 4, 5, 6, 7)
#define PG8_MMA(ai, bj, At, Bt) do { __builtin_amdgcn_s_setprio(3); _Pragma("unroll") for (int m = 0; m < 4; ++m) _Pragma("unroll") for (int n = 0; n < 2; ++n) { \
        if constexpr (FP8) acc[ai][bj][m][n] = __builtin_amdgcn_mfma_scale_f32_16x16x128_f8f6f4(PG8_V8(Bt[n]), PG8_V8(At[m]), acc[ai][bj][m][n], 0, 0, 0, 0x7f7f7f7f, 0, 0x7f7f7f7f); \
        else { _Pragma("unroll") for (int k = 0; k < 2; ++k) acc[ai][bj][m][n] = __builtin_amdgcn_mfma_f32_16x16x32_bf16(__builtin_bit_cast(bf16x8, Bt[n][k]), __builtin_bit_cast(bf16x8, At[m][k]), acc[ai][bj][m][n], 0, 0, 0); } } \
        __builtin_amdgcn_s_setprio(0); } while (0)
#define PG8_WAIT_V(n) asm volatile("s_waitcnt vmcnt(" #n ")" ::: "memory")
#define PG8_WAIT_VN(pe) do { if constexpr (Epi::NSTORES >= 16) asm volatile("s_cmp_lg_u32 %0, 0\n\ts_cbranch_scc1 1f\n\ts_waitcnt vmcnt(8)\n1:\n\ts_waitcnt vmcnt(24)" :: "s"(__builtin_amdgcn_readfirstlane((int)(pe))) : "memory", "scc"); \
        else if constexpr (Epi::NSTORES >= 8) asm volatile("s_cmp_lg_u32 %0, 0\n\ts_cbranch_scc1 1f\n\ts_waitcnt vmcnt(8)\n1:\n\ts_waitcnt vmcnt(16)" :: "s"(__builtin_amdgcn_readfirstlane((int)(pe))) : "memory", "scc"); \
        else asm volatile("s_waitcnt vmcnt(8)" ::: "memory"); } while (0)
#define PG8_WAIT_L(n) asm volatile("s_waitcnt lgkmcnt(" #n ")" ::: "memory")
#define PG8_BAR __builtin_amdgcn_s_barrier()
#define PG8_SCHED __builtin_amdgcn_sched_barrier(0)
#define PG8_GATHER_OFFS(dst, unit) do { _Pragma("unroll") for (int _h = 0; _h < 2; ++_h) _Pragma("unroll") for (int _i = 0; _i < 2; ++_i) \
        dst[_h][_i] = (unsigned)((GATHER == 1 ? rowidx[(unit).pm * BM + _h * HALF + Rr[_i]] : (unit).pm * BM + _h * HALF + Rr[_i]) * KB + 2 * Cc[_i]); } while (0)
#define PG8_GATHER_OFFS_LDS(dst, unit) do { _Pragma("unroll") for (int _h = 0; _h < 2; ++_h) _Pragma("unroll") for (int _i = 0; _i < 2; ++_i) \
        dst[_h][_i] = (unsigned)((GATHER == 1 ? IDX[_h * HALF + Rr[_i]] : (unit).pm * BM + _h * HALF + Rr[_i]) * KB + 2 * Cc[_i]); } while (0)
    LAS int* const IDX = (LAS int*)(lds + STAGE_BYTES + 1024);
    LAS float* const EC = (LAS float*)(lds + STAGE_BYTES + 2048) + wid * 64;
    Unit cur, nxt; int ui = 0;
    if (!S.next(0, cur)) return;
    f32x4 acc[2][2][4][2];
#pragma unroll
    for (int a = 0; a < 2; ++a)
#pragma unroll
        for (int b = 0; b < 2; ++b)
#pragma unroll
            for (int m = 0; m < 4; ++m)
#pragma unroll
                for (int n = 0; n < 2; ++n) acc[a][b][m][n] = (f32x4){0.f, 0.f, 0.f, 0.f};
    i32x4 At[4][2], B0[2][2], B1[2][2];
    const __amdgpu_buffer_rsrc_t rA = __builtin_amdgcn_make_buffer_rsrc((void*)(GATHER ? gatherA : Abase), 0, 0x7fffffff, 0x00020000);
    const __amdgpu_buffer_rsrc_t rB = __builtin_amdgcn_make_buffer_rsrc((void*)Bbase, 0, 0x7fffffff, 0x00020000);
    unsigned cA = GATHER ? 0u : cur.a, cB = cur.b;
    if constexpr (GATHER) { PG8_GATHER_OFFS(vA, cur); }
    if constexpr (EpiHasPre<Epi>::value) E.pre(cur, EC, wc, lane);
    PG8_STAGE(PG8_SB(0, 0), rB, cB, voffB); PG8_STAGE(PG8_SB(0, 1), rB, cB + hstepB, voffB); PG8_STAGE(PG8_SA(0, 0), rA, cA, vA[0]); PG8_STAGE(PG8_SA(0, 1), rA, cA, vA[1]);
    if (wr == 1) PG8_BAR;
    PG8_WAIT_V(2); PG8_BAR;
    PG8_STAGE(PG8_SB(1, 0), rB, cB + kstep, voffB); PG8_STAGE(PG8_SA(1, 0), rA, cA + kstep, vA[0]); PG8_STAGE(PG8_SB(1, 1), rB, cB + hstepB + kstep, voffB);
    PG8_WAIT_V(6); PG8_BAR;
    for (;;) {
        const bool has_next = S.next(ui + 1, nxt);
        const unsigned nA = GATHER ? 0u : (has_next ? nxt.a : cA), nB = has_next ? nxt.b : cB;
        if constexpr (GATHER == 1) { if (has_next && wid < 4) glds4(rowidx + nxt.pm * BM + 64 * wid + lane, IDX + 64 * wid); }
#pragma nounroll
        for (int t = 0; t < nt; t += 2) {
            const bool last = (t == nt - 2);
            const unsigned a1 = cA + (unsigned)(t + 1) * kstep;
            const unsigned a2 = last ? nA : cA + (unsigned)(t + 2) * kstep, b2 = last ? nB : cB + (unsigned)(t + 2) * kstep;
            const unsigned a3 = a2 + kstep, b3 = b2 + kstep;
            if constexpr (EpiHasMid<Epi>::value) { if (t == nt / 2) E.mid(acc, cur, wr, wc, fr, fq); }
            unsigned vN[2][2];
            if constexpr (GATHER) { if (last && has_next) { PG8_GATHER_OFFS_LDS(vN, nxt); } }
            const bool post_epi = (t == 0) && (ui > 0);
            PG8_LDB(B0, 0, 0); PG8_LDB(B1, 0, 1); PG8_SCHED; PG8_LDA(At, 0, 0); PG8_STAGE(PG8_SA(1, 1), rA, a1, vA[1]);
            if constexpr (GATHER) { if (last && has_next) {
#pragma unroll
                for (int _h = 0; _h < 2; ++_h)
#pragma unroll
                    for (int _i = 0; _i < 2; ++_i) vA[_h][_i] = vN[_h][_i]; } }
            PG8_WAIT_VN(post_epi);
            PG8_WAIT_L(0); PG8_BAR; PG8_MMA(0, 0, At, B0); PG8_MMA(0, 1, At, B1); PG8_BAR; PG8_SCHED;
            PG8_LDA(At, 0, 1); PG8_STAGE(PG8_SB(0, 0), rB, b2, voffB); PG8_STAGE(PG8_SB(0, 1), rB, b2 + hstepB, voffB); PG8_STAGE(PG8_SA(0, 0), rA, a2, vA[0]);
            PG8_WAIT_VN(post_epi);
            PG8_WAIT_L(0); PG8_BAR; PG8_MMA(1, 0, At, B0); PG8_MMA(1, 1, At, B1); PG8_BAR; PG8_SCHED;
            PG8_LDB(B0, 1, 0); PG8_LDB(B1, 1, 1); PG8_SCHED; PG8_LDA(At, 1, 0); PG8_STAGE(PG8_SA(0, 1), rA, a2, vA[1]);
            PG8_WAIT_V(8); PG8_WAIT_L(0); PG8_BAR; PG8_MMA(0, 0, At, B0); PG8_MMA(0, 1, At, B1); PG8_BAR; PG8_SCHED;
            PG8_LDA(At, 1, 1); PG8_STAGE(PG8_SB(1, 0), rB, b3, voffB); PG8_STAGE(PG8_SB(1, 1), rB, b3 + hstepB, voffB); PG8_STAGE(PG8_SA(1, 0), rA, a3, vA[0]);
            PG8_WAIT_V(8); PG8_WAIT_L(0); PG8_BAR; PG8_MMA(1, 0, At, B0); PG8_MMA(1, 1, At, B1); PG8_BAR; PG8_SCHED;
        }
        if constexpr (ALIGN_EPI) { if (wr == 0) PG8_BAR; }
        if constexpr (EpiHasPre<Epi>::value) E(acc, cur, wr, wc, fr, fq, EC); else E(acc, cur, wr, wc, fr, fq);
        if (!has_next) break;
#pragma unroll
        for (int a = 0; a < 2; ++a)
#pragma unroll
            for (int b = 0; b < 2; ++b)
#pragma unroll
                for (int m = 0; m < 4; ++m)
#pragma unroll
                    for (int n = 0; n < 2; ++n) acc[a][b][m][n] = (f32x4){0.f, 0.f, 0.f, 0.f};
        cur = nxt; cA = nA; cB = nB; ++ui;
        if constexpr (EpiHasPre<Epi>::value) E.pre(cur, EC, wc, lane);
        if constexpr (ALIGN_EPI) { if (wr == 1) PG8_BAR; }
    }
    PG8_WAIT_V(0);
    if constexpr (!ALIGN_EPI) { if (wr == 0) PG8_BAR; }
    PG8_BAR;
#undef PG8_SA
#undef PG8_SB
#undef PG8_STAGE
#undef PG8_LDA
#undef PG8_LDB
#undef PG8_MMA
#undef PG8_V8
#undef PG8_WAIT_V
#undef PG8_WAIT_VN
#undef PG8_WAIT_L
#undef PG8_BAR
#undef PG8_SCHED
#undef PG8_GATHER_OFFS
#undef PG8_GATHER_OFFS_LDS
}

struct DenseOrder {
    int nM, nN, nwg, G, c, lo, hi; const char* A; const char* B; size_t tA, tB;
    __device__ void init(int M, int N, int KB, int G_, int c_, const void* A_, const void* B_) { nM = M / BM; nN = N / BM; nwg = nM * nN; G = G_; c = c_; lo = 0; hi = 1 << 20; A = (const char*)A_; B = (const char*)B_; tA = (size_t)BM * KB; tB = tA; }
    __device__ bool next(int i, Unit& u) const {
        if (i + lo >= hi) return false;
        const long L = (long)(i + lo) * G + c; if (L >= nwg) return false;
        int wgid = (int)L; { const int q = nwg / 8, r = nwg % 8, xcd = wgid % 8, off = wgid / 8; wgid = (xcd < r ? xcd * (q + 1) : r * (q + 1) + (xcd - r) * q) + off; }
        const int nig = 8 * nN, gid = wgid / nig, fm = gid * 8, gsz = (nM - fm) < 8 ? (nM - fm) : 8;
        u.pm = fm + ((wgid % nig) % gsz); u.pn = (wgid % nig) / gsz; u.e = 0; u.a = (unsigned)((size_t)u.pm * tA); u.b = (unsigned)((size_t)u.pn * tB); return true;
    }
};
struct InprojOrder {
    int G, c; const char* A; const char* B; size_t tA, tB;
    __device__ bool next(int i, Unit& u) const {
        const int L = i * G + c; constexpr int NLAT = 128 * NT_HI, NCTX = 16 * 14;
        if (L < NLAT) { const int xcd = L % 8, off = L / 8; const int wgid = xcd * (NLAT / 8) + off; constexpr int nig = 8 * NT_HI; const int gid = wgid / nig;
            u.pm = 16 + gid * 8 + ((wgid % nig) % 8); u.pn = (wgid % nig) / 8; }
        else if (L < NLAT + NCTX) { const int idx = L - NLAT; u.pm = idx / 14; u.pn = idx % 14; }
        else return false;
        u.e = 0; u.a = (unsigned)((size_t)u.pm * tA); u.b = (unsigned)((size_t)u.pn * tB); return true;
    }
};
struct MoeOrder {
    int nt, NPN, G, c; const int* tile_e; const char* B; size_t eB, tB; const char* A0; const char* A1; size_t tA;
    __device__ bool next(int i, Unit& u) const {
        const int nx = (G % 8 == 0) ? 8 : 1, per = G / nx, x = c % nx, j = c / nx;
        const int q = (nt + nx - 1) / nx, s = i * per + j, grp = 4 * NPN;
        const int rl = (s / grp) * 4 + (s & 3), pn = (s % grp) >> 2;
        if (rl >= q) return false;
        const int rt = x * q + rl; if (rt >= nt) return false;
        const int e = __builtin_amdgcn_readfirstlane(tile_e[rt]);
        u.pm = rt; u.pn = pn; u.e = e; u.b = (unsigned)((size_t)e * eB + (size_t)pn * tB); u.a = 0u; return true;
    }
};

#define EPI_LOOP_BEGIN \
    int rb_ = wr * 64 + fr; asm volatile("" : "+v"(rb_));     \
    _Pragma("unroll") for (int ai = 0; ai < 2; ++ai) _Pragma("unroll") for (int m = 0; m < 4; ++m) { const int row = u.pm * BM + ai * HALF + m * 16 + rb_; \
    _Pragma("unroll") for (int bj = 0; bj < 2; ++bj) { const int col = u.pn * BM + bj * HALF + wc * 32 + 8 * fq; f32x4 v0 = acc[ai][bj][m][0], v1 = acc[ai][bj][m][1];
#define EPI_LOOP_END } }
__device__ __forceinline__ u32x4 pack8(f32x4 v0, f32x4 v1) { u32x4 w; w.x = cvt_pk_bf16(v0[0], v0[1]); w.y = cvt_pk_bf16(v0[2], v0[3]); w.z = cvt_pk_bf16(v1[0], v1[1]); w.w = cvt_pk_bf16(v1[2], v1[3]); return w; }
__device__ __forceinline__ void unpack8(u32x4 w, f32x4& a, f32x4& b) { a = (f32x4){bflo(w.x), bfhi(w.x), bflo(w.y), bfhi(w.y)}; b = (f32x4){bflo(w.z), bfhi(w.z), bflo(w.w), bfhi(w.w)}; }

__device__ __forceinline__ float logsigmoidf_(float x) { return fminf(x, 0.f) - __logf(1.f + __expf(-fabsf(x))); }
__device__ __forceinline__ u32x2 pack4(f32x4 v) { u32x2 w; w.x = cvt_pk_bf16(v[0], v[1]); w.y = cvt_pk_bf16(v[2], v[3]); return w; }
struct EpiInproj {
    static constexpr bool PRE = true; static constexpr int NSTORES = 8;
    bf16* Z; unsigned char* WS; float* EL; const float* gkb; const float* hlb; int rowoff_tiles, tileoff; float scale;
    __device__ __forceinline__ void pre(const Unit& uu, LAS float* ec, int wc, int lane) const {
        const int t = uu.pn + tileoff, c = lane & 15, sd = lane >> 4;
        if (t < 8) glds4(hlb + (sd >> 1) * 1024 + (sd & 1) * 512 + (t >> 1) * 128 + (t & 1) * 64 + 16 * wc + c, ec);
        else if (t < 12) glds4(gkb + (sd & 1) * 256 + (t - 8) * 64 + 16 * wc + c, ec);
    }
    __device__ __forceinline__ void operator()(const f32x4 (&acc)[2][2][4][2], const Unit& uu, int wr, int wc, int fr, int fq, const LAS float* ec) const {
        const int pm = uu.pm + rowoff_tiles, t = uu.pn + tileoff;
        int fr_ = fr; asm volatile("" : "+v"(fr_));
        if (t < 14) {
#pragma unroll
            for (int ai = 0; ai < 2; ++ai) {
                const int cg = 4 * pm + 2 * ai + wr;
                const bool ctx = cg < TC / 64; const int b = ctx ? cg >> 2 : (cg - TC / 64) >> 5, mc = ctx ? cg & 3 : (cg - TC / 64) & 31, smem = ctx ? mc : 4 + mc;
                if (t < 12) {
                    const bool hg = t < 8; const int h = hg ? t >> 1 : t - 8, cc0 = 16 * wc + 4 * fq, chh = hg ? (t & 1) * 64 + cc0 : cc0, ch = (hg ? h * 128 : h * 64) + chh;
                    f32x4 c0[2];
#pragma unroll
                    for (int d = 0; d < 2; ++d) { if (hg) { const f32x4 a0 = *(const LAS f32x4*)(ec + 16 * d + 4 * fq), a1 = *(const LAS f32x4*)(ec + 32 + 16 * d + 4 * fq);
#pragma unroll
                            for (int j = 0; j < 4; ++j) c0[d][j] = __builtin_amdgcn_rcpf(1.f + __expf(a1[j] - a0[j])); }
                        else c0[d] = *(const LAS f32x4*)(ec + 16 * d + 4 * fq) * 1.44269504f; }
                    const int tsz = hg ? 16384 : 8192, wbase = ((hg ? (t & 1) * 4 : 0) + wc) * 2048 + 8 * (fq & 2) + 512 * (fq & 1);
                    unsigned char* const qkb = WS + (hg ? WS_RQA : WS_RQB);
#pragma unroll
                    for (int d = 0; d < 2; ++d) {
                        const int sd = d ? (ctx ? 3 - mc : 35 - mc) : smem, chain = (b * 4 + h) * 2 + d;
                        unsigned char* const tq = qkb + (size_t)((chain * NSTEP + sd) * 2) * tsz; unsigned char* const tk = tq + tsz;
                        const float id = hg ? 1.f : 0.f; f32x4 run = (f32x4){id, id, id, id};
                        u32x2 wq0 = (u32x2){0u, 0u}, wk0 = wq0;
#pragma unroll
                        for (int mm = 0; mm < 4; ++mm) { const int m = d ? 3 - mm : mm; f32x4 ky, e, ie;
                            if (hg) { const f32x4 z = acc[ai][d][m][1 - d] * (scale * -1.44269504f);
#pragma unroll
                                for (int j = 0; j < 4; ++j) { const float lb = c0[d][j], oml = 1.f - lb, s = __builtin_amdgcn_rcpf(1.f + __builtin_amdgcn_exp2f(z[j]));
                                    float v = __builtin_fmaf(oml, s, lb), tt = v; ky[j] = __builtin_fmaf(-oml, s, oml);
                                    if (d == 0) { v *= dpp_mov<0x111>(v, 1.f); v *= dpp_mov<0x112>(v, 1.f); v *= dpp_mov<0x114>(v, 1.f); v *= dpp_mov<0x118>(v, 1.f); }
                                    else        { v *= dpp_mov<0x101>(v, 1.f); v *= dpp_mov<0x102>(v, 1.f); v *= dpp_mov<0x104>(v, 1.f); v *= dpp_mov<0x108>(v, 1.f); }
                                    tt *= dpp_mov<0x128>(tt, 1.f); tt *= dpp_mov<0x124>(tt, 1.f); tt *= dpp_mov<0x122>(tt, 1.f); tt *= dpp_mov<0x121>(tt, 1.f);
                                    const float cm = run[j] * v; run[j] *= tt; e[j] = cm; ie[j] = __builtin_amdgcn_rcpf(cm); } }
                            else { const f32x4 x = acc[ai][1][m][d] * (scale * 1.44269504f); ky = acc[ai][0][m][1] * scale;
#pragma unroll
                                for (int j = 0; j < 4; ++j) { const float y2 = x[j] + c0[d][j];
                                    float v = (fminf(y2, 0.f) - __builtin_amdgcn_logf(1.f + __builtin_amdgcn_exp2f(-fabsf(y2)))) * 0.0625f, tt = v;
                                    if (d == 0) { v += dpp_mov<0x111>(v, 0.f); v += dpp_mov<0x112>(v, 0.f); v += dpp_mov<0x114>(v, 0.f); v += dpp_mov<0x118>(v, 0.f); }
                                    else        { v += dpp_mov<0x101>(v, 0.f); v += dpp_mov<0x102>(v, 0.f); v += dpp_mov<0x104>(v, 0.f); v += dpp_mov<0x108>(v, 0.f); }
                                    tt += dpp_mov<0x128>(tt, 0.f); tt += dpp_mov<0x124>(tt, 0.f); tt += dpp_mov<0x122>(tt, 0.f); tt += dpp_mov<0x121>(tt, 0.f);
                                    const float cm = run[j] + v; run[j] += tt; e[j] = __builtin_amdgcn_exp2f(cm); ie[j] = __builtin_amdgcn_exp2f(-cm); } }
                            u32x2 wq = (u32x2){0u, 0u}; const u32x2 wk = pack4(ky * ie);
                            if (!ctx) wq = pack4(acc[ai][0][m][0] * (hg ? scale : scale * 0.125f) * e);
                            if ((mm & 1) == 0) { wq0 = wq; wk0 = wk; }
                            else { const int roff = (16 * (mm - 1) + (d ? 15 - fr_ : fr_)) * 32;
                                if (!ctx) { const auto sx = __builtin_amdgcn_permlane16_swap(wq0.x, wq.x, false, false), sy = __builtin_amdgcn_permlane16_swap(wq0.y, wq.y, false, false);
                                    *(u32x4*)(tq + wbase + roff) = (u32x4){sx[0], sy[0], sx[1], sy[1]}; }
                                const auto sx = __builtin_amdgcn_permlane16_swap(wk0.x, wk.x, false, false), sy = __builtin_amdgcn_permlane16_swap(wk0.y, wk.y, false, false);
                                *(u32x4*)(tk + wbase + roff) = (u32x4){sx[0], sy[0], sx[1], sy[1]}; } }
                        if (fr == 0) { f32x4 el;
#pragma unroll
                            for (int j = 0; j < 4; ++j) el[j] = hg ? run[j] : __builtin_amdgcn_exp2f(run[j]);
                            *(f32x4*)(EL + ((size_t)d * NCG + cg) * 768 + (hg ? 0 : 512) + ch) = el; }
                    }
                    if (hg) { unsigned char* const tv = WS + WS_RVA + (size_t)((b * 4 + h) * NSTEP + smem) * 16384;
#pragma unroll
                        for (int m = 0; m < 4; m += 2) { const u32x2 w0 = pack4(acc[ai][1][m][1] * scale), w1 = pack4(acc[ai][1][m + 1][1] * scale);
                            const auto sx = __builtin_amdgcn_permlane16_swap(w0.x, w1.x, false, false), sy = __builtin_amdgcn_permlane16_swap(w0.y, w1.y, false, false);
                            *(u32x4*)(tv + wbase + (16 * m + fr_) * 32) = (u32x4){sx[0], sy[0], sx[1], sy[1]}; } }
                } else {
#pragma unroll
                    for (int bj = 0; bj < 2; ++bj) { const int col = 256 * (t - 12) + 128 * bj + 32 * wc + 8 * fq, hv = col >> 7, c = col & 127;
                        unsigned char* const tv = WS + WS_RVB + (size_t)((b * 4 + hv) * NSTEP + smem) * 16384;
#pragma unroll
                        for (int m = 0; m < 4; ++m) *(u32x4*)(tv + (16 * m + fr_) * 256 + 2 * c) = pack8(acc[ai][bj][m][0] * scale, acc[ai][bj][m][1] * scale); }
                }
            }
        } else {
            bf16* zb = Z + (size_t)(pm * BM - TC) * NZ;
            int rb_ = wr * 64 + fr_;
            const int cb = (t < 16) ? ZC_OGA + (t - 14) * 256 : (t < 18) ? ZC_OGB + (t - 16) * 256 : ZC_MGA + (t - 18) * 256;
#pragma unroll
            for (int ai = 0; ai < 2; ++ai)
#pragma unroll
                for (int m = 0; m < 4; ++m) { bf16* zr = zb + (size_t)(ai * HALF + m * 16 + rb_) * NZ;
#pragma unroll
                    for (int bj = 0; bj < 2; ++bj) *(u32x4*)(zr + cb + bj * HALF + wc * 32 + 8 * fq) = pack8(acc[ai][bj][m][0] * scale, acc[ai][bj][m][1] * scale); }
        }
    }
};
struct EpiMerge {
    static constexpr bool MID = true; static constexpr int NSTORES = 16;
    const bf16* Zlat; bf16* out;
    __device__ __forceinline__ void mid(f32x4 (&acc)[2][2][4][2], const Unit& u, int wr, int wc, int fr, int fq) const {
        int rb_ = wr * 64 + fr; asm volatile("" : "+v"(rb_));
#pragma unroll
        for (int ai = 0; ai < 2; ++ai)
#pragma unroll
            for (int m = 0; m < 4; ++m) { const int row = u.pm * BM + ai * HALF + m * 16 + rb_;
#pragma unroll
                for (int bj = 0; bj < 2; ++bj) { const int col = u.pn * BM + bj * HALF + wc * 32 + 8 * fq;
                    const u32x4 aw = *(const u32x4*)(Zlat + (size_t)row * NZ + ZC_MGA + col), bw = *(const u32x4*)(Zlat + (size_t)row * NZ + ZC_MGB + col);
                    f32x4 a0, a1, b0, b1; unpack8(aw, a0, a1); unpack8(bw, b0, b1);
#pragma unroll
                    for (int j = 0; j < 4; ++j) { acc[ai][bj][m][0][j] *= (1.f + __expf(-b0[j])) * __builtin_amdgcn_rcpf(1.f + __expf(-a0[j]));
                                                  acc[ai][bj][m][1][j] *= (1.f + __expf(-b1[j])) * __builtin_amdgcn_rcpf(1.f + __expf(-a1[j])); } } }
    }
    __device__ __forceinline__ void operator()(const f32x4 (&acc)[2][2][4][2], const Unit& u, int wr, int wc, int fr, int fq) const {
        EPI_LOOP_BEGIN
            const u32x4 gw = *(const u32x4*)(Zlat + (size_t)row * NZ + ZC_MGB + col); f32x4 g0, g1; unpack8(gw, g0, g1);
#pragma unroll
            for (int j = 0; j < 4; ++j) { v0[j] *= sigmoidf_(g0[j]); v1[j] *= sigmoidf_(g1[j]); }
            *(u32x4*)(out + (size_t)row * D + col) = pack8(v0, v1);
        EPI_LOOP_END
    }
};
template <bool F8> __device__ __forceinline__ void store8(void* base, size_t idx, f32x4 v0, f32x4 v1) {
    if constexpr (F8) { u32x2 w; w.x = pk4_fp8(v0[0], v0[1], v0[2], v0[3]); w.y = pk4_fp8(v1[0], v1[1], v1[2], v1[3]); *(u32x2*)((unsigned char*)base + idx) = w; }
    else *(u32x4*)((bf16*)base + idx) = pack8(v0, v1);
}
template <bool F8> struct EpiStore {
    static constexpr int NSTORES = 16;
    void* out; int ldc; float scale;
    __device__ __forceinline__ void operator()(const f32x4 (&acc)[2][2][4][2], const Unit& u, int wr, int wc, int fr, int fq) const {
        EPI_LOOP_BEGIN
            store8<F8>(out, (size_t)row * ldc + col, v0 * scale, v1 * scale);
        EPI_LOOP_END
    }
};
struct EpiGateUp {
    static constexpr bool PRE = true; static constexpr int NSTORES = 8;
    bf16* H0; bf16* H1; const float* bg; const float* bu;
    __device__ __forceinline__ void pre(const Unit& u, LAS float* ec, int wc, int lane) const {
        glds4((lane < 32 ? bg : bu) + (size_t)u.e * FF + u.pn * HALF + wc * 32 + (lane & 31), ec); }
    __device__ __forceinline__ void operator()(const f32x4 (&acc)[2][2][4][2], const Unit& u, int wr, int wc, int fr, int fq, const LAS float* ec) const {
        const int ocol = u.pn * HALF + wc * 32 + 8 * fq;
        const f32x4 bg0 = *(const LAS f32x4*)(ec + 8 * fq), bg1 = *(const LAS f32x4*)(ec + 8 * fq + 4), bu0 = *(const LAS f32x4*)(ec + 32 + 8 * fq), bu1 = *(const LAS f32x4*)(ec + 32 + 8 * fq + 4);
        int rb_ = wr * 64 + fr; asm volatile("" : "+v"(rb_));
#pragma unroll
        for (int ai = 0; ai < 2; ++ai)
#pragma unroll
            for (int m = 0; m < 4; ++m) { const int row = u.pm * BM + ai * HALF + m * 16 + rb_;
                constexpr float ws = 1.f / MOE_WSCALE;
                f32x4 g0 = acc[ai][0][m][0] * ws + bg0, g1 = acc[ai][0][m][1] * ws + bg1, u0 = acc[ai][1][m][0] * ws + bu0, u1 = acc[ai][1][m][1] * ws + bu1, o0, o1;
#pragma unroll
                for (int j = 0; j < 4; ++j) { g0[j] = fminf(g0[j], 7.f); g1[j] = fminf(g1[j], 7.f); u0[j] = fminf(fmaxf(u0[j], -7.f), 7.f); u1[j] = fminf(fmaxf(u1[j], -7.f), 7.f); }
                f32x4 e0 = g0 * (-1.702f * 1.44269504f), e1 = g1 * (-1.702f * 1.44269504f);
#pragma unroll
                for (int j = 0; j < 4; ++j) { e0[j] = __builtin_amdgcn_exp2f(e0[j]); e1[j] = __builtin_amdgcn_exp2f(e1[j]); }
                e0 = e0 + 1.f; e1 = e1 + 1.f;
#pragma unroll
                for (int j = 0; j < 4; ++j) { e0[j] = __builtin_amdgcn_rcpf(e0[j]); e1[j] = __builtin_amdgcn_rcpf(e1[j]); }
                o0 = (g0 * e0) * (u0 + 1.f); o1 = (g1 * e1) * (u1 + 1.f);
                if constexpr (kMoeFp8) { unsigned char* hp = (row < H_SPLIT_TILES * BM) ? (unsigned char*)H0 + (size_t)row * FF : (unsigned char*)H1 + (size_t)(row - H_SPLIT_TILES * BM) * FF;
                    u32x2 w; w.x = pk4_fp8(o0[0], o0[1], o0[2], o0[3]); w.y = pk4_fp8(o1[0], o1[1], o1[2], o1[3]); *(u32x2*)(hp + ocol) = w; }
                else { bf16* hp = (row < H_SPLIT_TILES * BM) ? H0 + (size_t)row * FF : H1 + (size_t)(row - H_SPLIT_TILES * BM) * FF;
                    *(u32x4*)(hp + ocol) = pack8(o0, o1); } }
    }
};
struct EpiDown {
    static constexpr bool PRE = true; static constexpr int NSTORES = 8;
    bf16* Y; const float* bd;
    __device__ __forceinline__ void pre(const Unit& u, LAS float* ec, int wc, int lane) const {
        glds4(bd + (size_t)u.e * D + u.pn * BM + wc * 64 + lane, ec); }
    __device__ __forceinline__ void operator()(const f32x4 (&acc)[2][2][4][2], const Unit& u, int wr, int wc, int fr, int fq, const LAS float* ec) const {
        static_assert(kActFp8, "Y rows are fp8");
        f32x4 b0[2], b1[2];
#pragma unroll
        for (int bj = 0; bj < 2; ++bj) { b0[bj] = *(const LAS f32x4*)(ec + 16 * fq + 8 * bj); b1[bj] = *(const LAS f32x4*)(ec + 16 * fq + 8 * bj + 4); }
        int rb_ = wr * 64 + fr; asm volatile("" : "+v"(rb_));
        unsigned char* const yb = (unsigned char*)Y + u.pn * BM + wc * 64 + 16 * fq;
#pragma unroll
        for (int ai = 0; ai < 2; ++ai)
#pragma unroll
            for (int m = 0; m < 4; ++m) { const int row = u.pm * BM + ai * HALF + m * 16 + rb_; u32x4 o;
                { const f32x4 v0 = acc[ai][0][m][0] * (1.f / MOE_WSCALE) + b0[0], v1 = acc[ai][0][m][1] * (1.f / MOE_WSCALE) + b1[0]; o.x = pk4_fp8(v0[0], v0[1], v0[2], v0[3]); o.y = pk4_fp8(v1[0], v1[1], v1[2], v1[3]); }
                { const f32x4 v0 = acc[ai][1][m][0] * (1.f / MOE_WSCALE) + b0[1], v1 = acc[ai][1][m][1] * (1.f / MOE_WSCALE) + b1[1]; o.z = pk4_fp8(v0[0], v0[1], v0[2], v0[3]); o.w = pk4_fp8(v1[0], v1[1], v1[2], v1[3]); }
                *(u32x4*)(yb + (size_t)row * D) = o; }
    }
};
}

constexpr int RING_BYTES = 131072;
constexpr int LDSCTL_OFF = RING_BYTES;
constexpr int LDS_BYTES = 163840;
constexpr int MISC_OFF = LDS_BYTES - 128;

#define XB_TMO      128
#define XB_XCNT(j)  (256  + 64 * (j))
#define XB_XSUB(j)  (1280 + 64 * (j))
#define XB_XGEN(j)  (2304 + 64 * (j))
#define XB_TOP      3328
#define XB_TOPGEN   3392
#define XCD_BAR_WORDS 3456
#define XB_SPIN_CAP (1u << 22)
__device__ __forceinline__ unsigned xb_ld(unsigned* p)              { return __hip_atomic_load(p, __ATOMIC_RELAXED, __HIP_MEMORY_SCOPE_AGENT); }
__device__ __forceinline__ unsigned xb_add(unsigned* p, unsigned v) { return __hip_atomic_fetch_add(p, v, __ATOMIC_RELAXED, __HIP_MEMORY_SCOPE_AGENT); }
__device__ __forceinline__ unsigned xb_xcc_id() { return (unsigned)__builtin_amdgcn_s_getreg((3 << 11) | 20) & 0xFu; }
#define XB_SPIN(cond, bar) do { unsigned _sp = 0; while (cond) { __builtin_amdgcn_s_sleep(1); \
    if ((++_sp & 255u) == 0u) { if (xb_ld(&(bar)[XB_TMO])) break; if (_sp > XB_SPIN_CAP) { atomicAdd(&(bar)[XB_TMO], 1u); break; } } } } while (0)
struct XcdBarrier { unsigned* bar; unsigned x; volatile LAS unsigned* st; };
__device__ __forceinline__ XcdBarrier xcd_barrier_post(unsigned* bar, volatile LAS unsigned* st) {
    XcdBarrier b; b.bar = bar; b.x = xb_xcc_id(); b.st = st;
    if (threadIdx.x == 0) (void)xb_add(&bar[XB_XCNT(b.x)], 1u);
    return b;
}
__device__ __forceinline__ void xcd_barrier_complete(unsigned* bar, unsigned x, unsigned& nloc, unsigned& nx) {
    const unsigned G = gridDim.x * gridDim.y * gridDim.z;
    unsigned sum, cnt, mine, sp = 0u;
    for (;;) {
        sum = 0u; cnt = 0u; mine = 0u;
#pragma unroll
        for (unsigned j = 0; j < 16; ++j) { const unsigned c = xb_ld(&bar[XB_XCNT(j)]); sum += c; cnt += (c > 0u) ? 1u : 0u; mine = (j == x) ? c : mine; }
        if (sum == G) break;
        __builtin_amdgcn_s_sleep(1);
        if ((++sp & 255u) == 0u) { if (xb_ld(&bar[XB_TMO])) break; if (sp > XB_SPIN_CAP) { atomicAdd(&bar[XB_TMO], 1u); break; } }
    }
    nloc = mine > 0u ? mine : 1u; nx = cnt > 0u ? cnt : 1u;
}
__device__ __forceinline__ void xcd_barrier(const XcdBarrier& b) {
    asm volatile("s_waitcnt vmcnt(0)" ::: "memory");
    __syncthreads();
    if (threadIdx.x == 0) {
        unsigned* bar = b.bar;
        __builtin_amdgcn_s_waitcnt(0);
        unsigned nloc = b.st[0], nx = b.st[1];
        if (nloc == 0u) { xcd_barrier_complete(bar, b.x, nloc, nx); b.st[0] = nloc; b.st[1] = nx; }
        const unsigned old = xb_add(&bar[XB_XSUB(b.x)], 1u);
        const unsigned gen = old / nloc;
        if (old + 1u == (gen + 1u) * nloc) {
            __builtin_amdgcn_fence(__ATOMIC_RELEASE, "agent");
            asm volatile("s_waitcnt vmcnt(0)" ::: "memory");
            const unsigned og = xb_add(&bar[XB_TOP], 1u);
            const unsigned tg = og / nx;
            if (og + 1u == (tg + 1u) * nx) xb_add(&bar[XB_TOPGEN], 1u);
            else XB_SPIN(xb_ld(&bar[XB_TOPGEN]) == tg, bar);
            __builtin_amdgcn_fence(__ATOMIC_ACQUIRE, "agent");
            xb_add(&bar[XB_XGEN(b.x)], 1u);
            asm volatile("s_waitcnt vmcnt(0)" ::: "memory");
        } else {
            XB_SPIN(xb_ld(&bar[XB_XGEN(b.x)]) == gen, bar);
            __builtin_amdgcn_fence(__ATOMIC_ACQUIRE, "agent");
            asm volatile("s_waitcnt vmcnt(0)" ::: "memory");
        }
    }
    __syncthreads();
}

struct Args { const float* in[27]; float* out; unsigned char* ws; int ph_lo, ph_hi; };
enum { I_X = 0, I_C, I_CTX, I_CCTX, I_WADA, I_BADA, I_GPREMIX, I_GPOSTMIX, I_GPREFFN, I_GPOSTFFN, I_WIN, I_HLB, I_HNW, I_GKW2, I_GKB, I_GNW, I_WUPA, I_WUPB, I_WO, I_WR, I_BR, I_WG, I_BG, I_WU, I_BU, I_WDN, I_BDN };
struct Frame { LAS unsigned char* lds; int tid, lane, wave, vcu, G; const Args* a; };

__device__ __forceinline__ void transpose_item(const float* src, int ld, bf16* dst, int dpitch, LAS float* scr, int lane) {
    float tv[32];
#pragma unroll
    for (int i = 0; i < 32; ++i) tv[i] = __builtin_nontemporal_load(src + (size_t)(2 * i + (lane >> 5)) * ld + (lane & 31));
#pragma unroll
    for (int i = 0; i < 32; ++i) scr[(2 * i + (lane >> 5)) * 33 + (lane & 31)] = tv[i];
    LDS_WAIT(); asm volatile("" ::: "memory");
    const int c = lane & 7;
#pragma unroll
    for (int j = 0; j < 4; ++j) { const int n = (lane >> 3) + 8 * j; const LAS float* s = scr + (8 * c) * 33 + n;
        u32x4 o; o.x = pk2(s[0 * 33], s[1 * 33]); o.y = pk2(s[2 * 33], s[3 * 33]); o.z = pk2(s[4 * 33], s[5 * 33]); o.w = pk2(s[6 * 33], s[7 * 33]);
        *(u32x4*)(dst + (size_t)n * dpitch + 8 * c) = o; }
    LDS_WAIT(); asm volatile("" ::: "memory");
}

__device__ __forceinline__ void transpose_item_fp8(const float* src, int ld, unsigned char* dst, int dpitch, LAS float* scr, int lane, float sc) {
    float tv[32];
#pragma unroll
    for (int i = 0; i < 32; ++i) tv[i] = __builtin_nontemporal_load(src + (size_t)(2 * i + (lane >> 5)) * ld + (lane & 31));
#pragma unroll
    for (int i = 0; i < 32; ++i) scr[(2 * i + (lane >> 5)) * 33 + (lane & 31)] = tv[i];
    LDS_WAIT(); asm volatile("" ::: "memory");
    const int c = lane & 7;
#pragma unroll
    for (int j = 0; j < 4; ++j) { const int n = (lane >> 3) + 8 * j; const LAS float* s = scr + (8 * c) * 33 + n;
        u32x2 o; o.x = pk4_fp8(s[0 * 33] * sc, s[1 * 33] * sc, s[2 * 33] * sc, s[3 * 33] * sc); o.y = pk4_fp8(s[4 * 33] * sc, s[5 * 33] * sc, s[6 * 33] * sc, s[7 * 33] * sc);
        *(u32x2*)(dst + (size_t)n * dpitch + 8 * c) = o; }
    LDS_WAIT(); asm volatile("" ::: "memory");
}

__device__ __forceinline__ int inproj_src_col(int n) {
    const int t = n >> 8, rho = n & 255;
    if (t < 12) { const int a = 2 * (rho >> 7) + ((rho >> 2) & 1), cc = 16 * ((rho >> 5) & 3) + 4 * ((rho >> 3) & 3) + (rho & 3);
        if (t < 8) return a * 512 + (t >> 1) * 128 + (t & 1) * 64 + cc;
        const int h = t - 8; if (a == 0) return 2560 + h * 64 + cc; if (a == 1) return 2816 + h * 64 + cc; return -1 - ((a - 2) * 256 + h * 64 + cc); }
    if (t < 14) return 3072 + (n - 12 * 256);
    if (t < 16) return 2048 + (n - 14 * 256);
    return 3616 + (n - 16 * 256);
}
__device__ __forceinline__ void transpose_item_cols(const float* Wk, int ld, int col, bf16* dst, int dpitch, LAS float* scr, int lane) {
    float tv[32];
#pragma unroll
    for (int i = 0; i < 32; ++i) tv[i] = Wk[(size_t)(2 * i + (lane >> 5)) * ld + col];
#pragma unroll
    for (int i = 0; i < 32; ++i) scr[(2 * i + (lane >> 5)) * 33 + (lane & 31)] = tv[i];
    LDS_WAIT(); asm volatile("" ::: "memory");
    const int c = lane & 7;
#pragma unroll
    for (int j = 0; j < 4; ++j) { const int n = (lane >> 3) + 8 * j; const LAS float* s = scr + (8 * c) * 33 + n;
        u32x4 o; o.x = pk2(s[0 * 33], s[1 * 33]); o.y = pk2(s[2 * 33], s[3 * 33]); o.z = pk2(s[4 * 33], s[5 * 33]); o.w = pk2(s[6 * 33], s[7 * 33]);
        *(u32x4*)(dst + (size_t)n * dpitch + 8 * c) = o; }
    LDS_WAIT(); asm volatile("" ::: "memory");
}

__device__ __forceinline__ void p0_mod(const Frame& F, int item) {
    const Args& A = *F.a;
    LAS float* sc = (LAS float*)F.lds; LAS float* part = sc + 17 * 1024;
    const float* wp = A.in[I_WADA] + (size_t)(F.wave * 128) * 6144 + item * 64 + F.lane;
    float wv[32], wn[32];
#pragma unroll
    for (int i = 0; i < 32; ++i) wv[i] = wp[(size_t)i * 6144];
    for (int i = F.tid; i < 17 * 1024; i += NTHREADS) { const int r = i >> 10, k = i & 1023; const float v = (r < 16) ? A.in[I_C][r * 1024 + k] : A.in[I_CCTX][k]; sc[i] = v * sigmoidf_(v); }
    __syncthreads();
    const int k0 = F.wave * 128;
    float acc[17];
#pragma unroll
    for (int r = 0; r < 17; ++r) acc[r] = 0.f;
#pragma unroll
    for (int bq = 0; bq < 4; ++bq) {
        if (bq < 3) {
#pragma unroll
            for (int i = 0; i < 32; ++i) wn[i] = wp[(size_t)(32 * (bq + 1) + i) * 6144]; }
#pragma unroll
        for (int i4 = 0; i4 < 8; ++i4) { const int k = k0 + 32 * bq + 4 * i4;
#pragma unroll
            for (int r = 0; r < 17; ++r) { const f32x4 s = *(const LAS f32x4*)(sc + r * 1024 + k); acc[r] += s.x * wv[4 * i4] + s.y * wv[4 * i4 + 1] + s.z * wv[4 * i4 + 2] + s.w * wv[4 * i4 + 3]; } }
        if (bq < 3) {
#pragma unroll
            for (int i = 0; i < 32; ++i) wv[i] = wn[i]; }
    }
#pragma unroll
    for (int r = 0; r < 17; ++r) part[(F.wave * 17 + r) * 64 + F.lane] = acc[r];
    __syncthreads();
    float* mod = (float*)(A.ws + WS_MOD);
    for (int i = F.tid; i < 17 * 64; i += NTHREADS) { const int r = i >> 6, l = i & 63; float s = A.in[I_BADA][item * 64 + l];
#pragma unroll
        for (int w = 0; w < 8; ++w) s += part[(w * 17 + r) * 64 + l];
        mod[r * 6144 + item * 64 + l] = s; }
    __syncthreads();
}

__device__ __forceinline__ void p0_prologue(const Frame& F) {
    const Args& A = *F.a;
    if (F.vcu < 96) p0_mod(F, F.vcu);
    LAS float* scr = (LAS float*)(F.lds + F.wave * 16384);
    const int gw = F.vcu * NWAVES + F.wave, NGW = F.G * NWAVES;
    bf16* win_t = (bf16*)(A.ws + WS_WIN);
    constexpr int I_WIN_ITEMS = 16 * 208, I_WU = 8 * 32, I_WO_ITEMS = 16 * 32;
    for (int it = gw; it < I_WIN_ITEMS + 2 * I_WU + I_WO_ITEMS; it += NGW) {
        int r = it;
        if (r < I_WIN_ITEMS) { const int kb = r / 208, nb = r % 208, n0 = nb * 32;
            if (n0 < NT_HI * 256) { const int col = inproj_src_col(n0 + (F.lane & 31)); if (col < 0) continue;
                transpose_item_cols(A.in[I_WIN] + (size_t)(64 * kb) * IN_DIM, IN_DIM, col, win_t + (size_t)n0 * D + 64 * kb, D, scr, F.lane); }
            else { const int jl = n0 - NT_HI * 256; const float* sp = A.in[I_WIN] + (size_t)(64 * kb) * IN_DIM + (jl < 512 ? 2048 + jl : jl < 1024 ? 3616 + (jl - 512) : 4128 + (jl - 1024));
                if constexpr (kInFp8) transpose_item_fp8(sp, IN_DIM, (unsigned char*)(A.ws + WS_WIN_LO) + (size_t)(n0 - NT_HI * 256) * D + 64 * kb, D, scr, F.lane, IN_WSCALE);
                else transpose_item(sp, IN_DIM, (bf16*)(A.ws + WS_WIN_LO) + (size_t)(n0 - NT_HI * 256) * D + 64 * kb, D, scr, F.lane); }
            continue; }
        r -= I_WIN_ITEMS;
        if (r < I_WU) { const int kb = r / 32, nb = r % 32; transpose_item(A.in[I_WUPA] + (size_t)(64 * kb) * D + 32 * nb, D, (bf16*)(A.ws + WS_WUA) + (size_t)(32 * nb) * 1024 + 64 * kb, 1024, scr, F.lane); continue; }
        r -= I_WU;
        if (r < I_WU) { const int kb = r / 32, nb = r % 32; transpose_item(A.in[I_WUPB] + (size_t)(64 * kb) * D + 32 * nb, D, (bf16*)(A.ws + WS_WUA) + (size_t)(32 * nb) * 1024 + 512 + 64 * kb, 1024, scr, F.lane); continue; }
        r -= I_WU;
        { const int kb = r / 32, nb = r % 32; transpose_item(A.in[I_WO] + (size_t)(64 * kb) * D + 32 * nb, D, (bf16*)(A.ws + WS_WO) + (size_t)(32 * nb) * D + 64 * kb, D, scr, F.lane); }
    }
    const int gt = F.vcu * NTHREADS + F.tid, NGT = F.G * NTHREADS;
    for (int it = gt; it < 2 * 256 * 128; it += NGT) {
        const int k8 = it & 127, n = (it >> 7) & 255, dir = it >> 15;
        float w2[16];
#pragma unroll
        for (int r = 0; r < 16; ++r) w2[r] = A.in[I_GKW2][(dir * 16 + r) * 256 + n];
        float o[8];
#pragma unroll
        for (int kk = 0; kk < 8; ++kk) { const float* wr = A.in[I_WIN] + (size_t)(k8 * 8 + kk) * IN_DIM + 3584 + 16 * dir; float s = 0.f;
#pragma unroll
            for (int r4 = 0; r4 < 4; ++r4) { const f32x4 w = *(const f32x4*)(wr + 4 * r4); s += w.x * w2[4 * r4] + w.y * w2[4 * r4 + 1] + w.z * w2[4 * r4 + 2] + w.w * w2[4 * r4 + 3]; }
            o[kk] = s; }
        { u32x4 pk; pk.x = pk2(o[0], o[1]); pk.y = pk2(o[2], o[3]); pk.z = pk2(o[4], o[5]); pk.w = pk2(o[6], o[7]);
            const int cc = n & 63, rho = 128 + 32 * (cc >> 4) + 8 * ((cc >> 2) & 3) + 4 * dir + (cc & 3);
            *(u32x4*)(win_t + (size_t)(256 * (8 + (n >> 6)) + rho) * D + k8 * 8) = pk; }
    }
    bf16* wrb = (bf16*)(A.ws + WS_WRT);
    for (int it = gt; it < NE * D; it += NGT) { const int e = it >> 10, k = it & 1023; wrb[it] = (bf16)f2bf(A.in[I_WR][k * NE + e]); }
}

template <int WHICH> __device__ __forceinline__ void convert_expert_weights(const Frame& F) {
    static_assert(kMoeFp8, "fp8 expert weights");
    const Args& A = *F.a;
    LAS float* scr = (LAS float*)(F.lds + F.wave * 16384);
    const int gw = F.vcu * NWAVES + F.wave, NGW = F.G * NWAVES, lane = F.lane;
    constexpr int PER_E = WHICH == 0 ? 16 * 64 : 16 * 32, NIT = NE * PER_E;
    auto item = [&](int it, const float*& src, unsigned char*& dst) { const int e = it / PER_E, r = it % PER_E;
        if (WHICH == 0) { const int kb = r / 64, nb = r % 64, n0 = 32 * nb, pn = n0 >> 8, rr = n0 & 255;
            src = (rr < 128 ? A.in[I_WG] : A.in[I_WU]) + (size_t)e * D * FF + (size_t)(64 * kb) * FF + 128 * pn + (rr & 127);
            dst = A.ws + WS_WGU + (size_t)e * 2048 * D + (size_t)n0 * D + 64 * kb; }
        else { const int kb = r / 32, nb = r % 32; src = A.in[I_WDN] + (size_t)e * FF * D + (size_t)(64 * kb) * D + 32 * nb;
            dst = A.ws + WS_WD + (size_t)e * D * FF + (size_t)(32 * nb) * FF + 64 * kb; } };
    constexpr int ld = 1024;
    float tv[32], tn[32]; const float* src; unsigned char* dst; int it = gw;
    if (it < NIT) { item(it, src, dst);
#pragma unroll
        for (int i = 0; i < 32; ++i) tv[i] = __builtin_nontemporal_load(src + (size_t)(2 * i + (lane >> 5)) * ld + (lane & 31)); }
    while (it < NIT) {
        const int itn = it + NGW; const float* srcn = src; unsigned char* dstn = dst;
        if (itn < NIT) { item(itn, srcn, dstn);
#pragma unroll
            for (int i = 0; i < 32; ++i) tn[i] = __builtin_nontemporal_load(srcn + (size_t)(2 * i + (lane >> 5)) * ld + (lane & 31)); }
#pragma unroll
        for (int i = 0; i < 32; ++i) scr[(2 * i + (lane >> 5)) * 33 + (lane & 31)] = tv[i];
        LDS_WAIT(); asm volatile("" ::: "memory");
        { const int c = lane & 7;
#pragma unroll
          for (int j = 0; j < 4; ++j) { const int n = (lane >> 3) + 8 * j; const LAS float* s = scr + (8 * c) * 33 + n;
              u32x2 o; o.x = pk4_fp8(s[0 * 33] * MOE_WSCALE, s[1 * 33] * MOE_WSCALE, s[2 * 33] * MOE_WSCALE, s[3 * 33] * MOE_WSCALE);
              o.y = pk4_fp8(s[4 * 33] * MOE_WSCALE, s[5 * 33] * MOE_WSCALE, s[6 * 33] * MOE_WSCALE, s[7 * 33] * MOE_WSCALE);
              *(u32x2*)(dst + (size_t)n * D + 8 * c) = o; } }
        LDS_WAIT(); asm volatile("" ::: "memory");
        if (itn < NIT) {
#pragma unroll
            for (int i = 0; i < 32; ++i) tv[i] = tn[i]; }
        src = srcn; dst = dstn; it = itn;
    }
}

__device__ __forceinline__ void p1_prenorm(const Frame& F) {
    const Args& A = *F.a;
    const int gw = F.vcu * NWAVES + F.wave, NGW = F.G * NWAVES;
    const float* mod = (const float*)(A.ws + WS_MOD); bf16* hbf = (bf16*)(A.ws + WS_HBF);
    for (int m = gw; m < MALL; m += NGW) {
        const float* xr = (m < TC) ? A.in[I_CTX] + (size_t)m * D : A.in[I_X] + (size_t)(m - TC) * D;
        const float* md = mod + (size_t)((m < TC) ? 16 : (m - TC) / SEQ) * 6144;
        f32x4 v[4]; float ss = 0.f;
#pragma unroll
        for (int j = 0; j < 4; ++j) { v[j] = *((const f32x4*)xr + F.lane + 64 * j); ss += (v[j].x * v[j].x + v[j].y * v[j].y) + (v[j].z * v[j].z + v[j].w * v[j].w); }
        const float rstd = rsqrtf(wave_sum(ss) * (1.f / D) + EPS);
#pragma unroll
        for (int j = 0; j < 4; ++j) { const int k = 4 * (F.lane + 64 * j);
            const f32x4 g = *(const f32x4*)(A.in[I_GPREMIX] + k), sh = *(const f32x4*)(md + k), sc = *(const f32x4*)(md + 1024 + k);
            const f32x4 h = v[j] * rstd * g * (sc + 1.f) + sh;
            { u32x2 o; o.x = pk2(h.x, h.y); o.y = pk2(h.z, h.w); *((u32x2*)(hbf + (size_t)m * D) + F.lane + 64 * j) = o; }
            if (m >= TC) { if constexpr (kInFp8) *((unsigned*)((unsigned char*)A.out + (size_t)(m - TC) * D) + F.lane + 64 * j) = pk4_fp8(h.x, h.y, h.z, h.w);
                           else { u32x2 o; o.x = pk2(h.x, h.y); o.y = pk2(h.z, h.w); *((u32x2*)((bf16*)A.out + (size_t)(m - TC) * D) + F.lane + 64 * j) = o; } } }
    }
}

typedef short v4i16_t __attribute__((ext_vector_type(4)));
typedef short s16x4 __attribute__((ext_vector_type(4)));
__device__ __forceinline__ s16x4 lds_tr16(const LAS unsigned char* p) { return __builtin_bit_cast(s16x4, __builtin_amdgcn_ds_read_tr16_b64_v4i16((LAS v4i16_t*)p)); }
#define LBAR() do { asm volatile("s_waitcnt lgkmcnt(0)" ::: "memory"); __builtin_amdgcn_s_barrier(); asm volatile("" ::: "memory"); } while (0)

template <int DK, bool HGRN> __device__ __forceinline__ void scan_chain(const Frame& F, LAS unsigned char* L, int hv, int wl, int tl, bf16* obase) {
    const Args& A = *F.a;
    const float* ELg = (const float*)(A.ws + WS_EL);
    const int b = hv >> 3, h = (hv >> 1) & 3, dir = hv & 1;
    const int lane = tl & 63, l15 = lane & 15, g = lane >> 4;
    constexpr int PQ = DK * 2 + 16;
    constexpr int PV = 272;
    constexpr int PP = 144;
    constexpr int NCH = DK / 8;
    constexpr int NLD = DK / 64;
    constexpr int KS = DK / 32;
    LAS unsigned char* RQ = L;
    LAS unsigned char* RK = RQ + 64 * PQ;
    LAS unsigned char* VI = RK + 64 * PQ;
    LAS unsigned char* PI = VI + 64 * PV;
    constexpr int TSZ = 64 * DK * 2;
    const unsigned char* const qk0 = A.ws + (HGRN ? WS_RQA : WS_RQB) + (size_t)hv * NSTEP * 2 * TSZ;
    const unsigned char* const v0 = A.ws + (HGRN ? WS_RVA : WS_RVB) + (size_t)(hv >> 1) * NSTEP * 16384;
    const float* elp = ELg + (size_t)dir * NCG * 768 + (HGRN ? 0 : 512) + h * DK;
    f32x4 S[DK / 16];
#pragma unroll
    for (int i = 0; i < DK / 16; ++i) S[i] = (f32x4){0.f, 0.f, 0.f, 0.f};
    u32x4 rq[2][NLD], rk[2][NLD], rv[2][2], rel[2];
    LAS unsigned char* ELs = PI + 64 * PP;
#define SCAN_ISSUE(set, s_) do { const int s__ = (s_); const unsigned char* qt = qk0 + (size_t)s__ * 2 * TSZ; \
        _Pragma("unroll") for (int q = 0; q < NLD; ++q) { const int ci = tl + 512 * q; \
            if (s__ >= 4) rq[set][q] = *(const u32x4*)(qt + 16 * ci); \
            rk[set][q] = *(const u32x4*)(qt + TSZ + 16 * ci); } \
        { const int sm = dir ? (s__ < 4 ? 3 - s__ : 39 - s__) : s__; const unsigned char* vt = v0 + (size_t)sm * 16384; \
          _Pragma("unroll") for (int q = 0; q < 2; ++q) rv[set][q] = *(const u32x4*)(vt + 16 * (tl + 512 * q)); } \
        { const int mc = (s__ < 4) ? (dir ? 3 - s__ : s__) : (dir ? 35 - s__ : s__ - 4), cg = (s__ < 4) ? 4 * b + mc : TC / 64 + 32 * b + mc; \
          if (tl < DK / 4) rel[set] = *(const u32x4*)(elp + (size_t)cg * 768 + 4 * tl); } } while (0)
    SCAN_ISSUE(0, 0); SCAN_ISSUE(1, 1);
#pragma nounroll
    for (int s2 = 0; s2 < 36; s2 += 2) {
#pragma unroll
      for (int par = 0; par < 2; ++par) {
        const int s = s2 + par;
        const bool lat = s >= 4;
#pragma unroll
        for (int q = 0; q < NLD; ++q) { const int ci = tl + 512 * q, h2 = ci >> 9, wcc = (ci >> 7) & 3, t = (ci >> 1) & 63, hf = ci & 1;
            if (lat) { LAS unsigned char* qd = RQ + t * PQ + 64 * (2 * h2 + (wcc >> 1)) + 32 * hf + 8 * (wcc & 1);
                *(LAS u32x2*)qd = (u32x2){rq[par][q].x, rq[par][q].y}; *(LAS u32x2*)(qd + 16) = (u32x2){rq[par][q].z, rq[par][q].w}; }
            *(LAS u32x4*)(RK + t * PQ + 2 * (64 * h2 + 16 * wcc + 8 * hf)) = rk[par][q]; }
#pragma unroll
        for (int q = 0; q < 2; ++q) { const int ci = tl + 512 * q;
            if constexpr (HGRN) { const int h2 = ci >> 9, wcc = (ci >> 7) & 3, tm = (ci >> 1) & 63, hf = ci & 1, t = dir ? 63 - tm : tm; *(LAS u32x4*)(VI + t * PV + 2 * (64 * h2 + 16 * wcc + 8 * hf)) = rv[par][q]; }
            else { const int tm = ci >> 4, t = dir ? 63 - tm : tm, cc = ci & 15; *(LAS u32x4*)(VI + t * PV + 16 * cc) = rv[par][q]; } }
        if (tl < DK / 4) *(LAS u32x4*)(ELs + 16 * tl) = rel[par];
        LBAR();
        if (s + 2 < 36) SCAN_ISSUE(par, s + 2);
        bf16x8 Vf[2];
#pragma unroll
        for (int ks2 = 0; ks2 < 2; ++ks2) { const int q = l15 >> 2, p = l15 & 3;
            const s16x4 lo = lds_tr16(VI + (32 * ks2 + 8 * g + q) * PV + 32 * wl + 8 * p), hi = lds_tr16(VI + (32 * ks2 + 8 * g + 4 + q) * PV + 32 * wl + 8 * p);
            Vf[ks2] = (bf16x8){lo[0], lo[1], lo[2], lo[3], hi[0], hi[1], hi[2], hi[3]}; }
        if (lat) {
            const int ib = (0x12333210 >> (4 * wl)) & 15, jlo = (0x00102110 >> (4 * wl)) & 15, jhi = (0x00103210 >> (4 * wl)) & 15;
            bf16x8 Bq[KS];
#pragma unroll
            for (int ks = 0; ks < KS; ++ks) Bq[ks] = *(const LAS bf16x8*)(RQ + (16 * ib + l15) * PQ + 64 * ks + 16 * g);
#pragma unroll
            for (int jt = 0; jt < 4; ++jt) { if (jt >= jlo && jt <= jhi) {
                f32x4 acc = (f32x4){0.f, 0.f, 0.f, 0.f};
#pragma unroll
                for (int ks = 0; ks < KS; ++ks) { const LAS unsigned char* kp = RK + (16 * jt + l15) * PQ + 64 * ks + 8 * g;
                    const s16x4 lo = *(const LAS s16x4*)kp, hi = *(const LAS s16x4*)(kp + 32);
                    const bf16x8 Ak = (bf16x8){lo[0], lo[1], lo[2], lo[3], hi[0], hi[1], hi[2], hi[3]};
                    acc = __builtin_amdgcn_mfma_f32_16x16x32_bf16(Ak, Bq[ks], acc, 0, 0, 0); }
                if (jt == ib) {
#pragma unroll
                    for (int r = 0; r < 4; ++r) if (4 * g + r > l15) acc[r] = 0.f; }
                u32x2 w; w.x = pk2(acc[0], acc[1]); w.y = pk2(acc[2], acc[3]);
                *(LAS u32x2*)(PI + (16 * ib + l15) * PP + 32 * jt + 8 * g) = w; } }
            if (wl == 0 || wl == 2) *(LAS u32x2*)(PI + (16 * wl + l15) * PP + 32 * (wl + 1) + 8 * g) = (u32x2){0u, 0u};
            LBAR();
            bf16x8 Sb[KS];
#pragma unroll
            for (int ks = 0; ks < KS; ++ks) { const f32x4 a = S[2 * ks], c = S[2 * ks + 1]; u32x4 w; w.x = pk2(a[0], a[1]); w.y = pk2(a[2], a[3]); w.z = pk2(c[0], c[1]); w.w = pk2(c[2], c[3]); Sb[ks] = __builtin_bit_cast(bf16x8, w); }
#pragma unroll
            for (int it = 0; it < 4; ++it) {
                f32x4 acc = (f32x4){0.f, 0.f, 0.f, 0.f};
                { const bf16x8 Pf = *(const LAS bf16x8*)(PI + (16 * it + l15) * PP + 16 * g); acc = __builtin_amdgcn_mfma_f32_16x16x32_bf16(Vf[0], Pf, acc, 0, 0, 0); }
                if (it >= 2) { const bf16x8 Pf = *(const LAS bf16x8*)(PI + (16 * it + l15) * PP + 64 + 16 * g); acc = __builtin_amdgcn_mfma_f32_16x16x32_bf16(Vf[1], Pf, acc, 0, 0, 0); }
#pragma unroll
                for (int ks = 0; ks < KS; ++ks) { const bf16x8 Bi = *(const LAS bf16x8*)(RQ + (16 * it + l15) * PQ + 64 * ks + 16 * g); acc = __builtin_amdgcn_mfma_f32_16x16x32_bf16(Sb[ks], Bi, acc, 0, 0, 0); }
                const int p = 64 * (s - 4) + 16 * it + l15, tok = dir ? SEQ - 1 - p : p;
                u32x2 w; w.x = pk2(acc[0], acc[1]); w.y = pk2(acc[2], acc[3]);
                *(u32x2*)(obase + ((size_t)dir * T + (size_t)b * SEQ + tok) * 512 + h * 128 + 16 * wl + 4 * g) = w;
            }
        }
#pragma unroll
        for (int dt = 0; dt < DK / 16; ++dt) {
#pragma unroll
            for (int ks2 = 0; ks2 < 2; ++ks2) { const int q = l15 >> 2, p = l15 & 3;
                const s16x4 lo = lds_tr16(RK + (32 * ks2 + 8 * g + q) * PQ + 32 * dt + 8 * p), hi = lds_tr16(RK + (32 * ks2 + 8 * g + 4 + q) * PQ + 32 * dt + 8 * p);
                const bf16x8 Kf = (bf16x8){lo[0], lo[1], lo[2], lo[3], hi[0], hi[1], hi[2], hi[3]};
                S[dt] = __builtin_amdgcn_mfma_f32_16x16x32_bf16(Kf, Vf[ks2], S[dt], 0, 0, 0); }
            S[dt] = S[dt] * *(const LAS f32x4*)(ELs + (16 * dt + 4 * g) * 4);
        }
        LBAR();
      }
    }
#undef SCAN_ISSUE
}

__device__ __forceinline__ void p4_readout(const Frame& F) {
    const Args& A = *F.a;
    const int gw = F.vcu * NWAVES + F.wave, NGW = F.G * NWAVES;
    const bf16* Z = (const bf16*)(A.ws + WS_Z); const bf16* O = (const bf16*)A.out;
    for (int it = gw; it < 2 * T; it += NGW) {
        const int br = it & 1, tok = it >> 1;
        const bf16* of = O + ((size_t)(br * 2 + 0) * T + tok) * 512 + 8 * F.lane; const bf16* ob = O + ((size_t)(br * 2 + 1) * T + tok) * 512 + 8 * F.lane;
        const u32x4 wf = *(const u32x4*)of, wb = *(const u32x4*)ob, wg = *(const u32x4*)(Z + (size_t)tok * NZ + (br ? ZC_OGB : ZC_OGA) + 8 * F.lane);
        f32x4 a0, a1, b0, b1, g0, g1; pg8::unpack8(wf, a0, a1); pg8::unpack8(wb, b0, b1); pg8::unpack8(wg, g0, g1);
        a0 += b0; a1 += b1;
        float ss = (a0.x * a0.x + a0.y * a0.y) + (a0.z * a0.z + a0.w * a0.w) + (a1.x * a1.x + a1.y * a1.y) + (a1.z * a1.z + a1.w * a1.w);
        ss += __shfl_xor(ss, 1); ss += __shfl_xor(ss, 2); ss += __shfl_xor(ss, 4); ss += __shfl_xor(ss, 8);
        const float rstd = rsqrtf(ss * (1.f / 128.f) + EPS);
        const float* nw = (br ? A.in[I_GNW] : A.in[I_HNW]) + (8 * F.lane & 127);
        const f32x4 n0 = *(const f32x4*)nw, n1 = *(const f32x4*)(nw + 4);
#pragma unroll
        for (int j = 0; j < 4; ++j) { a0[j] = a0[j] * rstd * n0[j] * (g0[j] * sigmoidf_(g0[j])); a1[j] = a1[j] * rstd * n1[j] * (g1[j] * sigmoidf_(g1[j])); }
        bf16* r = (bf16*)(A.ws + WS_RA) + (size_t)tok * 1024 + br * 512 + 8 * F.lane;
        *(u32x4*)r = pg8::pack8(a0, a1);
    }
}

__device__ __forceinline__ void load_row_bf16(const bf16* p, int lane, f32x4 (&v)[4]) {
#pragma unroll
    for (int j = 0; j < 4; ++j) { const u32x2 w = *((const u32x2*)p + lane + 64 * j); v[j] = (f32x4){bflo(w.x), bfhi(w.x), bflo(w.y), bfhi(w.y)}; }
}
__device__ __forceinline__ void load_row_fp8(const unsigned char* p, int lane, f32x4 (&v)[4]) {
#pragma unroll
    for (int j = 0; j < 4; ++j) { const int w = *((const int*)p + lane + 64 * j); const f32x2 a = __builtin_amdgcn_cvt_pk_f32_fp8(w, false), b = __builtin_amdgcn_cvt_pk_f32_fp8(w, true); v[j] = (f32x4){a.x, a.y, b.x, b.y}; }
}
template <bool F8> __device__ __forceinline__ void load_row_act(const void* base, size_t row, int lane, f32x4 (&v)[4]) {
    if constexpr (F8) load_row_fp8((const unsigned char*)base + row * D, lane, v); else load_row_bf16((const bf16*)base + row * D, lane, v);
}
__device__ __forceinline__ float sumsq4(const f32x4 (&v)[4]) { float s = 0.f;
#pragma unroll
    for (int j = 0; j < 4; ++j) s += (v[j].x * v[j].x + v[j].y * v[j].y) + (v[j].z * v[j].z + v[j].w * v[j].w);
    return s; }
__device__ __forceinline__ void compute_x1(const Args& A, int tok, int lane, const float* md, f32x4 (&x1)[4]) {
    f32x4 mx[4]; load_row_act<kMixFp8>(A.ws + WS_MIXB, (size_t)tok, lane, mx);
    const float rstd = rsqrtf(wave_sum(sumsq4(mx)) * (1.f / D) + EPS);
#pragma unroll
    for (int j = 0; j < 4; ++j) { const int k = 4 * (lane + 64 * j);
        const f32x4 xv = *(const f32x4*)(A.in[I_X] + (size_t)tok * D + k), g = *(const f32x4*)(A.in[I_GPOSTMIX] + k), gt = *(const f32x4*)(md + 2048 + k);
        x1[j] = xv + gt * (mx[j] * rstd * g); }
}

__device__ __forceinline__ void p8_router(const Frame& F) {
    const Args& A = *F.a;
    constexpr int WP = 2064;
    LAS unsigned char* WL = F.lds;
    LAS unsigned char* HB = WL + 32 * WP;
    LAS float* LG = (LAS float*)(HB + 16 * WP);
    int* hist = (int*)((unsigned char*)F.lds + 32 * WP + 16 * WP + 16 * 33 * 4);
    const u32x4* wrb = (const u32x4*)(A.ws + WS_WRT);
#pragma unroll
    for (int q = 0; q < 8; ++q) { const int i = F.tid + NTHREADS * q; *(LAS u32x4*)(WL + (i >> 7) * WP + 16 * (i & 127)) = wrb[i]; }
    if (F.tid < NE) hist[F.tid] = 0;
    __syncthreads();
    const float* mod = (const float*)(A.ws + WS_MOD); unsigned char* h2b = (unsigned char*)(A.ws + WS_H2);
    int* topi = (int*)(A.ws + WS_TOPI); float* topp = (float*)(A.ws + WS_TOPP); int* lrank = (int*)(A.ws + WS_LRANK);
    static_assert(kMoeFp8, "the router phase writes fp8 h2 rows");
    if (F.vcu == 0 && F.wave == 0) {
#pragma unroll
        for (int j = 0; j < 4; ++j) *((unsigned*)(h2b + (size_t)T * D) + F.lane + 64 * j) = 0u; }
    const int l15 = F.lane & 15, g = F.lane >> 4;
    for (int r = 0; r < 8; ++r) {
        const int base = 128 * F.vcu + 16 * r;
#pragma unroll
        for (int q = 0; q < 2; ++q) { const int row = 2 * F.wave + q, tok = base + row; const float* md = mod + (size_t)(tok / SEQ) * 6144;
            f32x4 x1[4]; compute_x1(A, tok, F.lane, md, x1);
            const float rstd = rsqrtf(wave_sum(sumsq4(x1)) * (1.f / D) + EPS);
#pragma unroll
            for (int j = 0; j < 4; ++j) { const int k = 4 * (F.lane + 64 * j);
                { u32x2 o; o.x = pk2(x1[j].x, x1[j].y); o.y = pk2(x1[j].z, x1[j].w); *((u32x2*)((bf16*)(A.ws + WS_X1B) + (size_t)tok * D) + F.lane + 64 * j) = o; }
                const f32x4 gg = *(const f32x4*)(A.in[I_GPREFFN] + k), sh = *(const f32x4*)(md + 3072 + k), sc = *(const f32x4*)(md + 4096 + k);
                const f32x4 h = x1[j] * rstd * gg * (sc + 1.f) + sh;
                *((unsigned*)(h2b + (size_t)tok * D) + F.lane + 64 * j) = pk4_fp8(h.x, h.y, h.z, h.w);
                u32x2 o; o.x = pk2(h.x, h.y); o.y = pk2(h.z, h.w); *(LAS u32x2*)(HB + row * WP + 8 * (F.lane + 64 * j)) = o; } }
        LBAR();
        if (F.wave < 2) { const int n = F.wave; f32x4 acc = (f32x4){0.f, 0.f, 0.f, 0.f};
#pragma unroll 8
            for (int ks = 0; ks < 32; ++ks) { const bf16x8 a = *(const LAS bf16x8*)(HB + l15 * WP + 64 * ks + 16 * g), bb = *(const LAS bf16x8*)(WL + (16 * n + l15) * WP + 64 * ks + 16 * g);
                acc = __builtin_amdgcn_mfma_f32_16x16x32_bf16(a, bb, acc, 0, 0, 0); }
            const float bias = A.in[I_BR][16 * n + l15];
#pragma unroll
            for (int rr = 0; rr < 4; ++rr) LG[(4 * g + rr) * 33 + 16 * n + l15] = acc[rr] + bias; }
        LBAR();
        if (F.wave == 2 && F.lane < 16) { const int tok = base + F.lane;
            float v0 = -INFINITY, v1 = -INFINITY, v2 = -INFINITY, v3 = -INFINITY; int i0 = 0, i1 = 0, i2 = 0, i3 = 0;
#pragma unroll 8
            for (int e = 0; e < NE; ++e) { const float x = LG[F.lane * 33 + e]; const bool c0 = x > v0, c1 = x > v1, c2 = x > v2, c3 = x > v3;
                v3 = c3 ? (c2 ? v2 : x) : v3; i3 = c3 ? (c2 ? i2 : e) : i3; v2 = c2 ? (c1 ? v1 : x) : v2; i2 = c2 ? (c1 ? i1 : e) : i2;
                v1 = c1 ? (c0 ? v0 : x) : v1; i1 = c1 ? (c0 ? i0 : e) : i1; v0 = c0 ? x : v0; i0 = c0 ? e : i0; }
            const float e1 = __expf(v1 - v0), e2 = __expf(v2 - v0), e3 = __expf(v3 - v0), inv = 1.f / (1.f + e1 + e2 + e3);
            *(i32x4*)(topi + tok * 4) = (i32x4){i0, i1, i2, i3}; *(f32x4*)(topp + tok * 4) = (f32x4){inv, e1 * inv, e2 * inv, e3 * inv};
            i32x4 lr; lr.x = __hip_atomic_fetch_add(hist + i0, 1, __ATOMIC_RELAXED, __HIP_MEMORY_SCOPE_WORKGROUP); lr.y = __hip_atomic_fetch_add(hist + i1, 1, __ATOMIC_RELAXED, __HIP_MEMORY_SCOPE_WORKGROUP);
            lr.z = __hip_atomic_fetch_add(hist + i2, 1, __ATOMIC_RELAXED, __HIP_MEMORY_SCOPE_WORKGROUP); lr.w = __hip_atomic_fetch_add(hist + i3, 1, __ATOMIC_RELAXED, __HIP_MEMORY_SCOPE_WORKGROUP);
            *(i32x4*)(lrank + tok * 4) = lr; }
    }
    __syncthreads();
    if (F.tid < NE) { unsigned* gc = (unsigned*)(A.ws + WS_CTL) + CW_GCOUNT; const int basec = (int)__hip_atomic_fetch_add(gc + F.tid, (unsigned)hist[F.tid], RLX_AGENT);
        ((int*)(A.ws + WS_BLKBASE))[F.vcu * NE + F.tid] = basec; }
    __syncthreads();
}

__device__ __forceinline__ void p9_slots(const Frame& F) {
    const Args& A = *F.a;
    int* ps = (int*)((unsigned char*)F.lds); int* cn = ps + 64;
    const unsigned* gc = (const unsigned*)(A.ws + WS_CTL) + CW_GCOUNT;
    if (F.tid < NE) cn[F.tid] = (int)__hip_atomic_load(gc + F.tid, RLX_AGENT);
    __syncthreads();
    if (F.tid == 0) { int acc = 0; for (int e = 0; e < NE; ++e) { ps[e] = acc; acc += (cn[e] + 255) & ~255; } ps[NE] = acc; }
    __syncthreads();
    const int* topi = (const int*)(A.ws + WS_TOPI); const int* lrank = (const int*)(A.ws + WS_LRANK); const int* blkbase = (const int*)(A.ws + WS_BLKBASE);
    int* pslot = (int*)(A.ws + WS_PSLOT); int* tokslot = (int*)(A.ws + WS_TOKSLOT);
    for (int p = F.vcu * NTHREADS + F.tid; p < T * TOPK; p += F.G * NTHREADS) {
        const int tok = p >> 2, e = topi[p], slot = ps[e] + blkbase[(tok >> 7) * NE + e] + lrank[p];
        tokslot[slot] = tok; pslot[p] = slot; }
    if (F.vcu < NE) { const int e = F.vcu, pad = ((cn[e] + 255) & ~255); for (int i = cn[e] + F.tid; i < pad; i += NTHREADS) tokslot[ps[e] + i] = T; }
    if (F.vcu == NE) { const int ntile = ps[NE] >> 8; int* tile_e = (int*)(A.ws + WS_TILEE);
        for (int t = F.tid; t < MAXTILES; t += NTHREADS) { int e = 0; for (int q = 0; q < NE; ++q) if (t * 256 >= ps[q]) e = q; tile_e[t] = (t < ntile) ? e : 0; }
        if (F.tid == 0) ((int*)(A.ws + WS_CTL))[CW_NT] = ntile; }
    __syncthreads();
}

__device__ __forceinline__ void p12_final(const Frame& F) {
    const Args& A = *F.a;
    const int gw = F.vcu * NWAVES + F.wave, NGW = F.G * NWAVES;
    const float* mod = (const float*)(A.ws + WS_MOD); const bf16* Y = (const bf16*)(A.ws + WS_Y);
    const int* pslot = (const int*)(A.ws + WS_PSLOT); const float* topp = (const float*)(A.ws + WS_TOPP);
    constexpr int NTK = 4;
    for (int tok0 = gw; tok0 < T; tok0 += NTK * NGW) {
        int tok[NTK]; i32x4 sl[NTK]; f32x4 pw[NTK];
#pragma unroll
        for (int q = 0; q < NTK; ++q) { tok[q] = tok0 + q * NGW; sl[q] = *(const i32x4*)(pslot + tok[q] * 4); pw[q] = *(const f32x4*)(topp + tok[q] * 4); }
        f32x4 x1[NTK][4], f[NTK][4];
#pragma unroll
        for (int q = 0; q < NTK; ++q) { load_row_bf16((const bf16*)(A.ws + WS_X1B) + (size_t)tok[q] * D, F.lane, x1[q]);
#pragma unroll
            for (int j = 0; j < 4; ++j) f[q][j] = (f32x4){0.f, 0.f, 0.f, 0.f};
#pragma unroll
            for (int k = 0; k < 4; ++k) { f32x4 y[4]; load_row_act<kActFp8>(Y, (size_t)sl[q][k], F.lane, y);
#pragma unroll
                for (int j = 0; j < 4; ++j) f[q][j] += y[j] * pw[q][k]; } }
#pragma unroll
        for (int q = 0; q < NTK; ++q) { const float* md = mod + (size_t)(tok[q] / SEQ) * 6144;
            const float rstd = rsqrtf(wave_sum(sumsq4(f[q])) * (1.f / D) + EPS);
#pragma unroll
            for (int j = 0; j < 4; ++j) { const int k = 4 * (F.lane + 64 * j);
                const f32x4 g = *(const f32x4*)(A.in[I_GPOSTFFN] + k), gt = *(const f32x4*)(md + 5120 + k);
                *(f32x4*)(A.out + (size_t)tok[q] * D + k) = x1[q][j] + gt * (f[q][j] * rstd * g); } }
    }
}

constexpr int NPHASES = 12;
__global__ void __launch_bounds__(NTHREADS, 2) fwd_kernel(Args args) {
    extern __shared__ __attribute__((aligned(16))) unsigned char lds_raw[];
    Frame F; F.lds = (LAS unsigned char*)lds_raw; F.tid = threadIdx.x; F.lane = F.tid & 63; F.wave = __builtin_amdgcn_readfirstlane(F.tid >> 6);
    F.G = gridDim.x; { const int bx = blockIdx.x; F.vcu = (F.G % 8 == 0) ? (bx % 8) * (F.G / 8) + bx / 8 : bx; } F.a = &args;
    volatile LAS unsigned* MISC = (volatile LAS unsigned*)(F.lds + MISC_OFF);
    for (int u = F.tid; u < (LDS_BYTES - LDSCTL_OFF) / 4; u += NTHREADS) ((LAS unsigned*)(F.lds + LDSCTL_OFF))[u] = 0u;
    __syncthreads();
    unsigned char* ws = args.ws;
    unsigned* ctl = (unsigned*)(ws + WS_CTL);
    const int lo = args.ph_lo, hi = args.ph_hi;
    XcdBarrier bar; bar.bar = ctl + CW_BAR; bar.x = 0; bar.st = nullptr;
    if (hi - lo > 1) bar = xcd_barrier_post(ctl + CW_BAR, MISC + 8);
#define IN(k) (lo <= (k) && (k) < hi)
#define SEAM(k) do { if (IN(k) && IN((k) + 1)) xcd_barrier(bar); } while (0)
    const int bx = (int)blockIdx.x;

    if (IN(0)) { p0_prologue(F); } SEAM(0);
    if (IN(1)) { p1_prenorm(F); } SEAM(1);
    if (IN(2)) {
        const int nfirst = F.vcu & 1;
#pragma nounroll
        for (int pass = 0; pass < 3; ++pass) {
            if (pass == 1) { pg8::InprojOrder S{F.G, bx, (const char*)(ws + WS_HBF), (const char*)(ws + WS_WIN), (size_t)256 * 2048, (size_t)256 * 2048};
                pg8::EpiInproj E{(bf16*)(ws + WS_Z), ws, (float*)(ws + WS_EL), args.in[I_GKB], args.in[I_HLB], 0, 0, 1.f};
                pg8::gemm_phase<pg8::EpiInproj, pg8::InprojOrder, 0, true, false>(F.lds, 2048, S, E, nullptr, nullptr, S.A, S.B); }
            else { pg8::DenseOrder S; S.init(T, NT_LO * 256, IN_KB, F.G, bx, args.out, ws + WS_WIN_LO);
                if (pass == 0) S.hi = nfirst; else S.lo = nfirst;
                pg8::EpiInproj E{(bf16*)(ws + WS_Z), ws, (float*)(ws + WS_EL), args.in[I_GKB], args.in[I_HLB], TC / 256, NT_HI, 1.f / IN_WSCALE};
                pg8::gemm_phase<pg8::EpiInproj, pg8::DenseOrder, kInFp8 ? 2 : 0, true, kInFp8>(F.lds, IN_KB, S, E, nullptr, (const char*)args.out, S.A, S.B); }
        }
    } SEAM(2);
    if (IN(3)) {
        if (F.vcu < 128) scan_chain<128, true>(F, F.lds, F.vcu, F.wave, F.tid, (bf16*)args.out);
        else scan_chain<64, false>(F, F.lds, F.vcu - 128, F.wave, F.tid, (bf16*)args.out + (size_t)2 * T * 512);
    } SEAM(3);
    if (IN(4)) { p4_readout(F); } SEAM(4);
    if (IN(5)) {
        pg8::DenseOrder S; S.init(T, D, 2048, F.G, bx, ws + WS_RA, ws + WS_WUA);
        pg8::EpiMerge E{(const bf16*)(ws + WS_Z), (bf16*)args.out};
        pg8::gemm_phase<pg8::EpiMerge, pg8::DenseOrder, 0, true, false>(F.lds, 2048, S, E, nullptr, nullptr, S.A, S.B);
    } SEAM(5);
    if (IN(6)) {
        pg8::DenseOrder S; S.init(T, D, D * 2, F.G, bx, (const bf16*)args.out, ws + WS_WO);
        pg8::EpiStore<kMixFp8> E{(void*)(ws + WS_MIXB), D, 1.f};
        const bool conv_first = (F.vcu & 1) != 0;
        if (conv_first) { convert_expert_weights<0>(F); __syncthreads(); }
        pg8::gemm_phase<pg8::EpiStore<kMixFp8>, pg8::DenseOrder, 0, true, false>(F.lds, D * 2, S, E, nullptr, nullptr, S.A, S.B);
        if (!conv_first) { __syncthreads(); convert_expert_weights<0>(F); }
    } SEAM(6);
    if (IN(7)) { p8_router(F); } SEAM(7);
    if (IN(8)) { p9_slots(F); } SEAM(8);
    if (IN(9)) {
        const int ntile = __builtin_amdgcn_readfirstlane(((const int*)ctl)[CW_NT]);
        pg8::MoeOrder S{ntile, 8, F.G, bx, (const int*)(ws + WS_TILEE), (const char*)(ws + WS_WGU), (size_t)2048 * MOE_KB, (size_t)256 * MOE_KB, nullptr, nullptr, 0};
        pg8::EpiGateUp E{(bf16*)args.out, (bf16*)(ws + WS_HREST), args.in[I_BG], args.in[I_BU]};
        const bool conv_first = (F.vcu & 1) != 0;
        if (conv_first) { convert_expert_weights<1>(F); __syncthreads(); }
        pg8::gemm_phase<pg8::EpiGateUp, pg8::MoeOrder, 1, true, kMoeFp8>(F.lds, MOE_KB, S, E, (const int*)(ws + WS_TOKSLOT), (const char*)(ws + WS_H2), nullptr, S.B);
        if (!conv_first) { __syncthreads(); convert_expert_weights<1>(F); }
    } SEAM(9);
    if (IN(10)) {
        const int ntile = __builtin_amdgcn_readfirstlane(((const int*)ctl)[CW_NT]);
        pg8::MoeOrder S{ntile, 4, F.G, bx, (const int*)(ws + WS_TILEE), (const char*)(ws + WS_WD), (size_t)D * MOE_KB, (size_t)256 * MOE_KB, (const char*)args.out, (const char*)(ws + WS_HREST), (size_t)256 * MOE_KB};
        pg8::EpiDown E{(bf16*)(ws + WS_Y), args.in[I_BDN]};
        static_assert(kMoeFp8, "MoE operands are fp8");
        pg8::gemm_phase<pg8::EpiDown, pg8::MoeOrder, 2, true, true, 1>(F.lds, MOE_KB, S, E, nullptr, (const char*)(ws + WS_HREST), nullptr, S.B);
    } SEAM(10);
    if (IN(11)) { p12_final(F); }
#undef IN
#undef SEAM
}

extern "C" void kernel_launch(void* const* d_in, const int* in_sizes, int n_in, void* d_out, int out_size, void* d_ws, size_t ws_size, hipStream_t stream) {
    static int grid = 0;
    if (grid == 0) {
        if (n_in != 27 || out_size != T * D || ws_size < WS_END) { fprintf(stderr, "kernel_launch: unexpected shapes: n_in %d out %d ws %zu (need %zu)\n", n_in, out_size, ws_size, (size_t)WS_END); grid = -1; return; }
        int dev = 0, cus = 0, per_cu = 0;
        if (hipGetDevice(&dev) != hipSuccess || hipDeviceGetAttribute(&cus, hipDeviceAttributeMultiprocessorCount, dev) != hipSuccess) { grid = -1; return; }
        if (hipFuncSetAttribute((const void*)fwd_kernel, hipFuncAttributeMaxDynamicSharedMemorySize, LDS_BYTES) != hipSuccess) { fprintf(stderr, "kernel_launch: hipFuncSetAttribute failed\n"); grid = -1; return; }
        if (hipOccupancyMaxActiveBlocksPerMultiprocessor(&per_cu, (const void*)fwd_kernel, NTHREADS, LDS_BYTES) != hipSuccess || per_cu < 1) { fprintf(stderr, "kernel_launch: occupancy query says %d blocks per CU\n", per_cu); (void)hipGetLastError(); grid = -1; return; }
        grid = cus;
        if (grid > 256) grid = 256;
        if (grid % 8 != 0) grid -= grid % 8;
    }
    if (grid < 0) return;
    (void)hipMemsetAsync((char*)d_ws + WS_CTL, 0, CTL_ZERO_BYTES, stream);
    Args a{};
    for (int i = 0; i < 27; ++i) a.in[i] = (const float*)d_in[i];
    a.out = (float*)d_out; a.ws = (unsigned char*)d_ws;
    if (REPEAT_PHASE >= 0) {
        a.ph_lo = 0; a.ph_hi = REPEAT_PHASE + 1; hipLaunchKernelGGL(fwd_kernel, dim3(grid), dim3(NTHREADS), LDS_BYTES, stream, a);
        (void)hipMemsetAsync((char*)d_ws + WS_CTL + CW_BAR * 4, 0, XCD_BAR_WORDS * 4, stream);
        if (REPEAT_PHASE == 7) (void)hipMemsetAsync((char*)d_ws + WS_CTL + CW_GCOUNT * 4, 0, 256, stream);
        a.ph_lo = REPEAT_PHASE; a.ph_hi = NPHASES; hipLaunchKernelGGL(fwd_kernel, dim3(grid), dim3(NTHREADS), LDS_BYTES, stream, a); }
    else if (MK_N_LAUNCHES == 1) { a.ph_lo = 0; a.ph_hi = NPHASES; hipLaunchKernelGGL(fwd_kernel, dim3(grid), dim3(NTHREADS), LDS_BYTES, stream, a); }
    else for (int p = 0; p < NPHASES; ++p) { a.ph_lo = p; a.ph_hi = p + 1; hipLaunchKernelGGL(fwd_kernel, dim3(grid), dim3(NTHREADS), LDS_BYTES, stream, a); }
}
```

```cpp
#include <hip/hip_runtime.h>
#include <cstdio>
#include <cstdint>

#ifndef MK_N_LAUNCHES
#define MK_N_LAUNCHES 1
#endif

#ifndef REPEAT_PHASE
#define REPEAT_PHASE -1
#endif
#ifndef MOE_FP8
#define MOE_FP8 1
#endif
#ifndef INPROJ_FP8
#define INPROJ_FP8 1
#endif
#ifndef ACT_FP8
#define ACT_FP8 1
#endif
#ifndef USE_NAIVE_SCAN
#define USE_NAIVE_SCAN 0
#endif
#define LAS __attribute__((address_space(3)))
typedef unsigned short bf16;
typedef short bf16x8 __attribute__((ext_vector_type(8)));
typedef float f32x4 __attribute__((ext_vector_type(4)));
typedef float f32x2 __attribute__((ext_vector_type(2)));
typedef unsigned u32x4 __attribute__((ext_vector_type(4)));
typedef unsigned u32x2 __attribute__((ext_vector_type(2)));
typedef int i32x4 __attribute__((ext_vector_type(4)));
typedef int i32x8 __attribute__((ext_vector_type(8)));

constexpr int D = 1024, NB = 16, SEQ = 2048, CTX = 256;
constexpr int T = NB * SEQ, TC = NB * CTX, MALL = T + TC;
constexpr int NZ = 3072;
constexpr int ZC_OGA = 0, ZC_OGB = 512, ZC_MGA = 1024, ZC_MGB = 2048;
constexpr int NSTEP = 36;
constexpr int NT_HI = 14, NT_LO = 12;
constexpr int IN_DIM = 6176;
constexpr int NE = 32, TOPK = 4, FF = 1024;
constexpr int MAXSLOT = T * TOPK + NE * 256, MAXTILES = MAXSLOT / 256;
constexpr float EPS = 1e-6f;
constexpr int NWAVES = 8, NTHREADS = 512;

constexpr size_t MiB = 1u << 20;
constexpr size_t WS_CTL = 0, CTL_ZERO_BYTES = 1 * MiB;
constexpr size_t WS_MOD = 1 * MiB;
constexpr size_t WS_WRT = 1 * MiB + 512 * 1024;
constexpr size_t WS_WIN = 2 * MiB;
constexpr size_t WS_WUA = 15 * MiB, WS_WUB = 16 * MiB, WS_WO = 17 * MiB;
constexpr size_t WS_TOPI = 19 * MiB, WS_TOPP = WS_TOPI + 512 * 1024, WS_LRANK = 20 * MiB, WS_PSLOT = WS_LRANK + 512 * 1024, WS_BLKBASE = 21 * MiB, WS_TOKSLOT = 21 * MiB + 256 * 1024, WS_TILEE = 22 * MiB;
constexpr size_t WS_HBF = 24 * MiB;
constexpr size_t WS_RA = 24 * MiB, WS_RB = 56 * MiB;
constexpr size_t WS_H2 = 24 * MiB;
constexpr size_t WS_Z = 96 * MiB;
constexpr size_t WS_RQA = 288 * MiB;
constexpr size_t WS_RQB = 432 * MiB;
constexpr size_t WS_RVA = 504 * MiB;
constexpr size_t WS_RVB = 540 * MiB;
constexpr size_t WS_EL = 576 * MiB;
constexpr int NCG = MALL / 64;
constexpr size_t WS_WGU = 89 * MiB;
constexpr size_t WS_Y = 24 * MiB;
constexpr size_t WS_X1B = 160 * MiB;
constexpr size_t WS_MIXB = 296 * MiB;
constexpr size_t WS_WD = 360 * MiB;
constexpr size_t WS_HREST = (MOE_FP8 ? 392 : 424) * MiB;
constexpr size_t WS_END = 580 * MiB;
constexpr bool kInFp8 = (INPROJ_FP8 != 0);
constexpr int IN_KB = kInFp8 ? 1024 : 2048;
constexpr float IN_WSCALE = kInFp8 ? 32.f : 1.f;
constexpr size_t WS_WIN_LO = 12 * MiB;
constexpr bool kActFp8 = (ACT_FP8 != 0);
constexpr bool kMixFp8 = false;
constexpr bool kMoeFp8 = (MOE_FP8 != 0);
constexpr int MOE_KB = kMoeFp8 ? 1024 : 2048;
constexpr float MOE_WSCALE = kMoeFp8 ? 32.f : 1.f;
constexpr int H_SPLIT_TILES = kMoeFp8 ? 0 : 256;
constexpr int CW_BAR = 4096, CW_GCOUNT = 16384, CW_NT = 16384 + 64;

#define RLX_AGENT __ATOMIC_RELAXED, __HIP_MEMORY_SCOPE_AGENT
#define LDS_WAIT() asm volatile("s_waitcnt lgkmcnt(0)" ::: "memory")
#define VM_WAIT() asm volatile("s_waitcnt vmcnt(0)" ::: "memory")
__device__ __forceinline__ unsigned f2bf(float f) { unsigned u = __builtin_bit_cast(unsigned, f); return (u + 0x7fffu + ((u >> 16) & 1u)) >> 16; }
__device__ __forceinline__ unsigned pk2(float lo, float hi) { return f2bf(lo) | (f2bf(hi) << 16); }
__device__ __forceinline__ unsigned pk4_fp8(float a, float b, float c, float d) { int w = 0; w = __builtin_amdgcn_cvt_pk_fp8_f32(a, b, w, false); w = __builtin_amdgcn_cvt_pk_fp8_f32(c, d, w, true); return (unsigned)w; }
__device__ __forceinline__ float bf2f(unsigned short b) { return __builtin_bit_cast(float, ((unsigned)b) << 16); }
__device__ __forceinline__ float bflo(unsigned w) { return __builtin_bit_cast(float, w << 16); }
__device__ __forceinline__ float bfhi(unsigned w) { return __builtin_bit_cast(float, w & 0xffff0000u); }
__device__ __forceinline__ float sigmoidf_(float x) { return __builtin_amdgcn_rcpf(1.0f + __expf(-x)); }
template <int CTRL> __device__ __forceinline__ float dpp_mov(float v, float old) { return __builtin_bit_cast(float, __builtin_amdgcn_update_dpp(__builtin_bit_cast(int, old), __builtin_bit_cast(int, v), CTRL, 0xf, 0xf, false)); }
__device__ __forceinline__ float rdlane(float v, int l) { return __builtin_bit_cast(float, __builtin_amdgcn_readlane(__builtin_bit_cast(int, v), l)); }
__device__ __forceinline__ float wave_sum(float v) {
    v += dpp_mov<0x111>(v, 0.f); v += dpp_mov<0x112>(v, 0.f); v += dpp_mov<0x114>(v, 0.f); v += dpp_mov<0x118>(v, 0.f);
    return (rdlane(v, 15) + rdlane(v, 31)) + (rdlane(v, 47) + rdlane(v, 63));
}
__device__ __forceinline__ float wave_max(float v) {
    const float ninf = -INFINITY;
    v = fmaxf(v, dpp_mov<0x111>(v, ninf)); v = fmaxf(v, dpp_mov<0x112>(v, ninf)); v = fmaxf(v, dpp_mov<0x114>(v, ninf)); v = fmaxf(v, dpp_mov<0x118>(v, ninf));
    return fmaxf(fmaxf(rdlane(v, 15), rdlane(v, 31)), fmaxf(rdlane(v, 47), rdlane(v, 63)));
}

__device__ __forceinline__ int qperm(int d) { return (d & ~31) | (((d >> 2) & 3) << 3) | (((d >> 4) & 1) << 2) | (d & 3); }
namespace pg8 {
constexpr int BM = 256, BK = 64, HALF = 128, HTB = HALF * BK * 2, STAGE_BYTES = 8 * HTB;
__device__ __forceinline__ int lds_byte(int r, int c) { const int st = (r >> 4) * 2 + (c >> 5), rr = r & 15, cc = c & 31, ob = rr * 64 + cc * 2; return st * 1024 + (ob ^ (((ob >> 9) & 1) << 5)); }
__device__ __forceinline__ void stage_rc(int b, int& R, int& C) { const int st = b / 1024, sb = b % 1024, swz = sb ^ (((sb >> 9) & 1) << 5); R = (st >> 1) * 16 + swz / 64; C = (st & 1) * 32 + (swz % 64) / 2; }
__device__ __forceinline__ int perm32(int rho) { const int n = rho >> 4, i = rho & 15; return 8 * (i >> 2) + 4 * n + (i & 3); }
__device__ __forceinline__ unsigned cvt_pk_bf16(float lo, float hi) { unsigned r; asm volatile("v_cvt_pk_bf16_f32 %0, %1, %2" : "=v"(r) : "v"(lo), "v"(hi)); return r; }

struct Unit { int pm, pn, e; unsigned a, b; };

template <class E, class = void> struct EpiHasPre { static constexpr bool value = false; };
template <class E> struct EpiHasPre<E, decltype((void)E::PRE)> { static constexpr bool value = E::PRE; };
__device__ __forceinline__ void glds4(const void* g, LAS void* l) { __builtin_amdgcn_global_load_lds((const unsigned*)g, (LAS unsigned*)l, 4, 0, 0); }
template <class E, class = void> struct EpiHasMid { static constexpr bool value = false; };
template <class E> struct EpiHasMid<E, decltype((void)E::MID)> { static constexpr bool value = E::MID; };
template <class Epi, class Sched, int GATHER, bool ALIGN_EPI, bool FP8, int BPERM = 0>
__device__ __forceinline__ void gemm_phase(LAS unsigned char* lds, const int KB, const Sched& S, const Epi& E, const int* __restrict__ rowidx, const char* gatherA, const void* Abase, const void* Bbase) {
    const int tid = threadIdx.x, wid = __builtin_amdgcn_readfirstlane(tid >> 6), lane = tid & 63, wr = wid >> 2, wc = wid & 3, fr = lane & 15, fq = lane >> 4;
    const int nt = KB / (BK * 2);
    unsigned vA[2][2], voffB[2]; int Rr[2], Cc[2];
#pragma unroll
    for (int i = 0; i < 2; ++i) { int R, C; stage_rc(tid * 16 + i * 8192, R, C); Rr[i] = R; Cc[i] = C; const int Rb = (R & ~31) + perm32(R & 31);
        const int Rp = (R >> 5) * 64 + ((R >> 2) & 3) * 16 + ((R >> 4) & 1) * 4 + (R & 3);
        voffB[i] = (unsigned)((BPERM ? Rp : Rb) * KB + 2 * C); vA[0][i] = (unsigned)(R * KB + 2 * C); vA[1][i] = (unsigned)((R + HALF) * KB + 2 * C); }
    const unsigned kstep = (unsigned)(BK * 2);
    const unsigned hstep = (unsigned)(HALF * KB);
    const unsigned hstepB = BPERM ? (unsigned)(8 * KB) : hstep;
    const unsigned ldsw = (unsigned)wid * 1024u;
    const int aoff = lds_byte(wr * 64 + fr, FP8 ? fq * 16 : fq * 8), boff = lds_byte(wc * 32 + fr, FP8 ? fq * 16 : fq * 8);
    constexpr int KSTR = FP8 ? 16 : 1024;
#define PG8_SA(b, h) (((b) * 2 + (h)) * HTB)
#define PG8_SB(b, h) ((4 + (b) * 2 + (h)) * HTB)
#define PG8_STAGE(bufoff, rsrc, soff, voff) do { _Pragma("unroll") for (int _i = 0; _i < 2; ++_i) \
        __builtin_amdgcn_raw_ptr_buffer_load_lds(rsrc, (LAS void*)(lds + (bufoff) + ldsw + _i * 8192), 16, (int)(voff)[_i], (int)(soff), 0, 0); } while (0)
#define PG8_LDA(dst, b, h) do { _Pragma("unroll") for (int m = 0; m < 4; ++m) _Pragma("unroll") for (int k = 0; k < 2; ++k) dst[m][k] = *(const LAS i32x4*)(lds + PG8_SA(b, h) + aoff + m * 2048 + k * KSTR); } while (0)
#define PG8_LDB(dst, b, h) do { _Pragma("unroll") for (int n = 0; n < 2; ++n) _Pragma("unroll") for (int k = 0; k < 2; ++k) dst[n][k] = *(const LAS i32x4*)(lds + PG8_SB(b, h) + boff + n * 2048 + k * KSTR); } while (0)
#define PG8_V8(x) __builtin_shufflevector((x)[0], (x)[1], 0, 1, 2, 3, 4, 5, 6, 7)
#define PG8_MMA(ai, bj, At, Bt) do { __builtin_amdgcn_s_setprio(3); _Pragma("unroll") for (int m = 0; m < 4; ++m) _Pragma("unroll") for (int n = 0; n < 2; ++n) { \
        if constexpr (FP8) acc[ai][bj][m][n] = __builtin_amdgcn_mfma_scale_f32_16x16x128_f8f6f4(PG8_V8(Bt[n]), PG8_V8(At[m]), acc[ai][bj][m][n], 0, 0, 0, 0x7f7f7f7f, 0, 0x7f7f7f7f); \
        else { _Pragma("unroll") for (int k = 0; k < 2; ++k) acc[ai][bj][m][n] = __builtin_amdgcn_mfma_f32_16x16x32_bf16(__builtin_bit_cast(bf16x8, Bt[n][k]), __builtin_bit_cast(bf16x8, At[m][k]), acc[ai][bj][m][n], 0, 0, 0); } } \
        __builtin_amdgcn_s_setprio(0); } while (0)
#define PG8_WAIT_V(n) asm volatile("s_waitcnt vmcnt(" #n ")" ::: "memory")
#define PG8_WAIT_VN(pe) do { if constexpr (Epi::NSTORES >= 16) asm volatile("s_cmp_lg_u32 %0, 0\n\ts_cbranch_scc1 1f\n\ts_waitcnt vmcnt(8)\n1:\n\ts_waitcnt vmcnt(24)" :: "s"(__builtin_amdgcn_readfirstlane((int)(pe))) : "memory", "scc"); \
        else if constexpr (Epi::NSTORES >= 8) asm volatile("s_cmp_lg_u32 %0, 0\n\ts_cbranch_scc1 1f\n\ts_waitcnt vmcnt(8)\n1:\n\ts_waitcnt vmcnt(16)" :: "s"(__builtin_amdgcn_readfirstlane((int)(pe))) : "memory", "scc"); \
        else asm volatile("s_waitcnt vmcnt(8)" ::: "memory"); } while (0)
#define PG8_WAIT_L(n) asm volatile("s_waitcnt lgkmcnt(" #n ")" ::: "memory")
#define PG8_BAR __builtin_amdgcn_s_barrier()
#define PG8_SCHED __builtin_amdgcn_sched_barrier(0)
#define PG8_GATHER_OFFS(dst, unit) do { _Pragma("unroll") for (int _h = 0; _h < 2; ++_h) _Pragma("unroll") for (int _i = 0; _i < 2; ++_i) \
        dst[_h][_i] = (unsigned)((GATHER == 1 ? rowidx[(unit).pm * BM + _h * HALF + Rr[_i]] : (unit).pm * BM + _h * HALF + Rr[_i]) * KB + 2 * Cc[_i]); } while (0)
#define PG8_GATHER_OFFS_LDS(dst, unit) do { _Pragma("unroll") for (int _h = 0; _h < 2; ++_h) _Pragma("unroll") for (int _i = 0; _i < 2; ++_i) \
        dst[_h][_i] = (unsigned)((GATHER == 1 ? IDX[_h * HALF + Rr[_i]] : (unit).pm * BM + _h * HALF + Rr[_i]) * KB + 2 * Cc[_i]); } while (0)
    LAS int* const IDX = (LAS int*)(lds + STAGE_BYTES + 1024);
    LAS float* const EC = (LAS float*)(lds + STAGE_BYTES + 2048) + wid * 64;
    Unit cur, nxt; int ui = 0;
    if (!S.next(0, cur)) return;
    f32x4 acc[2][2][4][2];
#pragma unroll
    for (int a = 0; a < 2; ++a)
#pragma unroll
        for (int b = 0; b < 2; ++b)
#pragma unroll
            for (int m = 0; m < 4; ++m)
#pragma unroll
                for (int n = 0; n < 2; ++n) acc[a][b][m][n] = (f32x4){0.f, 0.f, 0.f, 0.f};
    i32x4 At[4][2], B0[2][2], B1[2][2];
    const __amdgpu_buffer_rsrc_t rA = __builtin_amdgcn_make_buffer_rsrc((void*)(GATHER ? gatherA : Abase), 0, 0x7fffffff, 0x00020000);
    const __amdgpu_buffer_rsrc_t rB = __builtin_amdgcn_make_buffer_rsrc((void*)Bbase, 0, 0x7fffffff, 0x00020000);
    unsigned cA = GATHER ? 0u : cur.a, cB = cur.b;
    if constexpr (GATHER) { PG8_GATHER_OFFS(vA, cur); }
    if constexpr (EpiHasPre<Epi>::value) E.pre(cur, EC, wc, lane);
    PG8_STAGE(PG8_SB(0, 0), rB, cB, voffB); PG8_STAGE(PG8_SB(0, 1), rB, cB + hstepB, voffB); PG8_STAGE(PG8_SA(0, 0), rA, cA, vA[0]); PG8_STAGE(PG8_SA(0, 1), rA, cA, vA[1]);
    if (wr == 1) PG8_BAR;
    PG8_WAIT_V(2); PG8_BAR;
    PG8_STAGE(PG8_SB(1, 0), rB, cB + kstep, voffB); PG8_STAGE(PG8_SA(1, 0), rA, cA + kstep, vA[0]); PG8_STAGE(PG8_SB(1, 1), rB, cB + hstepB + kstep, voffB);
    PG8_WAIT_V(6); PG8_BAR;
    for (;;) {
        const bool has_next = S.next(ui + 1, nxt);
        const unsigned nA = GATHER ? 0u : (has_next ? nxt.a : cA), nB = has_next ? nxt.b : cB;
        if constexpr (GATHER == 1) { if (has_next && wid < 4) glds4(rowidx + nxt.pm * BM + 64 * wid + lane, IDX + 64 * wid); }
#pragma nounroll
        for (int t = 0; t < nt; t += 2) {
            const bool last = (t == nt - 2);
            const unsigned a1 = cA + (unsigned)(t + 1) * kstep;
            const unsigned a2 = last ? nA : cA + (unsigned)(t + 2) * kstep, b2 = last ? nB : cB + (unsigned)(t + 2) * kstep;
            const unsigned a3 = a2 + kstep, b3 = b2 + kstep;
            if constexpr (EpiHasMid<Epi>::value) { if (t == nt / 2) E.mid(acc, cur, wr, wc, fr, fq); }
            unsigned vN[2][2];
            if constexpr (GATHER) { if (last && has_next) { PG8_GATHER_OFFS_LDS(vN, nxt); } }
            const bool post_epi = (t == 0) && (ui > 0);
            PG8_LDB(B0, 0, 0); PG8_LDB(B1, 0, 1); PG8_SCHED; PG8_LDA(At, 0, 0); PG8_STAGE(PG8_SA(1, 1), rA, a1, vA[1]);
            if constexpr (GATHER) { if (last && has_next) {
#pragma unroll
                for (int _h = 0; _h < 2; ++_h)
#pragma unroll
                    for (int _i = 0; _i < 2; ++_i) vA[_h][_i] = vN[_h][_i]; } }
            PG8_WAIT_VN(post_epi);
            PG8_WAIT_L(0); PG8_BAR; PG8_MMA(0, 0, At, B0); PG8_MMA(0, 1, At, B1); PG8_BAR; PG8_SCHED;
            PG8_LDA(At, 0, 1); PG8_STAGE(PG8_SB(0, 0), rB, b2, voffB); PG8_STAGE(PG8_SB(0, 1), rB, b2 + hstepB, voffB); PG8_STAGE(PG8_SA(0, 0), rA, a2, vA[0]);
            PG8_WAIT_VN(post_epi);
            PG8_WAIT_L(0); PG8_BAR; PG8_MMA(1, 0, At, B0); PG8_MMA(1, 1, At, B1); PG8_BAR; PG8_SCHED;
            PG8_LDB(B0, 1, 0); PG8_LDB(B1, 1, 1); PG8_SCHED; PG8_LDA(At, 1, 0); PG8_STAGE(PG8_SA(0, 1), rA, a2, vA[1]);
            PG8_WAIT_V(8); PG8_WAIT_L(0); PG8_BAR; PG8_MMA(0, 0, At, B0); PG8_MMA(0, 1, At, B1); PG8_BAR; PG8_SCHED;
            PG8_LDA(At, 1, 1); PG8_STAGE(PG8_SB(1, 0), rB, b3, voffB); PG8_STAGE(PG8_SB(1, 1), rB, b3 + hstepB, voffB); PG8_STAGE(PG8_SA(1, 0), rA, a3, vA[0]);
            PG8_WAIT_V(8); PG8_WAIT_L(0); PG8_BAR; PG8_MMA(1, 0, At, B0); PG8_MMA(1, 1, At, B1); PG8_BAR; PG8_SCHED;
        }
        if constexpr (ALIGN_EPI) { if (wr == 0) PG8_BAR; }
        if constexpr (EpiHasPre<Epi>::value) E(acc, cur, wr, wc, fr, fq, EC); else E(acc, cur, wr, wc, fr, fq);
        if (!has_next) break;
#pragma unroll
        for (int a = 0; a < 2; ++a)
#pragma unroll
            for (int b = 0; b < 2; ++b)
#pragma unroll
                for (int m = 0; m < 4; ++m)
#pragma unroll
                    for (int n = 0; n < 2; ++n) acc[a][b][m][n] = (f32x4){0.f, 0.f, 0.f, 0.f};
        cur = nxt; cA = nA; cB = nB; ++ui;
        if constexpr (EpiHasPre<Epi>::value) E.pre(cur, EC, wc, lane);
        if constexpr (ALIGN_EPI) { if (wr == 1) PG8_BAR; }
    }
    PG8_WAIT_V(0);
    if constexpr (!ALIGN_EPI) { if (wr == 0) PG8_BAR; }
    PG8_BAR;
#undef PG8_SA
#undef PG8_SB
#undef PG8_STAGE
#undef PG8_LDA
#undef PG8_LDB
#undef PG8_MMA
#undef PG8_V8
#undef PG8_WAIT_V
#undef PG8_WAIT_VN
#undef PG8_WAIT_L
#undef PG8_BAR
#undef PG8_SCHED
#undef PG8_GATHER_OFFS
#undef PG8_GATHER_OFFS_LDS
}

struct DenseOrder {
    int nM, nN, nwg, G, c, lo, hi; const char* A; const char* B; size_t tA, tB;
    __device__ void init(int M, int N, int KB, int G_, int c_, const void* A_, const void* B_) { nM = M / BM; nN = N / BM; nwg = nM * nN; G = G_; c = c_; lo = 0; hi = 1 << 20; A = (const char*)A_; B = (const char*)B_; tA = (size_t)BM * KB; tB = tA; }
    __device__ bool next(int i, Unit& u) const {
        if (i + lo >= hi) return false;
        const long L = (long)(i + lo) * G + c; if (L >= nwg) return false;
        int wgid = (int)L; { const int q = nwg / 8, r = nwg % 8, xcd = wgid % 8, off = wgid / 8; wgid = (xcd < r ? xcd * (q + 1) : r * (q + 1) + (xcd - r) * q) + off; }
        const int nig = 8 * nN, gid = wgid / nig, fm = gid * 8, gsz = (nM - fm) < 8 ? (nM - fm) : 8;
        u.pm = fm + ((wgid % nig) % gsz); u.pn = (wgid % nig) / gsz; u.e = 0; u.a = (unsigned)((size_t)u.pm * tA); u.b = (unsigned)((size_t)u.pn * tB); return true;
    }
};
struct InprojOrder {
    int G, c; const char* A; const char* B; size_t tA, tB;
    __device__ bool next(int i, Unit& u) const {
        const int L = i * G + c; constexpr int NLAT = 128 * NT_HI, NCTX = 16 * 14;
        if (L < NLAT) { const int xcd = L % 8, off = L / 8; const int wgid = xcd * (NLAT / 8) + off; constexpr int nig = 8 * NT_HI; const int gid = wgid / nig;
            u.pm = 16 + gid * 8 + ((wgid % nig) % 8); u.pn = (wgid % nig) / 8; }
        else if (L < NLAT + NCTX) { const int idx = L - NLAT; u.pm = idx / 14; u.pn = idx % 14; }
        else return false;
        u.e = 0; u.a = (unsigned)((size_t)u.pm * tA); u.b = (unsigned)((size_t)u.pn * tB); return true;
    }
};
struct MoeOrder {
    int nt, NPN, G, c; const int* tile_e; const char* B; size_t eB, tB; const char* A0; const char* A1; size_t tA;
    __device__ bool next(int i, Unit& u) const {
        const int nx = (G % 8 == 0) ? 8 : 1, per = G / nx, x = c % nx, j = c / nx;
        const int q = (nt + nx - 1) / nx, s = i * per + j, grp = 4 * NPN;
        const int rl = (s / grp) * 4 + (s & 3), pn = (s % grp) >> 2;
        if (rl >= q) return false;
        const int rt = x * q + rl; if (rt >= nt) return false;
        const int e = __builtin_amdgcn_readfirstlane(tile_e[rt]);
        u.pm = rt; u.pn = pn; u.e = e; u.b = (unsigned)((size_t)e * eB + (size_t)pn * tB); u.a = 0u; return true;
    }
};

#define EPI_LOOP_BEGIN \
    int rb_ = wr * 64 + fr; asm volatile("" : "+v"(rb_));     \
    _Pragma("unroll") for (int ai = 0; ai < 2; ++ai) _Pragma("unroll") for (int m = 0; m < 4; ++m) { const int row = u.pm * BM + ai * HALF + m * 16 + rb_; \
    _Pragma("unroll") for (int bj = 0; bj < 2; ++bj) { const int col = u.pn * BM + bj * HALF + wc * 32 + 8 * fq; f32x4 v0 = acc[ai][bj][m][0], v1 = acc[ai][bj][m][1];
#define EPI_LOOP_END } }
__device__ __forceinline__ u32x4 pack8(f32x4 v0, f32x4 v1) { u32x4 w; w.x = cvt_pk_bf16(v0[0], v0[1]); w.y = cvt_pk_bf16(v0[2], v0[3]); w.z = cvt_pk_bf16(v1[0], v1[1]); w.w = cvt_pk_bf16(v1[2], v1[3]); return w; }
__device__ __forceinline__ void unpack8(u32x4 w, f32x4& a, f32x4& b) { a = (f32x4){bflo(w.x), bfhi(w.x), bflo(w.y), bfhi(w.y)}; b = (f32x4){bflo(w.z), bfhi(w.z), bflo(w.w), bfhi(w.w)}; }

__device__ __forceinline__ float logsigmoidf_(float x) { return fminf(x, 0.f) - __logf(1.f + __expf(-fabsf(x))); }
__device__ __forceinline__ u32x2 pack4(f32x4 v) { u32x2 w; w.x = cvt_pk_bf16(v[0], v[1]); w.y = cvt_pk_bf16(v[2], v[3]); return w; }
struct EpiInproj {
    static constexpr bool PRE = true; static constexpr int NSTORES = 8;
    bf16* Z; unsigned char* WS; float* EL; const float* gkb; const float* hlb; int rowoff_tiles, tileoff; float scale;
    __device__ __forceinline__ void pre(const Unit& uu, LAS float* ec, int wc, int lane) const {
        const int t = uu.pn + tileoff, c = lane & 15, sd = lane >> 4;
        if (t < 8) glds4(hlb + (sd >> 1) * 1024 + (sd & 1) * 512 + (t >> 1) * 128 + (t & 1) * 64 + 16 * wc + c, ec);
        else if (t < 12) glds4(gkb + (sd & 1) * 256 + (t - 8) * 64 + 16 * wc + c, ec);
    }
    __device__ __forceinline__ void operator()(const f32x4 (&acc)[2][2][4][2], const Unit& uu, int wr, int wc, int fr, int fq, const LAS float* ec) const {
        const int pm = uu.pm + rowoff_tiles, t = uu.pn + tileoff;
        int fr_ = fr; asm volatile("" : "+v"(fr_));
        if (t < 14) {
#pragma unroll
            for (int ai = 0; ai < 2; ++ai) {
                const int cg = 4 * pm + 2 * ai + wr;
                const bool ctx = cg < TC / 64; const int b = ctx ? cg >> 2 : (cg - TC / 64) >> 5, mc = ctx ? cg & 3 : (cg - TC / 64) & 31, smem = ctx ? mc : 4 + mc;
                if (t < 12) {
                    const bool hg = t < 8; const int h = hg ? t >> 1 : t - 8, cc0 = 16 * wc + 4 * fq, chh = hg ? (t & 1) * 64 + cc0 : cc0, ch = (hg ? h * 128 : h * 64) + chh;
                    f32x4 c0[2];
#pragma unroll
                    for (int d = 0; d < 2; ++d) { if (hg) { const f32x4 a0 = *(const LAS f32x4*)(ec + 16 * d + 4 * fq), a1 = *(const LAS f32x4*)(ec + 32 + 16 * d + 4 * fq);
#pragma unroll
                            for (int j = 0; j < 4; ++j) c0[d][j] = __builtin_amdgcn_rcpf(1.f + __expf(a1[j] - a0[j])); }
                        else c0[d] = *(const LAS f32x4*)(ec + 16 * d + 4 * fq) * 1.44269504f; }
                    const int tsz = hg ? 16384 : 8192, wbase = ((hg ? (t & 1) * 4 : 0) + wc) * 2048 + 8 * (fq & 2) + 512 * (fq & 1);
                    unsigned char* const qkb = WS + (hg ? WS_RQA : WS_RQB);
#pragma unroll
                    for (int d = 0; d < 2; ++d) {
                        const int sd = d ? (ctx ? 3 - mc : 35 - mc) : smem, chain = (b * 4 + h) * 2 + d;
                        unsigned char* const tq = qkb + (size_t)((chain * NSTEP + sd) * 2) * tsz; unsigned char* const tk = tq + tsz;
                        const float id = hg ? 1.f : 0.f; f32x4 run = (f32x4){id, id, id, id};
                        u32x2 wq0 = (u32x2){0u, 0u}, wk0 = wq0;
#pragma unroll
                        for (int mm = 0; mm < 4; ++mm) { const int m = d ? 3 - mm : mm; f32x4 ky, e, ie;
                            if (hg) { const f32x4 z = acc[ai][d][m][1 - d] * (scale * -1.44269504f);
#pragma unroll
                                for (int j = 0; j < 4; ++j) { const float lb = c0[d][j], oml = 1.f - lb, s = __builtin_amdgcn_rcpf(1.f + __builtin_amdgcn_exp2f(z[j]));
                                    float v = __builtin_fmaf(oml, s, lb), tt = v; ky[j] = __builtin_fmaf(-oml, s, oml);
                                    if (d == 0) { v *= dpp_mov<0x111>(v, 1.f); v *= dpp_mov<0x112>(v, 1.f); v *= dpp_mov<0x114>(v, 1.f); v *= dpp_mov<0x118>(v, 1.f); }
                                    else        { v *= dpp_mov<0x101>(v, 1.f); v *= dpp_mov<0x102>(v, 1.f); v *= dpp_mov<0x104>(v, 1.f); v *= dpp_mov<0x108>(v, 1.f); }
                                    tt *= dpp_mov<0x128>(tt, 1.f); tt *= dpp_mov<0x124>(tt, 1.f); tt *= dpp_mov<0x122>(tt, 1.f); tt *= dpp_mov<0x121>(tt, 1.f);
                                    const float cm = run[j] * v; run[j] *= tt; e[j] = cm; ie[j] = __builtin_amdgcn_rcpf(cm); } }
                            else { const f32x4 x = acc[ai][1][m][d] * (scale * 1.44269504f); ky = acc[ai][0][m][1] * scale;
#pragma unroll
                                for (int j = 0; j < 4; ++j) { const float y2 = x[j] + c0[d][j];
                                    float v = (fminf(y2, 0.f) - __builtin_amdgcn_logf(1.f + __builtin_amdgcn_exp2f(-fabsf(y2)))) * 0.0625f, tt = v;
                                    if (d == 0) { v += dpp_mov<0x111>(v, 0.f); v += dpp_mov<0x112>(v, 0.f); v += dpp_mov<0x114>(v, 0.f); v += dpp_mov<0x118>(v, 0.f); }
                                    else        { v += dpp_mov<0x101>(v, 0.f); v += dpp_mov<0x102>(v, 0.f); v += dpp_mov<0x104>(v, 0.f); v += dpp_mov<0x108>(v, 0.f); }
                                    tt += dpp_mov<0x128>(tt, 0.f); tt += dpp_mov<0x124>(tt, 0.f); tt += dpp_mov<0x122>(tt, 0.f); tt += dpp_mov<0x121>(tt, 0.f);
                                    const float cm = run[j] + v; run[j] += tt; e[j] = __builtin_amdgcn_exp2f(cm); ie[j] = __builtin_amdgcn_exp2f(-cm); } }
                            u32x2 wq = (u32x2){0u, 0u}; const u32x2 wk = pack4(ky * ie);
                            if (!ctx) wq = pack4(acc[ai][0][m][0] * (hg ? scale : scale * 0.125f) * e);
                            if ((mm & 1) == 0) { wq0 = wq; wk0 = wk; }
                            else { const int roff = (16 * (mm - 1) + (d ? 15 - fr_ : fr_)) * 32;
                                if (!ctx) { const auto sx = __builtin_amdgcn_permlane16_swap(wq0.x, wq.x, false, false), sy = __builtin_amdgcn_permlane16_swap(wq0.y, wq.y, false, false);
                                    *(u32x4*)(tq + wbase + roff) = (u32x4){sx[0], sy[0], sx[1], sy[1]}; }
                                const auto sx = __builtin_amdgcn_permlane16_swap(wk0.x, wk.x, false, false), sy = __builtin_amdgcn_permlane16_swap(wk0.y, wk.y, false, false);
                                *(u32x4*)(tk + wbase + roff) = (u32x4){sx[0], sy[0], sx[1], sy[1]}; } }
                        if (fr == 0) { f32x4 el;
#pragma unroll
                            for (int j = 0; j < 4; ++j) el[j] = hg ? run[j] : __builtin_amdgcn_exp2f(run[j]);
                            *(f32x4*)(EL + ((size_t)d * NCG + cg) * 768 + (hg ? 0 : 512) + ch) = el; }
                    }
                    if (hg) { unsigned char* const tv = WS + WS_RVA + (size_t)((b * 4 + h) * NSTEP + smem) * 16384;
#pragma unroll
                        for (int m = 0; m < 4; m += 2) { const u32x2 w0 = pack4(acc[ai][1][m][1] * scale), w1 = pack4(acc[ai][1][m + 1][1] * scale);
                            const auto sx = __builtin_amdgcn_permlane16_swap(w0.x, w1.x, false, false), sy = __builtin_amdgcn_permlane16_swap(w0.y, w1.y, false, false);
                            *(u32x4*)(tv + wbase + (16 * m + fr_) * 32) = (u32x4){sx[0], sy[0], sx[1], sy[1]}; } }
                } else {
#pragma unroll
                    for (int bj = 0; bj < 2; ++bj) { const int col = 256 * (t - 12) + 128 * bj + 32 * wc + 8 * fq, hv = col >> 7, c = col & 127;
                        unsigned char* const tv = WS + WS_RVB + (size_t)((b * 4 + hv) * NSTEP + smem) * 16384;
#pragma unroll
                        for (int m = 0; m < 4; ++m) *(u32x4*)(tv + (16 * m + fr_) * 256 + 2 * c) = pack8(acc[ai][bj][m][0] * scale, acc[ai][bj][m][1] * scale); }
                }
            }
        } else {
            static_assert(kInFp8, "the gate tiles run in the fp8 pass");
            unsigned char* const zb = (unsigned char*)Z + (size_t)(pm * BM - TC) * (NZ * 2);
            int rb_ = wr * 64 + fr_;
            const int cl = wc * 64 + fq * 16;
            if (t < 18) {
                const int cb = (t < 16) ? ZC_OGA + (t - 14) * 256 : ZC_OGB + (t - 16) * 256;
#pragma unroll
                for (int ai = 0; ai < 2; ++ai)
#pragma unroll
                    for (int m = 0; m < 4; ++m) { unsigned char* zr = zb + (size_t)(ai * HALF + m * 16 + rb_) * (NZ * 2) + 2 * (cb + cl);
#pragma unroll
                        for (int bj = 0; bj < 2; ++bj) *(u32x4*)(zr + 16 * bj) = pack8(acc[ai][bj][m][0] * scale, acc[ai][bj][m][1] * scale); }
            } else {
                const int cg = 2048 + (t - 18) * 256 + cl;
#pragma unroll
                for (int ai = 0; ai < 2; ++ai)
#pragma unroll
                    for (int m = 0; m < 4; ++m) { unsigned w[4];
#pragma unroll
                        for (int bj = 0; bj < 2; ++bj)
#pragma unroll
                            for (int n = 0; n < 2; ++n) { const f32x4 x = acc[ai][bj][m][n] * (scale * -1.44269504f); unsigned pk = 0u;
#pragma unroll
                                for (int j = 0; j < 4; ++j) { const float c = fmaxf(255.f * __builtin_amdgcn_rcpf(1.f + __builtin_amdgcn_exp2f(x[j])), 1.f);
                                    pk = j == 0 ? __builtin_amdgcn_cvt_pk_u8_f32(c, 0, pk) : j == 1 ? __builtin_amdgcn_cvt_pk_u8_f32(c, 1, pk) : j == 2 ? __builtin_amdgcn_cvt_pk_u8_f32(c, 2, pk) : __builtin_amdgcn_cvt_pk_u8_f32(c, 3, pk); }
                                w[2 * bj + n] = pk; }
                        *(u32x4*)(zb + (size_t)(ai * HALF + m * 16 + rb_) * (NZ * 2) + cg) = (u32x4){w[0], w[1], w[2], w[3]}; }
            }
        }
    }
};
__device__ __forceinline__ f32x4 u8x4_f32(unsigned w) { return (f32x4){(float)(w & 255u), (float)((w >> 8) & 255u), (float)((w >> 16) & 255u), (float)(w >> 24)}; }
struct EpiMerge {
    static constexpr bool MID = true; static constexpr int NSTORES = 16;
    const bf16* Zlat; bf16* out;
    __device__ __forceinline__ void mid(f32x4 (&acc)[2][2][4][2], const Unit& u, int wr, int wc, int fr, int fq) const {
        int rb_ = wr * 64 + fr; asm volatile("" : "+v"(rb_));
#pragma unroll
        for (int ai = 0; ai < 2; ++ai)
#pragma unroll
            for (int m = 0; m < 4; ++m) { const int row = u.pm * BM + ai * HALF + m * 16 + rb_; const unsigned char* zg = (const unsigned char*)Zlat + (size_t)row * (NZ * 2) + 2048;
#pragma unroll
                for (int bj = 0; bj < 2; ++bj) { const int col = u.pn * BM + bj * HALF + wc * 32 + 8 * fq;
                    const u32x2 aw = *(const u32x2*)(zg + col), bw = *(const u32x2*)(zg + 1024 + col);
                    const f32x4 a0 = u8x4_f32(aw.x), a1 = u8x4_f32(aw.y), b0 = u8x4_f32(bw.x), b1 = u8x4_f32(bw.y);
#pragma unroll
                    for (int j = 0; j < 4; ++j) { acc[ai][bj][m][0][j] *= a0[j] * __builtin_amdgcn_rcpf(b0[j]); acc[ai][bj][m][1][j] *= a1[j] * __builtin_amdgcn_rcpf(b1[j]); } } }
    }
    __device__ __forceinline__ void operator()(const f32x4 (&acc)[2][2][4][2], const Unit& u, int wr, int wc, int fr, int fq) const {
        EPI_LOOP_BEGIN
            const u32x2 gw = *(const u32x2*)((const unsigned char*)Zlat + (size_t)row * (NZ * 2) + 3072 + col);
            v0 = v0 * (u8x4_f32(gw.x) * (1.f / 255.f)); v1 = v1 * (u8x4_f32(gw.y) * (1.f / 255.f));
            *(u32x4*)(out + (size_t)row * D + col) = pack8(v0, v1);
        EPI_LOOP_END
    }
};
template <bool F8> __device__ __forceinline__ void store8(void* base, size_t idx, f32x4 v0, f32x4 v1) {
    if constexpr (F8) { u32x2 w; w.x = pk4_fp8(v0[0], v0[1], v0[2], v0[3]); w.y = pk4_fp8(v1[0], v1[1], v1[2], v1[3]); *(u32x2*)((unsigned char*)base + idx) = w; }
    else *(u32x4*)((bf16*)base + idx) = pack8(v0, v1);
}
template <bool F8> struct EpiStore {
    static constexpr int NSTORES = 16;
    void* out; int ldc; float scale;
    __device__ __forceinline__ void operator()(const f32x4 (&acc)[2][2][4][2], const Unit& u, int wr, int wc, int fr, int fq) const {
        EPI_LOOP_BEGIN
            store8<F8>(out, (size_t)row * ldc + col, v0 * scale, v1 * scale);
        EPI_LOOP_END
    }
};
struct EpiGateUp {
    static constexpr bool PRE = true; static constexpr int NSTORES = 8;
    bf16* H0; bf16* H1; const float* bg; const float* bu;
    __device__ __forceinline__ void pre(const Unit& u, LAS float* ec, int wc, int lane) const {
        glds4((lane < 32 ? bg : bu) + (size_t)u.e * FF + u.pn * HALF + wc * 32 + (lane & 31), ec); }
    __device__ __forceinline__ void operator()(const f32x4 (&acc)[2][2][4][2], const Unit& u, int wr, int wc, int fr, int fq, const LAS float* ec) const {
        const int ocol = u.pn * HALF + wc * 32 + 8 * fq;
        const f32x4 bg0 = *(const LAS f32x4*)(ec + 8 * fq), bg1 = *(const LAS f32x4*)(ec + 8 * fq + 4), bu0 = *(const LAS f32x4*)(ec + 32 + 8 * fq), bu1 = *(const LAS f32x4*)(ec + 32 + 8 * fq + 4);
        int rb_ = wr * 64 + fr; asm volatile("" : "+v"(rb_));
#pragma unroll
        for (int ai = 0; ai < 2; ++ai)
#pragma unroll
            for (int m = 0; m < 4; ++m) { const int row = u.pm * BM + ai * HALF + m * 16 + rb_;
                constexpr float ws = 1.f / MOE_WSCALE;
                f32x4 g0 = acc[ai][0][m][0] * ws + bg0, g1 = acc[ai][0][m][1] * ws + bg1, u0 = acc[ai][1][m][0] * ws + bu0, u1 = acc[ai][1][m][1] * ws + bu1, o0, o1;
#pragma unroll
                for (int j = 0; j < 4; ++j) { g0[j] = fminf(g0[j], 7.f); g1[j] = fminf(g1[j], 7.f); u0[j] = fminf(fmaxf(u0[j], -7.f), 7.f); u1[j] = fminf(fmaxf(u1[j], -7.f), 7.f); }
                f32x4 e0 = g0 * (-1.702f * 1.44269504f), e1 = g1 * (-1.702f * 1.44269504f);
#pragma unroll
                for (int j = 0; j < 4; ++j) { e0[j] = __builtin_amdgcn_exp2f(e0[j]); e1[j] = __builtin_amdgcn_exp2f(e1[j]); }
                e0 = e0 + 1.f; e1 = e1 + 1.f;
#pragma unroll
                for (int j = 0; j < 4; ++j) { e0[j] = __builtin_amdgcn_rcpf(e0[j]); e1[j] = __builtin_amdgcn_rcpf(e1[j]); }
                o0 = (g0 * e0) * (u0 + 1.f); o1 = (g1 * e1) * (u1 + 1.f);
                if constexpr (kMoeFp8) { unsigned char* hp = (row < H_SPLIT_TILES * BM) ? (unsigned char*)H0 + (size_t)row * FF : (unsigned char*)H1 + (size_t)(row - H_SPLIT_TILES * BM) * FF;
                    u32x2 w; w.x = pk4_fp8(o0[0], o0[1], o0[2], o0[3]); w.y = pk4_fp8(o1[0], o1[1], o1[2], o1[3]); *(u32x2*)(hp + ocol) = w; }
                else { bf16* hp = (row < H_SPLIT_TILES * BM) ? H0 + (size_t)row * FF : H1 + (size_t)(row - H_SPLIT_TILES * BM) * FF;
                    *(u32x4*)(hp + ocol) = pack8(o0, o1); } }
    }
};
struct EpiDown {
    static constexpr bool PRE = true; static constexpr int NSTORES = 8;
    bf16* Y; const float* bd;
    __device__ __forceinline__ void pre(const Unit& u, LAS float* ec, int wc, int lane) const {
        glds4(bd + (size_t)u.e * D + u.pn * BM + wc * 64 + lane, ec); }
    __device__ __forceinline__ void operator()(const f32x4 (&acc)[2][2][4][2], const Unit& u, int wr, int wc, int fr, int fq, const LAS float* ec) const {
        static_assert(kActFp8, "Y rows are fp8");
        f32x4 b0[2], b1[2];
#pragma unroll
        for (int bj = 0; bj < 2; ++bj) { b0[bj] = *(const LAS f32x4*)(ec + 16 * fq + 8 * bj); b1[bj] = *(const LAS f32x4*)(ec + 16 * fq + 8 * bj + 4); }
        int rb_ = wr * 64 + fr; asm volatile("" : "+v"(rb_));
        unsigned char* const yb = (unsigned char*)Y + u.pn * BM + wc * 64 + 16 * fq;
#pragma unroll
        for (int ai = 0; ai < 2; ++ai)
#pragma unroll
            for (int m = 0; m < 4; ++m) { const int row = u.pm * BM + ai * HALF + m * 16 + rb_; u32x4 o;
                { const f32x4 v0 = acc[ai][0][m][0] * (1.f / MOE_WSCALE) + b0[0], v1 = acc[ai][0][m][1] * (1.f / MOE_WSCALE) + b1[0]; o.x = pk4_fp8(v0[0], v0[1], v0[2], v0[3]); o.y = pk4_fp8(v1[0], v1[1], v1[2], v1[3]); }
                { const f32x4 v0 = acc[ai][1][m][0] * (1.f / MOE_WSCALE) + b0[1], v1 = acc[ai][1][m][1] * (1.f / MOE_WSCALE) + b1[1]; o.z = pk4_fp8(v0[0], v0[1], v0[2], v0[3]); o.w = pk4_fp8(v1[0], v1[1], v1[2], v1[3]); }
                *(u32x4*)(yb + (size_t)row * D) = o; }
    }
};
}

constexpr int RING_BYTES = 131072;
constexpr int LDSCTL_OFF = RING_BYTES;
constexpr int LDS_BYTES = 163840;
constexpr int MISC_OFF = LDS_BYTES - 128;

#define XB_TMO      128
#define XB_XCNT(j)  (256  + 64 * (j))
#define XB_XSUB(j)  (1280 + 64 * (j))
#define XB_XGEN(j)  (2304 + 64 * (j))
#define XB_TOP      3328
#define XB_TOPGEN   3392
#define XCD_BAR_WORDS 3456
#define XB_SPIN_CAP (1u << 22)
__device__ __forceinline__ unsigned xb_ld(unsigned* p)              { return __hip_atomic_load(p, __ATOMIC_RELAXED, __HIP_MEMORY_SCOPE_AGENT); }
__device__ __forceinline__ unsigned xb_add(unsigned* p, unsigned v) { return __hip_atomic_fetch_add(p, v, __ATOMIC_RELAXED, __HIP_MEMORY_SCOPE_AGENT); }
__device__ __forceinline__ unsigned xb_xcc_id() { return (unsigned)__builtin_amdgcn_s_getreg((3 << 11) | 20) & 0xFu; }
#define XB_SPIN(cond, bar) do { unsigned _sp = 0; while (cond) { __builtin_amdgcn_s_sleep(1); \
    if ((++_sp & 255u) == 0u) { if (xb_ld(&(bar)[XB_TMO])) break; if (_sp > XB_SPIN_CAP) { atomicAdd(&(bar)[XB_TMO], 1u); break; } } } } while (0)
struct XcdBarrier { unsigned* bar; unsigned x; volatile LAS unsigned* st; };
__device__ __forceinline__ XcdBarrier xcd_barrier_post(unsigned* bar, volatile LAS unsigned* st) {
    XcdBarrier b; b.bar = bar; b.x = xb_xcc_id(); b.st = st;
    if (threadIdx.x == 0) (void)xb_add(&bar[XB_XCNT(b.x)], 1u);
    return b;
}
__device__ __forceinline__ void xcd_barrier_complete(unsigned* bar, unsigned x, unsigned& nloc, unsigned& nx) {
    const unsigned G = gridDim.x * gridDim.y * gridDim.z;
    unsigned sum, cnt, mine, sp = 0u;
    for (;;) {
        sum = 0u; cnt = 0u; mine = 0u;
#pragma unroll
        for (unsigned j = 0; j < 16; ++j) { const unsigned c = xb_ld(&bar[XB_XCNT(j)]); sum += c; cnt += (c > 0u) ? 1u : 0u; mine = (j == x) ? c : mine; }
        if (sum == G) break;
        __builtin_amdgcn_s_sleep(1);
        if ((++sp & 255u) == 0u) { if (xb_ld(&bar[XB_TMO])) break; if (sp > XB_SPIN_CAP) { atomicAdd(&bar[XB_TMO], 1u); break; } }
    }
    nloc = mine > 0u ? mine : 1u; nx = cnt > 0u ? cnt : 1u;
}
__device__ __forceinline__ void xcd_barrier(const XcdBarrier& b) {
    asm volatile("s_waitcnt vmcnt(0)" ::: "memory");
    __syncthreads();
    if (threadIdx.x == 0) {
        unsigned* bar = b.bar;
        __builtin_amdgcn_s_waitcnt(0);
        unsigned nloc = b.st[0], nx = b.st[1];
        if (nloc == 0u) { xcd_barrier_complete(bar, b.x, nloc, nx); b.st[0] = nloc; b.st[1] = nx; }
        const unsigned old = xb_add(&bar[XB_XSUB(b.x)], 1u);
        const unsigned gen = old / nloc;
        if (old + 1u == (gen + 1u) * nloc) {
            __builtin_amdgcn_fence(__ATOMIC_RELEASE, "agent");
            asm volatile("s_waitcnt vmcnt(0)" ::: "memory");
            const unsigned og = xb_add(&bar[XB_TOP], 1u);
            const unsigned tg = og / nx;
            if (og + 1u == (tg + 1u) * nx) xb_add(&bar[XB_TOPGEN], 1u);
            else XB_SPIN(xb_ld(&bar[XB_TOPGEN]) == tg, bar);
            __builtin_amdgcn_fence(__ATOMIC_ACQUIRE, "agent");
            xb_add(&bar[XB_XGEN(b.x)], 1u);
            asm volatile("s_waitcnt vmcnt(0)" ::: "memory");
        } else {
            XB_SPIN(xb_ld(&bar[XB_XGEN(b.x)]) == gen, bar);
            __builtin_amdgcn_fence(__ATOMIC_ACQUIRE, "agent");
            asm volatile("s_waitcnt vmcnt(0)" ::: "memory");
        }
    }
    __syncthreads();
}

struct Args { const float* in[27]; float* out; unsigned char* ws; int ph_lo, ph_hi; };
enum { I_X = 0, I_C, I_CTX, I_CCTX, I_WADA, I_BADA, I_GPREMIX, I_GPOSTMIX, I_GPREFFN, I_GPOSTFFN, I_WIN, I_HLB, I_HNW, I_GKW2, I_GKB, I_GNW, I_WUPA, I_WUPB, I_WO, I_WR, I_BR, I_WG, I_BG, I_WU, I_BU, I_WDN, I_BDN };
struct Frame { LAS unsigned char* lds; int tid, lane, wave, vcu, G; const Args* a; };

__device__ __forceinline__ void transpose_item(const float* src, int ld, bf16* dst, int dpitch, LAS float* scr, int lane) {
    float tv[32];
#pragma unroll
    for (int i = 0; i < 32; ++i) tv[i] = __builtin_nontemporal_load(src + (size_t)(2 * i + (lane >> 5)) * ld + (lane & 31));
#pragma unroll
    for (int i = 0; i < 32; ++i) scr[(2 * i + (lane >> 5)) * 33 + (lane & 31)] = tv[i];
    LDS_WAIT(); asm volatile("" ::: "memory");
    const int c = lane & 7;
#pragma unroll
    for (int j = 0; j < 4; ++j) { const int n = (lane >> 3) + 8 * j; const LAS float* s = scr + (8 * c) * 33 + n;
        u32x4 o; o.x = pk2(s[0 * 33], s[1 * 33]); o.y = pk2(s[2 * 33], s[3 * 33]); o.z = pk2(s[4 * 33], s[5 * 33]); o.w = pk2(s[6 * 33], s[7 * 33]);
        *(u32x4*)(dst + (size_t)n * dpitch + 8 * c) = o; }
    LDS_WAIT(); asm volatile("" ::: "memory");
}

__device__ __forceinline__ void transpose_item_fp8(const float* src, int ld, unsigned char* dst, int dpitch, LAS float* scr, int lane, float sc) {
    float tv[32];
#pragma unroll
    for (int i = 0; i < 32; ++i) tv[i] = __builtin_nontemporal_load(src + (size_t)(2 * i + (lane >> 5)) * ld + (lane & 31));
#pragma unroll
    for (int i = 0; i < 32; ++i) scr[(2 * i + (lane >> 5)) * 33 + (lane & 31)] = tv[i];
    LDS_WAIT(); asm volatile("" ::: "memory");
    const int c = lane & 7;
#pragma unroll
    for (int j = 0; j < 4; ++j) { const int n = (lane >> 3) + 8 * j; const LAS float* s = scr + (8 * c) * 33 + n;
        u32x2 o; o.x = pk4_fp8(s[0 * 33] * sc, s[1 * 33] * sc, s[2 * 33] * sc, s[3 * 33] * sc); o.y = pk4_fp8(s[4 * 33] * sc, s[5 * 33] * sc, s[6 * 33] * sc, s[7 * 33] * sc);
        *(u32x2*)(dst + (size_t)n * dpitch + 8 * c) = o; }
    LDS_WAIT(); asm volatile("" ::: "memory");
}

__device__ __forceinline__ int inproj_src_col(int n) {
    const int t = n >> 8, rho = n & 255;
    if (t < 12) { const int a = 2 * (rho >> 7) + ((rho >> 2) & 1), cc = 16 * ((rho >> 5) & 3) + 4 * ((rho >> 3) & 3) + (rho & 3);
        if (t < 8) return a * 512 + (t >> 1) * 128 + (t & 1) * 64 + cc;
        const int h = t - 8; if (a == 0) return 2560 + h * 64 + cc; if (a == 1) return 2816 + h * 64 + cc; return -1 - ((a - 2) * 256 + h * 64 + cc); }
    if (t < 14) return 3072 + (n - 12 * 256);
    if (t < 16) return 2048 + (n - 14 * 256);
    return 3616 + (n - 16 * 256);
}
__device__ __forceinline__ void transpose_item_cols(const float* Wk, int ld, int col, bf16* dst, int dpitch, LAS float* scr, int lane) {
    float tv[32];
#pragma unroll
    for (int i = 0; i < 32; ++i) tv[i] = Wk[(size_t)(2 * i + (lane >> 5)) * ld + col];
#pragma unroll
    for (int i = 0; i < 32; ++i) scr[(2 * i + (lane >> 5)) * 33 + (lane & 31)] = tv[i];
    LDS_WAIT(); asm volatile("" ::: "memory");
    const int c = lane & 7;
#pragma unroll
    for (int j = 0; j < 4; ++j) { const int n = (lane >> 3) + 8 * j; const LAS float* s = scr + (8 * c) * 33 + n;
        u32x4 o; o.x = pk2(s[0 * 33], s[1 * 33]); o.y = pk2(s[2 * 33], s[3 * 33]); o.z = pk2(s[4 * 33], s[5 * 33]); o.w = pk2(s[6 * 33], s[7 * 33]);
        *(u32x4*)(dst + (size_t)n * dpitch + 8 * c) = o; }
    LDS_WAIT(); asm volatile("" ::: "memory");
}

__device__ __forceinline__ void p0_mod(const Frame& F, int item) {
    const Args& A = *F.a;
    LAS float* sc = (LAS float*)F.lds; LAS float* part = sc + 17 * 1024;
    const float* wp = A.in[I_WADA] + (size_t)(F.wave * 128) * 6144 + item * 64 + F.lane;
    float wv[32], wn[32];
#pragma unroll
    for (int i = 0; i < 32; ++i) wv[i] = wp[(size_t)i * 6144];
    for (int i = F.tid; i < 17 * 1024; i += NTHREADS) { const int r = i >> 10, k = i & 1023; const float v = (r < 16) ? A.in[I_C][r * 1024 + k] : A.in[I_CCTX][k]; sc[i] = v * sigmoidf_(v); }
    __syncthreads();
    const int k0 = F.wave * 128;
    float acc[17];
#pragma unroll
    for (int r = 0; r < 17; ++r) acc[r] = 0.f;
#pragma unroll
    for (int bq = 0; bq < 4; ++bq) {
        if (bq < 3) {
#pragma unroll
            for (int i = 0; i < 32; ++i) wn[i] = wp[(size_t)(32 * (bq + 1) + i) * 6144]; }
#pragma unroll
        for (int i4 = 0; i4 < 8; ++i4) { const int k = k0 + 32 * bq + 4 * i4;
#pragma unroll
            for (int r = 0; r < 17; ++r) { const f32x4 s = *(const LAS f32x4*)(sc + r * 1024 + k); acc[r] += s.x * wv[4 * i4] + s.y * wv[4 * i4 + 1] + s.z * wv[4 * i4 + 2] + s.w * wv[4 * i4 + 3]; } }
        if (bq < 3) {
#pragma unroll
            for (int i = 0; i < 32; ++i) wv[i] = wn[i]; }
    }
#pragma unroll
    for (int r = 0; r < 17; ++r) part[(F.wave * 17 + r) * 64 + F.lane] = acc[r];
    __syncthreads();
    float* mod = (float*)(A.ws + WS_MOD);
    for (int i = F.tid; i < 17 * 64; i += NTHREADS) { const int r = i >> 6, l = i & 63; float s = A.in[I_BADA][item * 64 + l];
#pragma unroll
        for (int w = 0; w < 8; ++w) s += part[(w * 17 + r) * 64 + l];
        mod[r * 6144 + item * 64 + l] = s; }
    __syncthreads();
}

__device__ __forceinline__ void p0_prologue(const Frame& F) {
    const Args& A = *F.a;
    if (F.vcu < 96) p0_mod(F, F.vcu);
    LAS float* scr = (LAS float*)(F.lds + F.wave * 16384);
    const int gw = F.vcu * NWAVES + F.wave, NGW = F.G * NWAVES;
    bf16* win_t = (bf16*)(A.ws + WS_WIN);
    constexpr int I_WIN_ITEMS = 16 * 208, I_WU = 8 * 32, I_WO_ITEMS = 16 * 32;
    for (int it = gw; it < I_WIN_ITEMS + 2 * I_WU + I_WO_ITEMS; it += NGW) {
        int r = it;
        if (r < I_WIN_ITEMS) { const int kb = r / 208, nb = r % 208, n0 = nb * 32;
            if (n0 < NT_HI * 256) { const int col = inproj_src_col(n0 + (F.lane & 31)); if (col < 0) continue;
                transpose_item_cols(A.in[I_WIN] + (size_t)(64 * kb) * IN_DIM, IN_DIM, col, win_t + (size_t)n0 * D + 64 * kb, D, scr, F.lane); }
            else { const int jl = n0 - NT_HI * 256; const float* sp = A.in[I_WIN] + (size_t)(64 * kb) * IN_DIM + (jl < 512 ? 2048 + jl : jl < 1024 ? 3616 + (jl - 512) : 4128 + (jl - 1024));
                if constexpr (kInFp8) transpose_item_fp8(sp, IN_DIM, (unsigned char*)(A.ws + WS_WIN_LO) + (size_t)(n0 - NT_HI * 256) * D + 64 * kb, D, scr, F.lane, IN_WSCALE);
                else transpose_item(sp, IN_DIM, (bf16*)(A.ws + WS_WIN_LO) + (size_t)(n0 - NT_HI * 256) * D + 64 * kb, D, scr, F.lane); }
            continue; }
        r -= I_WIN_ITEMS;
        if (r < I_WU) { const int kb = r / 32, nb = r % 32; transpose_item(A.in[I_WUPA] + (size_t)(64 * kb) * D + 32 * nb, D, (bf16*)(A.ws + WS_WUA) + (size_t)(32 * nb) * 1024 + 64 * kb, 1024, scr, F.lane); continue; }
        r -= I_WU;
        if (r < I_WU) { const int kb = r / 32, nb = r % 32; transpose_item(A.in[I_WUPB] + (size_t)(64 * kb) * D + 32 * nb, D, (bf16*)(A.ws + WS_WUA) + (size_t)(32 * nb) * 1024 + 512 + 64 * kb, 1024, scr, F.lane); continue; }
        r -= I_WU;
        { const int kb = r / 32, nb = r % 32; transpose_item(A.in[I_WO] + (size_t)(64 * kb) * D + 32 * nb, D, (bf16*)(A.ws + WS_WO) + (size_t)(32 * nb) * D + 64 * kb, D, scr, F.lane); }
    }
    const int gt = F.vcu * NTHREADS + F.tid, NGT = F.G * NTHREADS;
    for (int it = gt; it < 2 * 256 * 128; it += NGT) {
        const int k8 = it & 127, n = (it >> 7) & 255, dir = it >> 15;
        float w2[16];
#pragma unroll
        for (int r = 0; r < 16; ++r) w2[r] = A.in[I_GKW2][(dir * 16 + r) * 256 + n];
        float o[8];
#pragma unroll
        for (int kk = 0; kk < 8; ++kk) { const float* wr = A.in[I_WIN] + (size_t)(k8 * 8 + kk) * IN_DIM + 3584 + 16 * dir; float s = 0.f;
#pragma unroll
            for (int r4 = 0; r4 < 4; ++r4) { const f32x4 w = *(const f32x4*)(wr + 4 * r4); s += w.x * w2[4 * r4] + w.y * w2[4 * r4 + 1] + w.z * w2[4 * r4 + 2] + w.w * w2[4 * r4 + 3]; }
            o[kk] = s; }
        { u32x4 pk; pk.x = pk2(o[0], o[1]); pk.y = pk2(o[2], o[3]); pk.z = pk2(o[4], o[5]); pk.w = pk2(o[6], o[7]);
            const int cc = n & 63, rho = 128 + 32 * (cc >> 4) + 8 * ((cc >> 2) & 3) + 4 * dir + (cc & 3);
            *(u32x4*)(win_t + (size_t)(256 * (8 + (n >> 6)) + rho) * D + k8 * 8) = pk; }
    }
    bf16* wrb = (bf16*)(A.ws + WS_WRT);
    for (int it = gt; it < NE * D; it += NGT) { const int e = it >> 10, k = it & 1023; wrb[it] = (bf16)f2bf(A.in[I_WR][k * NE + e]); }
}

template <int WHICH> __device__ __forceinline__ void convert_expert_weights(const Frame& F) {
    static_assert(kMoeFp8, "fp8 expert weights");
    const Args& A = *F.a;
    LAS float* scr = (LAS float*)(F.lds + F.wave * 16384);
    const int gw = F.vcu * NWAVES + F.wave, NGW = F.G * NWAVES, lane = F.lane;
    constexpr int PER_E = WHICH == 0 ? 16 * 64 : 16 * 32, NIT = NE * PER_E;
    auto item = [&](int it, const float*& src, unsigned char*& dst) { const int e = it / PER_E, r = it % PER_E;
        if (WHICH == 0) { const int kb = r / 64, nb = r % 64, n0 = 32 * nb, pn = n0 >> 8, rr = n0 & 255;
            src = (rr < 128 ? A.in[I_WG] : A.in[I_WU]) + (size_t)e * D * FF + (size_t)(64 * kb) * FF + 128 * pn + (rr & 127);
            dst = A.ws + WS_WGU + (size_t)e * 2048 * D + (size_t)n0 * D + 64 * kb; }
        else { const int kb = r / 32, nb = r % 32; src = A.in[I_WDN] + (size_t)e * FF * D + (size_t)(64 * kb) * D + 32 * nb;
            dst = A.ws + WS_WD + (size_t)e * D * FF + (size_t)(32 * nb) * FF + 64 * kb; } };
    constexpr int ld = 1024;
    float tv[32], tn[32]; const float* src; unsigned char* dst; int it = gw;
    if (it < NIT) { item(it, src, dst);
#pragma unroll
        for (int i = 0; i < 32; ++i) tv[i] = __builtin_nontemporal_load(src + (size_t)(2 * i + (lane >> 5)) * ld + (lane & 31)); }
    while (it < NIT) {
        const int itn = it + NGW; const float* srcn = src; unsigned char* dstn = dst;
        if (itn < NIT) { item(itn, srcn, dstn);
#pragma unroll
            for (int i = 0; i < 32; ++i) tn[i] = __builtin_nontemporal_load(srcn + (size_t)(2 * i + (lane >> 5)) * ld + (lane & 31)); }
#pragma unroll
        for (int i = 0; i < 32; ++i) scr[(2 * i + (lane >> 5)) * 33 + (lane & 31)] = tv[i];
        LDS_WAIT(); asm volatile("" ::: "memory");
        { const int c = lane & 7;
#pragma unroll
          for (int j = 0; j < 4; ++j) { const int n = (lane >> 3) + 8 * j; const LAS float* s = scr + (8 * c) * 33 + n;
              u32x2 o; o.x = pk4_fp8(s[0 * 33] * MOE_WSCALE, s[1 * 33] * MOE_WSCALE, s[2 * 33] * MOE_WSCALE, s[3 * 33] * MOE_WSCALE);
              o.y = pk4_fp8(s[4 * 33] * MOE_WSCALE, s[5 * 33] * MOE_WSCALE, s[6 * 33] * MOE_WSCALE, s[7 * 33] * MOE_WSCALE);
              *(u32x2*)(dst + (size_t)n * D + 8 * c) = o; } }
        LDS_WAIT(); asm volatile("" ::: "memory");
        if (itn < NIT) {
#pragma unroll
            for (int i = 0; i < 32; ++i) tv[i] = tn[i]; }
        src = srcn; dst = dstn; it = itn;
    }
}

__device__ __forceinline__ void p1_prenorm(const Frame& F) {
    const Args& A = *F.a;
    const int gw = F.vcu * NWAVES + F.wave, NGW = F.G * NWAVES;
    const float* mod = (const float*)(A.ws + WS_MOD); bf16* hbf = (bf16*)(A.ws + WS_HBF);
    for (int m = gw; m < MALL; m += NGW) {
        const float* xr = (m < TC) ? A.in[I_CTX] + (size_t)m * D : A.in[I_X] + (size_t)(m - TC) * D;
        const float* md = mod + (size_t)((m < TC) ? 16 : (m - TC) / SEQ) * 6144;
        f32x4 v[4]; float ss = 0.f;
#pragma unroll
        for (int j = 0; j < 4; ++j) { v[j] = *((const f32x4*)xr + F.lane + 64 * j); ss += (v[j].x * v[j].x + v[j].y * v[j].y) + (v[j].z * v[j].z + v[j].w * v[j].w); }
        const float rstd = rsqrtf(wave_sum(ss) * (1.f / D) + EPS);
#pragma unroll
        for (int j = 0; j < 4; ++j) { const int k = 4 * (F.lane + 64 * j);
            const f32x4 g = *(const f32x4*)(A.in[I_GPREMIX] + k), sh = *(const f32x4*)(md + k), sc = *(const f32x4*)(md + 1024 + k);
            const f32x4 h = v[j] * rstd * g * (sc + 1.f) + sh;
            { u32x2 o; o.x = pk2(h.x, h.y); o.y = pk2(h.z, h.w); *((u32x2*)(hbf + (size_t)m * D) + F.lane + 64 * j) = o; }
            if (m >= TC) { if constexpr (kInFp8) *((unsigned*)((unsigned char*)A.out + (size_t)(m - TC) * D) + F.lane + 64 * j) = pk4_fp8(h.x, h.y, h.z, h.w);
                           else { u32x2 o; o.x = pk2(h.x, h.y); o.y = pk2(h.z, h.w); *((u32x2*)((bf16*)A.out + (size_t)(m - TC) * D) + F.lane + 64 * j) = o; } } }
    }
}

typedef short v4i16_t __attribute__((ext_vector_type(4)));
typedef short s16x4 __attribute__((ext_vector_type(4)));
__device__ __forceinline__ s16x4 lds_tr16(const LAS unsigned char* p) { return __builtin_bit_cast(s16x4, __builtin_amdgcn_ds_read_tr16_b64_v4i16((LAS v4i16_t*)p)); }
#define LBAR() do { asm volatile("s_waitcnt lgkmcnt(0)" ::: "memory"); __builtin_amdgcn_s_barrier(); asm volatile("" ::: "memory"); } while (0)

template <int DK, bool HGRN> __device__ __forceinline__ void scan_chain(const Frame& F, LAS unsigned char* L, int hv, int wl, int tl, bf16* obase) {
    const Args& A = *F.a;
    const float* ELg = (const float*)(A.ws + WS_EL);
    const int b = hv >> 3, h = (hv >> 1) & 3, dir = hv & 1;
    const int lane = tl & 63, l15 = lane & 15, g = lane >> 4;
    constexpr int PQ = DK * 2 + 16;
    constexpr int PV = 272;
    constexpr int PP = 144;
    constexpr int NCH = DK / 8;
    constexpr int NLD = DK / 64;
    constexpr int KS = DK / 32;
    LAS unsigned char* RQ = L;
    LAS unsigned char* RK = RQ + 64 * PQ;
    LAS unsigned char* VI = RK + 64 * PQ;
    LAS unsigned char* PI = VI + 64 * PV;
    constexpr int TSZ = 64 * DK * 2;
    const unsigned char* const qk0 = A.ws + (HGRN ? WS_RQA : WS_RQB) + (size_t)hv * NSTEP * 2 * TSZ;
    const unsigned char* const v0 = A.ws + (HGRN ? WS_RVA : WS_RVB) + (size_t)(hv >> 1) * NSTEP * 16384;
    const float* elp = ELg + (size_t)dir * NCG * 768 + (HGRN ? 0 : 512) + h * DK;
    f32x4 S[DK / 16];
#pragma unroll
    for (int i = 0; i < DK / 16; ++i) S[i] = (f32x4){0.f, 0.f, 0.f, 0.f};
    u32x4 rq[2][NLD], rk[2][NLD], rv[2][2], rel[2];
    LAS unsigned char* ELs = PI + 64 * PP;
#define SCAN_ISSUE(set, s_) do { const int s__ = (s_); const unsigned char* qt = qk0 + (size_t)s__ * 2 * TSZ; \
        _Pragma("unroll") for (int q = 0; q < NLD; ++q) { const int ci = tl + 512 * q; \
            if (s__ >= 4) rq[set][q] = *(const u32x4*)(qt + 16 * ci); \
            rk[set][q] = *(const u32x4*)(qt + TSZ + 16 * ci); } \
        { const int sm = dir ? (s__ < 4 ? 3 - s__ : 39 - s__) : s__; const unsigned char* vt = v0 + (size_t)sm * 16384; \
          _Pragma("unroll") for (int q = 0; q < 2; ++q) rv[set][q] = *(const u32x4*)(vt + 16 * (tl + 512 * q)); } \
        { const int mc = (s__ < 4) ? (dir ? 3 - s__ : s__) : (dir ? 35 - s__ : s__ - 4), cg = (s__ < 4) ? 4 * b + mc : TC / 64 + 32 * b + mc; \
          if (tl < DK / 4) rel[set] = *(const u32x4*)(elp + (size_t)cg * 768 + 4 * tl); } } while (0)
    SCAN_ISSUE(0, 0); SCAN_ISSUE(1, 1);
#pragma nounroll
    for (int s2 = 0; s2 < 36; s2 += 2) {
#pragma unroll
      for (int par = 0; par < 2; ++par) {
        const int s = s2 + par;
        const bool lat = s >= 4;
#pragma unroll
        for (int q = 0; q < NLD; ++q) { const int ci = tl + 512 * q, h2 = ci >> 9, wcc = (ci >> 7) & 3, t = (ci >> 1) & 63, hf = ci & 1;
            if (lat) { LAS unsigned char* qd = RQ + t * PQ + 64 * (2 * h2 + (wcc >> 1)) + 32 * hf + 8 * (wcc & 1);
                *(LAS u32x2*)qd = (u32x2){rq[par][q].x, rq[par][q].y}; *(LAS u32x2*)(qd + 16) = (u32x2){rq[par][q].z, rq[par][q].w}; }
            *(LAS u32x4*)(RK + t * PQ + 2 * (64 * h2 + 16 * wcc + 8 * hf)) = rk[par][q]; }
#pragma unroll
        for (int q = 0; q < 2; ++q) { const int ci = tl + 512 * q;
            if constexpr (HGRN) { const int h2 = ci >> 9, wcc = (ci >> 7) & 3, tm = (ci >> 1) & 63, hf = ci & 1, t = dir ? 63 - tm : tm; *(LAS u32x4*)(VI + t * PV + 2 * (64 * h2 + 16 * wcc + 8 * hf)) = rv[par][q]; }
            else { const int tm = ci >> 4, t = dir ? 63 - tm : tm, cc = ci & 15; *(LAS u32x4*)(VI + t * PV + 16 * cc) = rv[par][q]; } }
        if (tl < DK / 4) *(LAS u32x4*)(ELs + 16 * tl) = rel[par];
        LBAR();
        if (s + 2 < 36) SCAN_ISSUE(par, s + 2);
        bf16x8 Vf[2];
#pragma unroll
        for (int ks2 = 0; ks2 < 2; ++ks2) { const int q = l15 >> 2, p = l15 & 3;
            const s16x4 lo = lds_tr16(VI + (32 * ks2 + 8 * g + q) * PV + 32 * wl + 8 * p), hi = lds_tr16(VI + (32 * ks2 + 8 * g + 4 + q) * PV + 32 * wl + 8 * p);
            Vf[ks2] = (bf16x8){lo[0], lo[1], lo[2], lo[3], hi[0], hi[1], hi[2], hi[3]}; }
        if (lat) {
            const int ib = (0x12333210 >> (4 * wl)) & 15, jlo = (0x00102110 >> (4 * wl)) & 15, jhi = (0x00103210 >> (4 * wl)) & 15;
            bf16x8 Bq[KS];
#pragma unroll
            for (int ks = 0; ks < KS; ++ks) Bq[ks] = *(const LAS bf16x8*)(RQ + (16 * ib + l15) * PQ + 64 * ks + 16 * g);
#pragma unroll
            for (int jt = 0; jt < 4; ++jt) { if (jt >= jlo && jt <= jhi) {
                f32x4 acc = (f32x4){0.f, 0.f, 0.f, 0.f};
#pragma unroll
                for (int ks = 0; ks < KS; ++ks) { const LAS unsigned char* kp = RK + (16 * jt + l15) * PQ + 64 * ks + 8 * g;
                    const s16x4 lo = *(const LAS s16x4*)kp, hi = *(const LAS s16x4*)(kp + 32);
                    const bf16x8 Ak = (bf16x8){lo[0], lo[1], lo[2], lo[3], hi[0], hi[1], hi[2], hi[3]};
                    acc = __builtin_amdgcn_mfma_f32_16x16x32_bf16(Ak, Bq[ks], acc, 0, 0, 0); }
                if (jt == ib) {
#pragma unroll
                    for (int r = 0; r < 4; ++r) if (4 * g + r > l15) acc[r] = 0.f; }
                u32x2 w; w.x = pk2(acc[0], acc[1]); w.y = pk2(acc[2], acc[3]);
                *(LAS u32x2*)(PI + (16 * ib + l15) * PP + 32 * jt + 8 * g) = w; } }
            if (wl == 0 || wl == 2) *(LAS u32x2*)(PI + (16 * wl + l15) * PP + 32 * (wl + 1) + 8 * g) = (u32x2){0u, 0u};
            LBAR();
            bf16x8 Sb[KS];
#pragma unroll
            for (int ks = 0; ks < KS; ++ks) { const f32x4 a = S[2 * ks], c = S[2 * ks + 1]; u32x4 w; w.x = pk2(a[0], a[1]); w.y = pk2(a[2], a[3]); w.z = pk2(c[0], c[1]); w.w = pk2(c[2], c[3]); Sb[ks] = __builtin_bit_cast(bf16x8, w); }
#pragma unroll
            for (int it = 0; it < 4; ++it) {
                f32x4 acc = (f32x4){0.f, 0.f, 0.f, 0.f};
                { const bf16x8 Pf = *(const LAS bf16x8*)(PI + (16 * it + l15) * PP + 16 * g); acc = __builtin_amdgcn_mfma_f32_16x16x32_bf16(Vf[0], Pf, acc, 0, 0, 0); }
                if (it >= 2) { const bf16x8 Pf = *(const LAS bf16x8*)(PI + (16 * it + l15) * PP + 64 + 16 * g); acc = __builtin_amdgcn_mfma_f32_16x16x32_bf16(Vf[1], Pf, acc, 0, 0, 0); }
#pragma unroll
                for (int ks = 0; ks < KS; ++ks) { const bf16x8 Bi = *(const LAS bf16x8*)(RQ + (16 * it + l15) * PQ + 64 * ks + 16 * g); acc = __builtin_amdgcn_mfma_f32_16x16x32_bf16(Sb[ks], Bi, acc, 0, 0, 0); }
                const int p = 64 * (s - 4) + 16 * it + l15, tok = dir ? SEQ - 1 - p : p;
                u32x2 w; w.x = pk2(acc[0], acc[1]); w.y = pk2(acc[2], acc[3]);
                *(u32x2*)(obase + ((size_t)dir * T + (size_t)b * SEQ + tok) * 512 + h * 128 + 16 * wl + 4 * g) = w;
            }
        }
#pragma unroll
        for (int dt = 0; dt < DK / 16; ++dt) {
#pragma unroll
            for (int ks2 = 0; ks2 < 2; ++ks2) { const int q = l15 >> 2, p = l15 & 3;
                const s16x4 lo = lds_tr16(RK + (32 * ks2 + 8 * g + q) * PQ + 32 * dt + 8 * p), hi = lds_tr16(RK + (32 * ks2 + 8 * g + 4 + q) * PQ + 32 * dt + 8 * p);
                const bf16x8 Kf = (bf16x8){lo[0], lo[1], lo[2], lo[3], hi[0], hi[1], hi[2], hi[3]};
                S[dt] = __builtin_amdgcn_mfma_f32_16x16x32_bf16(Kf, Vf[ks2], S[dt], 0, 0, 0); }
            S[dt] = S[dt] * *(const LAS f32x4*)(ELs + (16 * dt + 4 * g) * 4);
        }
        LBAR();
      }
    }
#undef SCAN_ISSUE
}

__device__ __forceinline__ void p4_readout(const Frame& F) {
    const Args& A = *F.a;
    const int gw = F.vcu * NWAVES + F.wave, NGW = F.G * NWAVES;
    const bf16* Z = (const bf16*)(A.ws + WS_Z); const bf16* O = (const bf16*)A.out;
    for (int it = gw; it < 2 * T; it += NGW) {
        const int br = it & 1, tok = it >> 1;
        const bf16* of = O + ((size_t)(br * 2 + 0) * T + tok) * 512 + 8 * F.lane; const bf16* ob = O + ((size_t)(br * 2 + 1) * T + tok) * 512 + 8 * F.lane;
        const u32x4 wf = *(const u32x4*)of, wb = *(const u32x4*)ob, wg = *(const u32x4*)(Z + (size_t)tok * NZ + (br ? ZC_OGB : ZC_OGA) + 8 * F.lane);
        f32x4 a0, a1, b0, b1, g0, g1; pg8::unpack8(wf, a0, a1); pg8::unpack8(wb, b0, b1); pg8::unpack8(wg, g0, g1);
        a0 += b0; a1 += b1;
        float ss = (a0.x * a0.x + a0.y * a0.y) + (a0.z * a0.z + a0.w * a0.w) + (a1.x * a1.x + a1.y * a1.y) + (a1.z * a1.z + a1.w * a1.w);
        ss += __shfl_xor(ss, 1); ss += __shfl_xor(ss, 2); ss += __shfl_xor(ss, 4); ss += __shfl_xor(ss, 8);
        const float rstd = rsqrtf(ss * (1.f / 128.f) + EPS);
        const float* nw = (br ? A.in[I_GNW] : A.in[I_HNW]) + (8 * F.lane & 127);
        const f32x4 n0 = *(const f32x4*)nw, n1 = *(const f32x4*)(nw + 4);
#pragma unroll
        for (int j = 0; j < 4; ++j) { a0[j] = a0[j] * rstd * n0[j] * (g0[j] * sigmoidf_(g0[j])); a1[j] = a1[j] * rstd * n1[j] * (g1[j] * sigmoidf_(g1[j])); }
        bf16* r = (bf16*)(A.ws + WS_RA) + (size_t)tok * 1024 + br * 512 + 8 * F.lane;
        *(u32x4*)r = pg8::pack8(a0, a1);
    }
}

__device__ __forceinline__ void load_row_bf16(const bf16* p, int lane, f32x4 (&v)[4]) {
#pragma unroll
    for (int j = 0; j < 4; ++j) { const u32x2 w = *((const u32x2*)p + lane + 64 * j); v[j] = (f32x4){bflo(w.x), bfhi(w.x), bflo(w.y), bfhi(w.y)}; }
}
__device__ __forceinline__ void load_row_fp8(const unsigned char* p, int lane, f32x4 (&v)[4]) {
#pragma unroll
    for (int j = 0; j < 4; ++j) { const int w = *((const int*)p + lane + 64 * j); const f32x2 a = __builtin_amdgcn_cvt_pk_f32_fp8(w, false), b = __builtin_amdgcn_cvt_pk_f32_fp8(w, true); v[j] = (f32x4){a.x, a.y, b.x, b.y}; }
}
template <bool F8> __device__ __forceinline__ void load_row_act(const void* base, size_t row, int lane, f32x4 (&v)[4]) {
    if constexpr (F8) load_row_fp8((const unsigned char*)base + row * D, lane, v); else load_row_bf16((const bf16*)base + row * D, lane, v);
}
__device__ __forceinline__ float sumsq4(const f32x4 (&v)[4]) { float s = 0.f;
#pragma unroll
    for (int j = 0; j < 4; ++j) s += (v[j].x * v[j].x + v[j].y * v[j].y) + (v[j].z * v[j].z + v[j].w * v[j].w);
    return s; }
__device__ __forceinline__ void compute_x1(const Args& A, int tok, int lane, const float* md, f32x4 (&x1)[4]) {
    f32x4 mx[4]; load_row_act<kMixFp8>(A.ws + WS_MIXB, (size_t)tok, lane, mx);
    const float rstd = rsqrtf(wave_sum(sumsq4(mx)) * (1.f / D) + EPS);
#pragma unroll
    for (int j = 0; j < 4; ++j) { const int k = 4 * (lane + 64 * j);
        const f32x4 xv = *(const f32x4*)(A.in[I_X] + (size_t)tok * D + k), g = *(const f32x4*)(A.in[I_GPOSTMIX] + k), gt = *(const f32x4*)(md + 2048 + k);
        x1[j] = xv + gt * (mx[j] * rstd * g); }
}

__device__ __forceinline__ void p8_router(const Frame& F) {
    const Args& A = *F.a;
    constexpr int WP = 2064;
    LAS unsigned char* WL = F.lds;
    LAS unsigned char* HB = WL + 32 * WP;
    LAS float* LG = (LAS float*)(HB + 16 * WP);
    int* hist = (int*)((unsigned char*)F.lds + 32 * WP + 16 * WP + 16 * 33 * 4);
    const u32x4* wrb = (const u32x4*)(A.ws + WS_WRT);
#pragma unroll
    for (int q = 0; q < 8; ++q) { const int i = F.tid + NTHREADS * q; *(LAS u32x4*)(WL + (i >> 7) * WP + 16 * (i & 127)) = wrb[i]; }
    if (F.tid < NE) hist[F.tid] = 0;
    __syncthreads();
    const float* mod = (const float*)(A.ws + WS_MOD); unsigned char* h2b = (unsigned char*)(A.ws + WS_H2);
    int* topi = (int*)(A.ws + WS_TOPI); float* topp = (float*)(A.ws + WS_TOPP); int* lrank = (int*)(A.ws + WS_LRANK);
    static_assert(kMoeFp8, "the router phase writes fp8 h2 rows");
    if (F.vcu == 0 && F.wave == 0) {
#pragma unroll
        for (int j = 0; j < 4; ++j) *((unsigned*)(h2b + (size_t)T * D) + F.lane + 64 * j) = 0u; }
    const int l15 = F.lane & 15, g = F.lane >> 4;
    for (int r = 0; r < 8; ++r) {
        const int base = 128 * F.vcu + 16 * r;
#pragma unroll
        for (int q = 0; q < 2; ++q) { const int row = 2 * F.wave + q, tok = base + row; const float* md = mod + (size_t)(tok / SEQ) * 6144;
            f32x4 x1[4]; compute_x1(A, tok, F.lane, md, x1);
            const float rstd = rsqrtf(wave_sum(sumsq4(x1)) * (1.f / D) + EPS);
#pragma unroll
            for (int j = 0; j < 4; ++j) { const int k = 4 * (F.lane + 64 * j);
                { u32x2 o; o.x = pk2(x1[j].x, x1[j].y); o.y = pk2(x1[j].z, x1[j].w); *((u32x2*)((bf16*)(A.ws + WS_X1B) + (size_t)tok * D) + F.lane + 64 * j) = o; }
                const f32x4 gg = *(const f32x4*)(A.in[I_GPREFFN] + k), sh = *(const f32x4*)(md + 3072 + k), sc = *(const f32x4*)(md + 4096 + k);
                const f32x4 h = x1[j] * rstd * gg * (sc + 1.f) + sh;
                *((unsigned*)(h2b + (size_t)tok * D) + F.lane + 64 * j) = pk4_fp8(h.x, h.y, h.z, h.w);
                u32x2 o; o.x = pk2(h.x, h.y); o.y = pk2(h.z, h.w); *(LAS u32x2*)(HB + row * WP + 8 * (F.lane + 64 * j)) = o; } }
        LBAR();
        if (F.wave < 2) { const int n = F.wave; f32x4 acc = (f32x4){0.f, 0.f, 0.f, 0.f};
#pragma unroll 8
            for (int ks = 0; ks < 32; ++ks) { const bf16x8 a = *(const LAS bf16x8*)(HB + l15 * WP + 64 * ks + 16 * g), bb = *(const LAS bf16x8*)(WL + (16 * n + l15) * WP + 64 * ks + 16 * g);
                acc = __builtin_amdgcn_mfma_f32_16x16x32_bf16(a, bb, acc, 0, 0, 0); }
            const float bias = A.in[I_BR][16 * n + l15];
#pragma unroll
            for (int rr = 0; rr < 4; ++rr) LG[(4 * g + rr) * 33 + 16 * n + l15] = acc[rr] + bias; }
        LBAR();
        if (F.wave == 2 && F.lane < 16) { const int tok = base + F.lane;
            float v0 = -INFINITY, v1 = -INFINITY, v2 = -INFINITY, v3 = -INFINITY; int i0 = 0, i1 = 0, i2 = 0, i3 = 0;
#pragma unroll 8
            for (int e = 0; e < NE; ++e) { const float x = LG[F.lane * 33 + e]; const bool c0 = x > v0, c1 = x > v1, c2 = x > v2, c3 = x > v3;
                v3 = c3 ? (c2 ? v2 : x) : v3; i3 = c3 ? (c2 ? i2 : e) : i3; v2 = c2 ? (c1 ? v1 : x) : v2; i2 = c2 ? (c1 ? i1 : e) : i2;
                v1 = c1 ? (c0 ? v0 : x) : v1; i1 = c1 ? (c0 ? i0 : e) : i1; v0 = c0 ? x : v0; i0 = c0 ? e : i0; }
            const float e1 = __expf(v1 - v0), e2 = __expf(v2 - v0), e3 = __expf(v3 - v0), inv = 1.f / (1.f + e1 + e2 + e3);
            *(i32x4*)(topi + tok * 4) = (i32x4){i0, i1, i2, i3}; *(f32x4*)(topp + tok * 4) = (f32x4){inv, e1 * inv, e2 * inv, e3 * inv};
            i32x4 lr; lr.x = __hip_atomic_fetch_add(hist + i0, 1, __ATOMIC_RELAXED, __HIP_MEMORY_SCOPE_WORKGROUP); lr.y = __hip_atomic_fetch_add(hist + i1, 1, __ATOMIC_RELAXED, __HIP_MEMORY_SCOPE_WORKGROUP);
            lr.z = __hip_atomic_fetch_add(hist + i2, 1, __ATOMIC_RELAXED, __HIP_MEMORY_SCOPE_WORKGROUP); lr.w = __hip_atomic_fetch_add(hist + i3, 1, __ATOMIC_RELAXED, __HIP_MEMORY_SCOPE_WORKGROUP);
            *(i32x4*)(lrank + tok * 4) = lr; }
    }
    __syncthreads();
    if (F.tid < NE) { unsigned* gc = (unsigned*)(A.ws + WS_CTL) + CW_GCOUNT; const int basec = (int)__hip_atomic_fetch_add(gc + F.tid, (unsigned)hist[F.tid], RLX_AGENT);
        ((int*)(A.ws + WS_BLKBASE))[F.vcu * NE + F.tid] = basec; }
    __syncthreads();
}

__device__ __forceinline__ void p9_slots(const Frame& F) {
    const Args& A = *F.a;
    int* ps = (int*)((unsigned char*)F.lds); int* cn = ps + 64;
    const unsigned* gc = (const unsigned*)(A.ws + WS_CTL) + CW_GCOUNT;
    if (F.tid < NE) cn[F.tid] = (int)__hip_atomic_load(gc + F.tid, RLX_AGENT);
    __syncthreads();
    if (F.tid == 0) { int acc = 0; for (int e = 0; e < NE; ++e) { ps[e] = acc; acc += (cn[e] + 255) & ~255; } ps[NE] = acc; }
    __syncthreads();
    const int* topi = (const int*)(A.ws + WS_TOPI); const int* lrank = (const int*)(A.ws + WS_LRANK); const int* blkbase = (const int*)(A.ws + WS_BLKBASE);
    int* pslot = (int*)(A.ws + WS_PSLOT); int* tokslot = (int*)(A.ws + WS_TOKSLOT);
    for (int p = F.vcu * NTHREADS + F.tid; p < T * TOPK; p += F.G * NTHREADS) {
        const int tok = p >> 2, e = topi[p], slot = ps[e] + blkbase[(tok >> 7) * NE + e] + lrank[p];
        tokslot[slot] = tok; pslot[p] = slot; }
    if (F.vcu < NE) { const int e = F.vcu, pad = ((cn[e] + 255) & ~255); for (int i = cn[e] + F.tid; i < pad; i += NTHREADS) tokslot[ps[e] + i] = T; }
    if (F.vcu == NE) { const int ntile = ps[NE] >> 8; int* tile_e = (int*)(A.ws + WS_TILEE);
        for (int t = F.tid; t < MAXTILES; t += NTHREADS) { int e = 0; for (int q = 0; q < NE; ++q) if (t * 256 >= ps[q]) e = q; tile_e[t] = (t < ntile) ? e : 0; }
        if (F.tid == 0) ((int*)(A.ws + WS_CTL))[CW_NT] = ntile; }
    __syncthreads();
}

__device__ __forceinline__ void p12_final(const Frame& F) {
    const Args& A = *F.a;
    const int gw = F.vcu * NWAVES + F.wave, NGW = F.G * NWAVES;
    const float* mod = (const float*)(A.ws + WS_MOD); const bf16* Y = (const bf16*)(A.ws + WS_Y);
    const int* pslot = (const int*)(A.ws + WS_PSLOT); const float* topp = (const float*)(A.ws + WS_TOPP);
    constexpr int NTK = 4;
    for (int tok0 = gw; tok0 < T; tok0 += NTK * NGW) {
        int tok[NTK]; i32x4 sl[NTK]; f32x4 pw[NTK];
#pragma unroll
        for (int q = 0; q < NTK; ++q) { tok[q] = tok0 + q * NGW; sl[q] = *(const i32x4*)(pslot + tok[q] * 4); pw[q] = *(const f32x4*)(topp + tok[q] * 4); }
        f32x4 x1[NTK][4], f[NTK][4];
#pragma unroll
        for (int q = 0; q < NTK; ++q) { load_row_bf16((const bf16*)(A.ws + WS_X1B) + (size_t)tok[q] * D, F.lane, x1[q]);
#pragma unroll
            for (int j = 0; j < 4; ++j) f[q][j] = (f32x4){0.f, 0.f, 0.f, 0.f};
#pragma unroll
            for (int k = 0; k < 4; ++k) { f32x4 y[4]; load_row_act<kActFp8>(Y, (size_t)sl[q][k], F.lane, y);
#pragma unroll
                for (int j = 0; j < 4; ++j) f[q][j] += y[j] * pw[q][k]; } }
#pragma unroll
        for (int q = 0; q < NTK; ++q) { const float* md = mod + (size_t)(tok[q] / SEQ) * 6144;
            const float rstd = rsqrtf(wave_sum(sumsq4(f[q])) * (1.f / D) + EPS);
#pragma unroll
            for (int j = 0; j < 4; ++j) { const int k = 4 * (F.lane + 64 * j);
                const f32x4 g = *(const f32x4*)(A.in[I_GPOSTFFN] + k), gt = *(const f32x4*)(md + 5120 + k);
                *(f32x4*)(A.out + (size_t)tok[q] * D + k) = x1[q][j] + gt * (f[q][j] * rstd * g); } }
    }
}

constexpr int NPHASES = 12;
__global__ void __launch_bounds__(NTHREADS, 2) fwd_kernel(Args args) {
    extern __shared__ __attribute__((aligned(16))) unsigned char lds_raw[];
    Frame F; F.lds = (LAS unsigned char*)lds_raw; F.tid = threadIdx.x; F.lane = F.tid & 63; F.wave = __builtin_amdgcn_readfirstlane(F.tid >> 6);
    F.G = gridDim.x; { const int bx = blockIdx.x; F.vcu = (F.G % 8 == 0) ? (bx % 8) * (F.G / 8) + bx / 8 : bx; } F.a = &args;
    volatile LAS unsigned* MISC = (volatile LAS unsigned*)(F.lds + MISC_OFF);
    for (int u = F.tid; u < (LDS_BYTES - LDSCTL_OFF) / 4; u += NTHREADS) ((LAS unsigned*)(F.lds + LDSCTL_OFF))[u] = 0u;
    __syncthreads();
    unsigned char* ws = args.ws;
    unsigned* ctl = (unsigned*)(ws + WS_CTL);
    const int lo = args.ph_lo, hi = args.ph_hi;
    XcdBarrier bar; bar.bar = ctl + CW_BAR; bar.x = 0; bar.st = nullptr;
    if (hi - lo > 1) bar = xcd_barrier_post(ctl + CW_BAR, MISC + 8);
#define IN(k) (lo <= (k) && (k) < hi)
#define SEAM(k) do { if (IN(k) && IN((k) + 1)) xcd_barrier(bar); } while (0)
    const int bx = (int)blockIdx.x;

    if (IN(0)) { p0_prologue(F); } SEAM(0);
    if (IN(1)) { p1_prenorm(F); } SEAM(1);
    if (IN(2)) {
        const int nfirst = F.vcu & 1;
#pragma nounroll
        for (int pass = 0; pass < 3; ++pass) {
            if (pass == 1) { pg8::InprojOrder S{F.G, bx, (const char*)(ws + WS_HBF), (const char*)(ws + WS_WIN), (size_t)256 * 2048, (size_t)256 * 2048};
                pg8::EpiInproj E{(bf16*)(ws + WS_Z), ws, (float*)(ws + WS_EL), args.in[I_GKB], args.in[I_HLB], 0, 0, 1.f};
                pg8::gemm_phase<pg8::EpiInproj, pg8::InprojOrder, 0, true, false>(F.lds, 2048, S, E, nullptr, nullptr, S.A, S.B); }
            else { pg8::DenseOrder S; S.init(T, NT_LO * 256, IN_KB, F.G, bx, args.out, ws + WS_WIN_LO);
                if (pass == 0) S.hi = nfirst; else S.lo = nfirst;
                pg8::EpiInproj E{(bf16*)(ws + WS_Z), ws, (float*)(ws + WS_EL), args.in[I_GKB], args.in[I_HLB], TC / 256, NT_HI, 1.f / IN_WSCALE};
                pg8::gemm_phase<pg8::EpiInproj, pg8::DenseOrder, kInFp8 ? 2 : 0, true, kInFp8, 1>(F.lds, IN_KB, S, E, nullptr, (const char*)args.out, S.A, S.B); }
        }
    } SEAM(2);
    if (IN(3)) {
        if (F.vcu < 128) scan_chain<128, true>(F, F.lds, F.vcu, F.wave, F.tid, (bf16*)args.out);
        else scan_chain<64, false>(F, F.lds, F.vcu - 128, F.wave, F.tid, (bf16*)args.out + (size_t)2 * T * 512);
    } SEAM(3);
    if (IN(4)) { p4_readout(F); } SEAM(4);
    if (IN(5)) {
        pg8::DenseOrder S; S.init(T, D, 2048, F.G, bx, ws + WS_RA, ws + WS_WUA);
        pg8::EpiMerge E{(const bf16*)(ws + WS_Z), (bf16*)args.out};
        pg8::gemm_phase<pg8::EpiMerge, pg8::DenseOrder, 0, true, false>(F.lds, 2048, S, E, nullptr, nullptr, S.A, S.B);
    } SEAM(5);
    if (IN(6)) {
        pg8::DenseOrder S; S.init(T, D, D * 2, F.G, bx, (const bf16*)args.out, ws + WS_WO);
        pg8::EpiStore<kMixFp8> E{(void*)(ws + WS_MIXB), D, 1.f};
        const bool conv_first = (F.vcu & 1) != 0;
        if (conv_first) { convert_expert_weights<0>(F); __syncthreads(); }
        pg8::gemm_phase<pg8::EpiStore<kMixFp8>, pg8::DenseOrder, 0, true, false>(F.lds, D * 2, S, E, nullptr, nullptr, S.A, S.B);
        if (!conv_first) { __syncthreads(); convert_expert_weights<0>(F); }
    } SEAM(6);
    if (IN(7)) { p8_router(F); } SEAM(7);
    if (IN(8)) { p9_slots(F); } SEAM(8);
    if (IN(9)) {
        const int ntile = __builtin_amdgcn_readfirstlane(((const int*)ctl)[CW_NT]);
        pg8::MoeOrder S{ntile, 8, F.G, bx, (const int*)(ws + WS_TILEE), (const char*)(ws + WS_WGU), (size_t)2048 * MOE_KB, (size_t)256 * MOE_KB, nullptr, nullptr, 0};
        pg8::EpiGateUp E{(bf16*)args.out, (bf16*)(ws + WS_HREST), args.in[I_BG], args.in[I_BU]};
        const bool conv_first = (F.vcu & 1) != 0;
        if (conv_first) { convert_expert_weights<1>(F); __syncthreads(); }
        pg8::gemm_phase<pg8::EpiGateUp, pg8::MoeOrder, 1, true, kMoeFp8>(F.lds, MOE_KB, S, E, (const int*)(ws + WS_TOKSLOT), (const char*)(ws + WS_H2), nullptr, S.B);
        if (!conv_first) { __syncthreads(); convert_expert_weights<1>(F); }
    } SEAM(9);
    if (IN(10)) {
        const int ntile = __builtin_amdgcn_readfirstlane(((const int*)ctl)[CW_NT]);
        pg8::MoeOrder S{ntile, 4, F.G, bx, (const int*)(ws + WS_TILEE), (const char*)(ws + WS_WD), (size_t)D * MOE_KB, (size_t)256 * MOE_KB, (const char*)args.out, (const char*)(ws + WS_HREST), (size_t)256 * MOE_KB};
        pg8::EpiDown E{(bf16*)(ws + WS_Y), args.in[I_BDN]};
        static_assert(kMoeFp8, "MoE operands are fp8");
        pg8::gemm_phase<pg8::EpiDown, pg8::MoeOrder, 2, true, true, 1>(F.lds, MOE_KB, S, E, nullptr, (const char*)(ws + WS_HREST), nullptr, S.B);
    } SEAM(10);
    if (IN(11)) { p12_final(F); }
#undef IN
#undef SEAM
}

extern "C" void kernel_launch(void* const* d_in, const int* in_sizes, int n_in, void* d_out, int out_size, void* d_ws, size_t ws_size, hipStream_t stream) {
    static int grid = 0;
    if (grid == 0) {
        if (n_in != 27 || out_size != T * D || ws_size < WS_END) { fprintf(stderr, "kernel_launch: unexpected shapes: n_in %d out %d ws %zu (need %zu)\n", n_in, out_size, ws_size, (size_t)WS_END); grid = -1; return; }
        int dev = 0, cus = 0, per_cu = 0;
        if (hipGetDevice(&dev) != hipSuccess || hipDeviceGetAttribute(&cus, hipDeviceAttributeMultiprocessorCount, dev) != hipSuccess) { grid = -1; return; }
        if (hipFuncSetAttribute((const void*)fwd_kernel, hipFuncAttributeMaxDynamicSharedMemorySize, LDS_BYTES) != hipSuccess) { fprintf(stderr, "kernel_launch: hipFuncSetAttribute failed\n"); grid = -1; return; }
        if (hipOccupancyMaxActiveBlocksPerMultiprocessor(&per_cu, (const void*)fwd_kernel, NTHREADS, LDS_BYTES) != hipSuccess || per_cu < 1) { fprintf(stderr, "kernel_launch: occupancy query says %d blocks per CU\n", per_cu); (void)hipGetLastError(); grid = -1; return; }
        grid = cus;
        if (grid > 256) grid = 256;
        if (grid % 8 != 0) grid -= grid % 8;
    }
    if (grid < 0) return;
    (void)hipMemsetAsync((char*)d_ws + WS_CTL, 0, CTL_ZERO_BYTES, stream);
    Args a{};
    for (int i = 0; i < 27; ++i) a.in[i] = (const float*)d_in[i];
    a.out = (float*)d_out; a.ws = (unsigned char*)d_ws;
    if (REPEAT_PHASE >= 0) {
        a.ph_lo = 0; a.ph_hi = REPEAT_PHASE + 1; hipLaunchKernelGGL(fwd_kernel, dim3(grid), dim3(NTHREADS), LDS_BYTES, stream, a);
        (void)hipMemsetAsync((char*)d_ws + WS_CTL + CW_BAR * 4, 0, XCD_BAR_WORDS * 4, stream);
        if (REPEAT_PHASE == 7) (void)hipMemsetAsync((char*)d_ws + WS_CTL + CW_GCOUNT * 4, 0, 256, stream);
        a.ph_lo = REPEAT_PHASE; a.ph_hi = NPHASES; hipLaunchKernelGGL(fwd_kernel, dim3(grid), dim3(NTHREADS), LDS_BYTES, stream, a); }
    else if (MK_N_LAUNCHES == 1) { a.ph_lo = 0; a.ph_hi = NPHASES; hipLaunchKernelGGL(fwd_kernel, dim3(grid), dim3(NTHREADS), LDS_BYTES, stream, a); }
    else for (int p = 0; p < NPHASES; ++p) { a.ph_lo = p; a.ph_hi = p + 1; hipLaunchKernelGGL(fwd_kernel, dim3(grid), dim3(NTHREADS), LDS_BYTES, stream, a); }
}
```

```cpp
#include <hip/hip_runtime.h>
#include <cstdio>
#include <cstdint>

#ifndef MK_N_LAUNCHES
#define MK_N_LAUNCHES 1
#endif

#ifndef REPEAT_PHASE
#define REPEAT_PHASE -1
#endif
#ifndef MOE_FP8
#define MOE_FP8 1
#endif
#ifndef INPROJ_FP8
#define INPROJ_FP8 1
#endif
#ifndef ACT_FP8
#define ACT_FP8 1
#endif
#ifndef USE_NAIVE_SCAN
#define USE_NAIVE_SCAN 0
#endif
#define LAS __attribute__((address_space(3)))
typedef unsigned short bf16;
typedef short bf16x8 __attribute__((ext_vector_type(8)));
typedef float f32x4 __attribute__((ext_vector_type(4)));
typedef float f32x2 __attribute__((ext_vector_type(2)));
typedef unsigned u32x4 __attribute__((ext_vector_type(4)));
typedef unsigned u32x2 __attribute__((ext_vector_type(2)));
typedef int i32x4 __attribute__((ext_vector_type(4)));
typedef int i32x8 __attribute__((ext_vector_type(8)));

constexpr int D = 1024, NB = 16, SEQ = 2048, CTX = 256;
constexpr int T = NB * SEQ, TC = NB * CTX, MALL = T + TC;
constexpr int NZ = 3072;
constexpr int ZC_OGA = 0, ZC_OGB = 512, ZC_MGA = 1024, ZC_MGB = 2048;
constexpr int NSTEP = 36;
constexpr int NT_HI = 14, NT_LO = 12;
constexpr int IN_DIM = 6176;
constexpr int NE = 32, TOPK = 4, FF = 1024;
constexpr int MAXSLOT = T * TOPK + NE * 256, MAXTILES = MAXSLOT / 256;
constexpr float EPS = 1e-6f;
constexpr int NWAVES = 8, NTHREADS = 512;

constexpr size_t MiB = 1u << 20;
constexpr size_t WS_CTL = 0, CTL_ZERO_BYTES = 1 * MiB;
constexpr size_t WS_MOD = 1 * MiB;
constexpr size_t WS_WRT = 1 * MiB + 512 * 1024;
constexpr size_t WS_WIN = 2 * MiB;
constexpr size_t WS_WUA = 15 * MiB, WS_WUB = 16 * MiB, WS_WO = 17 * MiB;
constexpr size_t WS_TOPI = 19 * MiB, WS_TOPP = WS_TOPI + 512 * 1024, WS_LRANK = 20 * MiB, WS_PSLOT = WS_LRANK + 512 * 1024, WS_BLKBASE = 21 * MiB, WS_TOKSLOT = 21 * MiB + 256 * 1024, WS_TILEE = 22 * MiB;
constexpr size_t WS_HBF = 24 * MiB;
constexpr size_t WS_RA = 24 * MiB, WS_RB = 56 * MiB;
constexpr size_t WS_H2 = 24 * MiB;
constexpr size_t WS_Z = 96 * MiB;
constexpr size_t WS_RQA = 288 * MiB;
constexpr size_t WS_RQB = 432 * MiB;
constexpr size_t WS_RVA = 504 * MiB;
constexpr size_t WS_RVB = 540 * MiB;
constexpr size_t WS_EL = 576 * MiB;
constexpr int NCG = MALL / 64;
constexpr size_t WS_WGU = 89 * MiB;
constexpr size_t WS_Y = 24 * MiB;
constexpr size_t WS_X1B = 160 * MiB;
constexpr size_t WS_MIXB = 296 * MiB;
constexpr size_t WS_WD = 360 * MiB;
constexpr size_t WS_HREST = (MOE_FP8 ? 392 : 424) * MiB;
constexpr size_t WS_END = 580 * MiB;
constexpr bool kInFp8 = (INPROJ_FP8 != 0);
constexpr int IN_KB = kInFp8 ? 1024 : 2048;
constexpr float IN_WSCALE = kInFp8 ? 32.f : 1.f;
constexpr size_t WS_WIN_LO = 12 * MiB;
constexpr bool kActFp8 = (ACT_FP8 != 0);
constexpr bool kMixFp8 = false;
constexpr bool kMoeFp8 = (MOE_FP8 != 0);
constexpr int MOE_KB = kMoeFp8 ? 1024 : 2048;
constexpr float MOE_WSCALE = kMoeFp8 ? 32.f : 1.f;
constexpr int H_SPLIT_TILES = kMoeFp8 ? 0 : 256;
constexpr int CW_BAR = 4096, CW_GCOUNT = 16384, CW_NT = 16384 + 64;

#define RLX_AGENT __ATOMIC_RELAXED, __HIP_MEMORY_SCOPE_AGENT
#define LDS_WAIT() asm volatile("s_waitcnt lgkmcnt(0)" ::: "memory")
#define VM_WAIT() asm volatile("s_waitcnt vmcnt(0)" ::: "memory")
__device__ __forceinline__ unsigned f2bf(float f) { unsigned u = __builtin_bit_cast(unsigned, f); return (u + 0x7fffu + ((u >> 16) & 1u)) >> 16; }
__device__ __forceinline__ unsigned pk2(float lo, float hi) { return f2bf(lo) | (f2bf(hi) << 16); }
__device__ __forceinline__ unsigned pk4_fp8(float a, float b, float c, float d) { int w = 0; w = __builtin_amdgcn_cvt_pk_fp8_f32(a, b, w, false); w = __builtin_amdgcn_cvt_pk_fp8_f32(c, d, w, true); return (unsigned)w; }
__device__ __forceinline__ float bf2f(unsigned short b) { return __builtin_bit_cast(float, ((unsigned)b) << 16); }
__device__ __forceinline__ float bflo(unsigned w) { return __builtin_bit_cast(float, w << 16); }
__device__ __forceinline__ float bfhi(unsigned w) { return __builtin_bit_cast(float, w & 0xffff0000u); }
__device__ __forceinline__ float sigmoidf_(float x) { return __builtin_amdgcn_rcpf(1.0f + __expf(-x)); }
template <int CTRL> __device__ __forceinline__ float dpp_mov(float v, float old) { return __builtin_bit_cast(float, __builtin_amdgcn_update_dpp(__builtin_bit_cast(int, old), __builtin_bit_cast(int, v), CTRL, 0xf, 0xf, false)); }
__device__ __forceinline__ float rdlane(float v, int l) { return __builtin_bit_cast(float, __builtin_amdgcn_readlane(__builtin_bit_cast(int, v), l)); }
__device__ __forceinline__ float wave_sum(float v) {
    v += dpp_mov<0x111>(v, 0.f); v += dpp_mov<0x112>(v, 0.f); v += dpp_mov<0x114>(v, 0.f); v += dpp_mov<0x118>(v, 0.f);
    return (rdlane(v, 15) + rdlane(v, 31)) + (rdlane(v, 47) + rdlane(v, 63));
}
__device__ __forceinline__ float wave_max(float v) {
    const float ninf = -INFINITY;
    v = fmaxf(v, dpp_mov<0x111>(v, ninf)); v = fmaxf(v, dpp_mov<0x112>(v, ninf)); v = fmaxf(v, dpp_mov<0x114>(v, ninf)); v = fmaxf(v, dpp_mov<0x118>(v, ninf));
    return fmaxf(fmaxf(rdlane(v, 15), rdlane(v, 31)), fmaxf(rdlane(v, 47), rdlane(v, 63)));
}

__device__ __forceinline__ int qperm(int d) { return (d & ~31) | (((d >> 2) & 3) << 3) | (((d >> 4) & 1) << 2) | (d & 3); }
namespace pg8 {
constexpr int BM = 256, BK = 64, HALF = 128, HTB = HALF * BK * 2, STAGE_BYTES = 8 * HTB;
__device__ __forceinline__ int lds_byte(int r, int c) { const int st = (r >> 4) * 2 + (c >> 5), rr = r & 15, cc = c & 31, ob = rr * 64 + cc * 2; return st * 1024 + (ob ^ (((ob >> 9) & 1) << 5)); }
__device__ __forceinline__ void stage_rc(int b, int& R, int& C) { const int st = b / 1024, sb = b % 1024, swz = sb ^ (((sb >> 9) & 1) << 5); R = (st >> 1) * 16 + swz / 64; C = (st & 1) * 32 + (swz % 64) / 2; }
__device__ __forceinline__ int perm32(int rho) { const int n = rho >> 4, i = rho & 15; return 8 * (i >> 2) + 4 * n + (i & 3); }
__device__ __forceinline__ unsigned cvt_pk_bf16(float lo, float hi) { unsigned r; asm volatile("v_cvt_pk_bf16_f32 %0, %1, %2" : "=v"(r) : "v"(lo), "v"(hi)); return r; }

struct Unit { int pm, pn, e; unsigned a, b; };

template <class E, class = void> struct EpiHasPre { static constexpr bool value = false; };
template <class E> struct EpiHasPre<E, decltype((void)E::PRE)> { static constexpr bool value = E::PRE; };
__device__ __forceinline__ void glds4(const void* g, LAS void* l) { __builtin_amdgcn_global_load_lds((const unsigned*)g, (LAS unsigned*)l, 4, 0, 0); }
template <class E, class = void> struct EpiHasMid { static constexpr bool value = false; };
template <class E> struct EpiHasMid<E, decltype((void)E::MID)> { static constexpr bool value = E::MID; };
template <class Epi, class Sched, int GATHER, bool ALIGN_EPI, bool FP8, int BPERM = 0>
__device__ __forceinline__ void gemm_phase(LAS unsigned char* lds, const int KB, const Sched& S, const Epi& E, const int* __restrict__ rowidx, const char* gatherA, const void* Abase, const void* Bbase) {
    const int tid = threadIdx.x, wid = __builtin_amdgcn_readfirstlane(tid >> 6), lane = tid & 63, wr = wid >> 2, wc = wid & 3, fr = lane & 15, fq = lane >> 4;
    const int nt = KB / (BK * 2);
    unsigned vA[2][2], voffB[2]; int Rr[2], Cc[2];
#pragma unroll
    for (int i = 0; i < 2; ++i) { int R, C; stage_rc(tid * 16 + i * 8192, R, C); Rr[i] = R; Cc[i] = C; const int Rb = (R & ~31) + perm32(R & 31);
        const int Rp = (R >> 5) * 64 + ((R >> 2) & 3) * 16 + ((R >> 4) & 1) * 4 + (R & 3);
        voffB[i] = (unsigned)((BPERM ? Rp : Rb) * KB + 2 * C); vA[0][i] = (unsigned)(R * KB + 2 * C); vA[1][i] = (unsigned)((R + HALF) * KB + 2 * C); }
    const unsigned kstep = (unsigned)(BK * 2);
    const unsigned hstep = (unsigned)(HALF * KB);
    const unsigned hstepB = BPERM ? (unsigned)(8 * KB) : hstep;
    const unsigned ldsw = (unsigned)wid * 1024u;
    const int aoff = lds_byte(wr * 64 + fr, FP8 ? fq * 16 : fq * 8), boff = lds_byte(wc * 32 + fr, FP8 ? fq * 16 : fq * 8);
    constexpr int KSTR = FP8 ? 16 : 1024;
#define PG8_SA(b, h) (((b) * 2 + (h)) * HTB)
#define PG8_SB(b, h) ((4 + (b) * 2 + (h)) * HTB)
#define PG8_STAGE(bufoff, rsrc, soff, voff) do { _Pragma("unroll") for (int _i = 0; _i < 2; ++_i) \
        __builtin_amdgcn_raw_ptr_buffer_load_lds(rsrc, (LAS void*)(lds + (bufoff) + ldsw + _i * 8192), 16, (int)(voff)[_i], (int)(soff), 0, 0); } while (0)
#define PG8_LDA(dst, b, h) do { _Pragma("unroll") for (int m = 0; m < 4; ++m) _Pragma("unroll") for (int k = 0; k < 2; ++k) dst[m][k] = *(const LAS i32x4*)(lds + PG8_SA(b, h) + aoff + m * 2048 + k * KSTR); } while (0)
#define PG8_LDB(dst, b, h) do { _Pragma("unroll") for (int n = 0; n < 2; ++n) _Pragma("unroll") for (int k = 0; k < 2; ++k) dst[n][k] = *(const LAS i32x4*)(lds + PG8_SB(b, h) + boff + n * 2048 + k * KSTR); } while (0)
#define PG8_V8(x) __builtin_shufflevector((x)[0], (x)[1], 0, 1, 2, 3, 4, 5, 6, 7)
#define PG8_MMA(ai, bj, At, Bt) do { __builtin_amdgcn_s_setprio(3); _Pragma("unroll") for (int m = 0; m < 4; ++m) _Pragma("unroll") for (int n = 0; n < 2; ++n) { \
        if constexpr (FP8) acc[ai][bj][m][n] = __builtin_amdgcn_mfma_scale_f32_16x16x128_f8f6f4(PG8_V8(Bt[n]), PG8_V8(At[m]), acc[ai][bj][m][n], 0, 0, 0, 0x7f7f7f7f, 0, 0x7f7f7f7f); \
        else { _Pragma("unroll") for (int k = 0; k < 2; ++k) acc[ai][bj][m][n] = __builtin_amdgcn_mfma_f32_16x16x32_bf16(__builtin_bit_cast(bf16x8, Bt[n][k]), __builtin_bit_cast(bf16x8, At[m][k]), acc[ai][bj][m][n], 0, 0, 0); } } \
        __builtin_amdgcn_s_setprio(0); } while (0)
#define PG8_WAIT_V(n) asm volatile("s_waitcnt vmcnt(" #n ")" ::: "memory")
#define PG8_WAIT_VN(pe) do { if constexpr (Epi::NSTORES >= 16) asm volatile("s_cmp_lg_u32 %0, 0\n\ts_cbranch_scc1 1f\n\ts_waitcnt vmcnt(8)\n1:\n\ts_waitcnt vmcnt(24)" :: "s"(__builtin_amdgcn_readfirstlane((int)(pe))) : "memory", "scc"); \
        else if constexpr (Epi::NSTORES >= 8) asm volatile("s_cmp_lg_u32 %0, 0\n\ts_cbranch_scc1 1f\n\ts_waitcnt vmcnt(8)\n1:\n\ts_waitcnt vmcnt(16)" :: "s"(__builtin_amdgcn_readfirstlane((int)(pe))) : "memory", "scc"); \
        else asm volatile("s_waitcnt vmcnt(8)" ::: "memory"); } while (0)
#define PG8_WAIT_L(n) asm volatile("s_waitcnt lgkmcnt(" #n ")" ::: "memory")
#define PG8_BAR __builtin_amdgcn_s_barrier()
#define PG8_SCHED __builtin_amdgcn_sched_barrier(0)
#define PG8_GATHER_OFFS(dst, unit) do { _Pragma("unroll") for (int _h = 0; _h < 2; ++_h) _Pragma("unroll") for (int _i = 0; _i < 2; ++_i) \
        dst[_h][_i] = (unsigned)((GATHER == 1 ? rowidx[(unit).pm * BM + _h * HALF + Rr[_i]] : (unit).pm * BM + _h * HALF + Rr[_i]) * KB + 2 * Cc[_i]); } while (0)
#define PG8_GATHER_OFFS_LDS(dst, unit) do { _Pragma("unroll") for (int _h = 0; _h < 2; ++_h) _Pragma("unroll") for (int _i = 0; _i < 2; ++_i) \
        dst[_h][_i] = (unsigned)((GATHER == 1 ? IDX[_h * HALF + Rr[_i]] : (unit).pm * BM + _h * HALF + Rr[_i]) * KB + 2 * Cc[_i]); } while (0)
    LAS int* const IDX = (LAS int*)(lds + STAGE_BYTES + 1024);
    LAS float* const EC = (LAS float*)(lds + STAGE_BYTES + 2048) + wid * 64;
    Unit cur, nxt; int ui = 0;
    if (!S.next(0, cur)) return;
    f32x4 acc[2][2][4][2];
#pragma unroll
    for (int a = 0; a < 2; ++a)
#pragma unroll
        for (int b = 0; b < 2; ++b)
#pragma unroll
            for (int m = 0; m < 4; ++m)
#pragma unroll
                for (int n = 0; n < 2; ++n) acc[a][b][m][n] = (f32x4){0.f, 0.f, 0.f, 0.f};
    i32x4 At[4][2], B0[2][2], B1[2][2];
    const __amdgpu_buffer_rsrc_t rA = __builtin_amdgcn_make_buffer_rsrc((void*)(GATHER ? gatherA : Abase), 0, 0x7fffffff, 0x00020000);
    const __amdgpu_buffer_rsrc_t rB = __builtin_amdgcn_make_buffer_rsrc((void*)Bbase, 0, 0x7fffffff, 0x00020000);
    unsigned cA = GATHER ? 0u : cur.a, cB = cur.b;
    if constexpr (GATHER) { PG8_GATHER_OFFS(vA, cur); }
    if constexpr (EpiHasPre<Epi>::value) E.pre(cur, EC, wc, lane);
    PG8_STAGE(PG8_SB(0, 0), rB, cB, voffB); PG8_STAGE(PG8_SB(0, 1), rB, cB + hstepB, voffB); PG8_STAGE(PG8_SA(0, 0), rA, cA, vA[0]); PG8_STAGE(PG8_SA(0, 1), rA, cA, vA[1]);
    if (wr == 1) PG8_BAR;
    PG8_WAIT_V(2); PG8_BAR;
    PG8_STAGE(PG8_SB(1, 0), rB, cB + kstep, voffB); PG8_STAGE(PG8_SA(1, 0), rA, cA + kstep, vA[0]); PG8_STAGE(PG8_SB(1, 1), rB, cB + hstepB + kstep, voffB);
    PG8_WAIT_V(6); PG8_BAR;
    for (;;) {
        const bool has_next = S.next(ui + 1, nxt);
        const unsigned nA = GATHER ? 0u : (has_next ? nxt.a : cA), nB = has_next ? nxt.b : cB;
        if constexpr (GATHER == 1) { if (has_next && wid < 4) glds4(rowidx + nxt.pm * BM + 64 * wid + lane, IDX + 64 * wid); }
#pragma nounroll
        for (int t = 0; t < nt; t += 2) {
            const bool last = (t == nt - 2);
            const unsigned a1 = cA + (unsigned)(t + 1) * kstep;
            const unsigned a2 = last ? nA : cA + (unsigned)(t + 2) * kstep, b2 = last ? nB : cB + (unsigned)(t + 2) * kstep;
            const unsigned a3 = a2 + kstep, b3 = b2 + kstep;
            if constexpr (EpiHasMid<Epi>::value) { if (t == nt / 2) E.mid(acc, cur, wr, wc, fr, fq); }
            unsigned vN[2][2];
            if constexpr (GATHER) { if (last && has_next) { PG8_GATHER_OFFS_LDS(vN, nxt); } }
            const bool post_epi = (t == 0) && (ui > 0);
            PG8_LDB(B0, 0, 0); PG8_LDB(B1, 0, 1); PG8_SCHED; PG8_LDA(At, 0, 0); PG8_STAGE(PG8_SA(1, 1), rA, a1, vA[1]);
            if constexpr (GATHER) { if (last && has_next) {
#pragma unroll
                for (int _h = 0; _h < 2; ++_h)
#pragma unroll
                    for (int _i = 0; _i < 2; ++_i) vA[_h][_i] = vN[_h][_i]; } }
            PG8_WAIT_VN(post_epi);
            PG8_WAIT_L(0); PG8_BAR; PG8_MMA(0, 0, At, B0); PG8_MMA(0, 1, At, B1); PG8_BAR; PG8_SCHED;
            PG8_LDA(At, 0, 1); PG8_STAGE(PG8_SB(0, 0), rB, b2, voffB); PG8_STAGE(PG8_SB(0, 1), rB, b2 + hstepB, voffB); PG8_STAGE(PG8_SA(0, 0), rA, a2, vA[0]);
            PG8_WAIT_VN(post_epi);
            PG8_WAIT_L(0); PG8_BAR; PG8_MMA(1, 0, At, B0); PG8_MMA(1, 1, At, B1); PG8_BAR; PG8_SCHED;
            PG8_LDB(B0, 1, 0); PG8_LDB(B1, 1, 1); PG8_SCHED; PG8_LDA(At, 1, 0); PG8_STAGE(PG8_SA(0, 1), rA, a2, vA[1]);
            PG8_WAIT_V(8); PG8_WAIT_L(0); PG8_BAR; PG8_MMA(0, 0, At, B0); PG8_MMA(0, 1, At, B1); PG8_BAR; PG8_SCHED;
            PG8_LDA(At, 1, 1); PG8_STAGE(PG8_SB(1, 0), rB, b3, voffB); PG8_STAGE(PG8_SB(1, 1), rB, b3 + hstepB, voffB); PG8_STAGE(PG8_SA(1, 0), rA, a3, vA[0]);
            PG8_WAIT_V(8); PG8_WAIT_L(0); PG8_BAR; PG8_MMA(1, 0, At, B0); PG8_MMA(1, 1, At, B1); PG8_BAR; PG8_SCHED;
        }
        if constexpr (ALIGN_EPI) { if (wr == 0) PG8_BAR; }
        if constexpr (EpiHasPre<Epi>::value) E(acc, cur, wr, wc, fr, fq, EC); else E(acc, cur, wr, wc, fr, fq);
        if (!has_next) break;
#pragma unroll
        for (int a = 0; a < 2; ++a)
#pragma unroll
            for (int b = 0; b < 2; ++b)
#pragma unroll
                for (int m = 0; m < 4; ++m)
#pragma unroll
                    for (int n = 0; n < 2; ++n) acc[a][b][m][n] = (f32x4){0.f, 0.f, 0.f, 0.f};
        cur = nxt; cA = nA; cB = nB; ++ui;
        if constexpr (EpiHasPre<Epi>::value) E.pre(cur, EC, wc, lane);
        if constexpr (ALIGN_EPI) { if (wr == 1) PG8_BAR; }
    }
    PG8_WAIT_V(0);
    if constexpr (!ALIGN_EPI) { if (wr == 0) PG8_BAR; }
    PG8_BAR;
#undef PG8_SA
#undef PG8_SB
#undef PG8_STAGE
#undef PG8_LDA
#undef PG8_LDB
#undef PG8_MMA
#undef PG8_V8
#undef PG8_WAIT_V
#undef PG8_WAIT_VN
#undef PG8_WAIT_L
#undef PG8_BAR
#undef PG8_SCHED
#undef PG8_GATHER_OFFS
#undef PG8_GATHER_OFFS_LDS
}

struct DenseOrder {
    int nM, nN, nwg, G, c, lo, hi; const char* A; const char* B; size_t tA, tB;
    __device__ void init(int M, int N, int KB, int G_, int c_, const void* A_, const void* B_) { nM = M / BM; nN = N / BM; nwg = nM * nN; G = G_; c = c_; lo = 0; hi = 1 << 20; A = (const char*)A_; B = (const char*)B_; tA = (size_t)BM * KB; tB = tA; }
    __device__ bool next(int i, Unit& u) const {
        if (i + lo >= hi) return false;
        const long L = (long)(i + lo) * G + c; if (L >= nwg) return false;
        int wgid = (int)L; { const int q = nwg / 8, r = nwg % 8, xcd = wgid % 8, off = wgid / 8; wgid = (xcd < r ? xcd * (q + 1) : r * (q + 1) + (xcd - r) * q) + off; }
        const int nig = 8 * nN, gid = wgid / nig, fm = gid * 8, gsz = (nM - fm) < 8 ? (nM - fm) : 8;
        u.pm = fm + ((wgid % nig) % gsz); u.pn = (wgid % nig) / gsz; u.e = 0; u.a = (unsigned)((size_t)u.pm * tA); u.b = (unsigned)((size_t)u.pn * tB); return true;
    }
};
struct InprojOrder {
    int G, c; const char* A; const char* B; size_t tA, tB;
    __device__ bool next(int i, Unit& u) const {
        const int L = i * G + c; constexpr int NLAT = 128 * NT_HI, NCTX = 16 * 14;
        if (L < NLAT) { const int xcd = L % 8, off = L / 8; const int wgid = xcd * (NLAT / 8) + off; constexpr int nig = 8 * NT_HI; const int gid = wgid / nig;
            u.pm = 16 + gid * 8 + ((wgid % nig) % 8); u.pn = (wgid % nig) / 8; }
        else if (L < NLAT + NCTX) { const int idx = L - NLAT; u.pm = idx / 14; u.pn = idx % 14; }
        else return false;
        u.e = 0; u.a = (unsigned)((size_t)u.pm * tA); u.b = (unsigned)((size_t)u.pn * tB); return true;
    }
};
struct MoeOrder {
    int nt, NPN, G, c; const int* tile_e; const char* B; size_t eB, tB; const char* A0; const char* A1; size_t tA;
    __device__ bool next(int i, Unit& u) const {
        const int nx = (G % 8 == 0) ? 8 : 1, per = G / nx, x = c % nx, j = c / nx;
        const int q = (nt + nx - 1) / nx, s = i * per + j, grp = 4 * NPN;
        const int rl = (s / grp) * 4 + (s & 3), pn = (s % grp) >> 2;
        if (rl >= q) return false;
        const int rt = x * q + rl; if (rt >= nt) return false;
        const int e = __builtin_amdgcn_readfirstlane(tile_e[rt]);
        u.pm = rt; u.pn = pn; u.e = e; u.b = (unsigned)((size_t)e * eB + (size_t)pn * tB); u.a = 0u; return true;
    }
};

#define EPI_LOOP_BEGIN \
    int rb_ = wr * 64 + fr; asm volatile("" : "+v"(rb_));     \
    _Pragma("unroll") for (int ai = 0; ai < 2; ++ai) _Pragma("unroll") for (int m = 0; m < 4; ++m) { const int row = u.pm * BM + ai * HALF + m * 16 + rb_; \
    _Pragma("unroll") for (int bj = 0; bj < 2; ++bj) { const int col = u.pn * BM + bj * HALF + wc * 32 + 8 * fq; f32x4 v0 = acc[ai][bj][m][0], v1 = acc[ai][bj][m][1];
#define EPI_LOOP_END } }
__device__ __forceinline__ u32x4 pack8(f32x4 v0, f32x4 v1) { u32x4 w; w.x = cvt_pk_bf16(v0[0], v0[1]); w.y = cvt_pk_bf16(v0[2], v0[3]); w.z = cvt_pk_bf16(v1[0], v1[1]); w.w = cvt_pk_bf16(v1[2], v1[3]); return w; }
__device__ __forceinline__ void unpack8(u32x4 w, f32x4& a, f32x4& b) { a = (f32x4){bflo(w.x), bfhi(w.x), bflo(w.y), bfhi(w.y)}; b = (f32x4){bflo(w.z), bfhi(w.z), bflo(w.w), bfhi(w.w)}; }

__device__ __forceinline__ float logsigmoidf_(float x) { return fminf(x, 0.f) - __logf(1.f + __expf(-fabsf(x))); }
__device__ __forceinline__ u32x2 pack4(f32x4 v) { u32x2 w; w.x = cvt_pk_bf16(v[0], v[1]); w.y = cvt_pk_bf16(v[2], v[3]); return w; }
struct EpiInproj {
    static constexpr bool PRE = true; static constexpr int NSTORES = 8;
    bf16* Z; unsigned char* WS; float* EL; const float* gkb; const float* hlb; int rowoff_tiles, tileoff; float scale;
    __device__ __forceinline__ void pre(const Unit& uu, LAS float* ec, int wc, int lane) const {
        const int t = uu.pn + tileoff, c = lane & 15, sd = lane >> 4;
        if (t < 8) glds4(hlb + (sd >> 1) * 1024 + (sd & 1) * 512 + (t >> 1) * 128 + (t & 1) * 64 + 16 * wc + c, ec);
        else if (t < 12) glds4(gkb + (sd & 1) * 256 + (t - 8) * 64 + 16 * wc + c, ec);
    }
    __device__ __forceinline__ void operator()(const f32x4 (&acc)[2][2][4][2], const Unit& uu, int wr, int wc, int fr, int fq, const LAS float* ec) const {
        const int pm = uu.pm + rowoff_tiles, t = uu.pn + tileoff;
        int fr_ = fr; asm volatile("" : "+v"(fr_));
        if (t < 14) {
#pragma unroll
            for (int ai = 0; ai < 2; ++ai) {
                const int cg = 4 * pm + 2 * ai + wr;
                const bool ctx = cg < TC / 64; const int b = ctx ? cg >> 2 : (cg - TC / 64) >> 5, mc = ctx ? cg & 3 : (cg - TC / 64) & 31, smem = ctx ? mc : 4 + mc;
                if (t < 12) {
                    const bool hg = t < 8; const int h = hg ? t >> 1 : t - 8, cc0 = 16 * wc + 4 * fq, chh = hg ? (t & 1) * 64 + cc0 : cc0, ch = (hg ? h * 128 : h * 64) + chh;
                    f32x4 c0[2];
#pragma unroll
                    for (int d = 0; d < 2; ++d) { if (hg) { const f32x4 a0 = *(const LAS f32x4*)(ec + 16 * d + 4 * fq), a1 = *(const LAS f32x4*)(ec + 32 + 16 * d + 4 * fq);
#pragma unroll
                            for (int j = 0; j < 4; ++j) c0[d][j] = __builtin_amdgcn_rcpf(1.f + __expf(a1[j] - a0[j])); }
                        else c0[d] = *(const LAS f32x4*)(ec + 16 * d + 4 * fq) * 1.44269504f; }
                    const int tsz = hg ? 16384 : 8192, wbase = ((hg ? (t & 1) * 4 : 0) + wc) * 2048 + 8 * (fq & 2) + 512 * (fq & 1);
                    unsigned char* const qkb = WS + (hg ? WS_RQA : WS_RQB);
#pragma unroll
                    for (int d = 0; d < 2; ++d) {
                        const int sd = d ? (ctx ? 3 - mc : 35 - mc) : smem, chain = (b * 4 + h) * 2 + d;
                        unsigned char* const tq = qkb + (size_t)((chain * NSTEP + sd) * 2) * tsz; unsigned char* const tk = tq + tsz;
                        const float id = hg ? 1.f : 0.f; f32x4 run = (f32x4){id, id, id, id};
                        u32x2 wq0 = (u32x2){0u, 0u}, wk0 = wq0;
#pragma unroll
                        for (int mm = 0; mm < 4; ++mm) { const int m = d ? 3 - mm : mm; f32x4 ky, e, ie;
                            if (hg) { const f32x4 z = acc[ai][d][m][1 - d] * (scale * -1.44269504f);
#pragma unroll
                                for (int j = 0; j < 4; ++j) { const float lb = c0[d][j], oml = 1.f - lb, s = __builtin_amdgcn_rcpf(1.f + __builtin_amdgcn_exp2f(z[j]));
                                    float v = __builtin_fmaf(oml, s, lb), tt = v; ky[j] = __builtin_fmaf(-oml, s, oml);
                                    if (d == 0) { v *= dpp_mov<0x111>(v, 1.f); v *= dpp_mov<0x112>(v, 1.f); v *= dpp_mov<0x114>(v, 1.f); v *= dpp_mov<0x118>(v, 1.f); }
                                    else        { v *= dpp_mov<0x101>(v, 1.f); v *= dpp_mov<0x102>(v, 1.f); v *= dpp_mov<0x104>(v, 1.f); v *= dpp_mov<0x108>(v, 1.f); }
                                    tt *= dpp_mov<0x128>(tt, 1.f); tt *= dpp_mov<0x124>(tt, 1.f); tt *= dpp_mov<0x122>(tt, 1.f); tt *= dpp_mov<0x121>(tt, 1.f);
                                    const float cm = run[j] * v; run[j] *= tt; e[j] = cm; ie[j] = __builtin_amdgcn_rcpf(cm); } }
                            else { const f32x4 x = acc[ai][1][m][d] * (scale * 1.44269504f); ky = acc[ai][0][m][1] * scale;
#pragma unroll
                                for (int j = 0; j < 4; ++j) { const float y2 = x[j] + c0[d][j];
                                    float v = (fminf(y2, 0.f) - __builtin_amdgcn_logf(1.f + __builtin_amdgcn_exp2f(-fabsf(y2)))) * 0.0625f, tt = v;
                                    if (d == 0) { v += dpp_mov<0x111>(v, 0.f); v += dpp_mov<0x112>(v, 0.f); v += dpp_mov<0x114>(v, 0.f); v += dpp_mov<0x118>(v, 0.f); }
                                    else        { v += dpp_mov<0x101>(v, 0.f); v += dpp_mov<0x102>(v, 0.f); v += dpp_mov<0x104>(v, 0.f); v += dpp_mov<0x108>(v, 0.f); }
                                    tt += dpp_mov<0x128>(tt, 0.f); tt += dpp_mov<0x124>(tt, 0.f); tt += dpp_mov<0x122>(tt, 0.f); tt += dpp_mov<0x121>(tt, 0.f);
                                    const float cm = run[j] + v; run[j] += tt; e[j] = __builtin_amdgcn_exp2f(cm); ie[j] = __builtin_amdgcn_exp2f(-cm); } }
                            u32x2 wq = (u32x2){0u, 0u}; const u32x2 wk = pack4(ky * ie);
                            if (!ctx) wq = pack4(acc[ai][0][m][0] * (hg ? scale : scale * 0.125f) * e);
                            if ((mm & 1) == 0) { wq0 = wq; wk0 = wk; }
                            else { const int roff = (16 * (mm - 1) + (d ? 15 - fr_ : fr_)) * 32;
                                if (!ctx) { const auto sx = __builtin_amdgcn_permlane16_swap(wq0.x, wq.x, false, false), sy = __builtin_amdgcn_permlane16_swap(wq0.y, wq.y, false, false);
                                    *(u32x4*)(tq + wbase + roff) = (u32x4){sx[0], sy[0], sx[1], sy[1]}; }
                                const auto sx = __builtin_amdgcn_permlane16_swap(wk0.x, wk.x, false, false), sy = __builtin_amdgcn_permlane16_swap(wk0.y, wk.y, false, false);
                                *(u32x4*)(tk + wbase + roff) = (u32x4){sx[0], sy[0], sx[1], sy[1]}; } }
                        if (fr == 0) { f32x4 el;
#pragma unroll
                            for (int j = 0; j < 4; ++j) el[j] = hg ? run[j] : __builtin_amdgcn_exp2f(run[j]);
                            *(f32x4*)(EL + ((size_t)d * NCG + cg) * 768 + (hg ? 0 : 512) + ch) = el; }
                    }
                    if (hg) { unsigned char* const tv = WS + WS_RVA + (size_t)((b * 4 + h) * NSTEP + smem) * 16384;
#pragma unroll
                        for (int m = 0; m < 4; m += 2) { const u32x2 w0 = pack4(acc[ai][1][m][1] * scale), w1 = pack4(acc[ai][1][m + 1][1] * scale);
                            const auto sx = __builtin_amdgcn_permlane16_swap(w0.x, w1.x, false, false), sy = __builtin_amdgcn_permlane16_swap(w0.y, w1.y, false, false);
                            *(u32x4*)(tv + wbase + (16 * m + fr_) * 32) = (u32x4){sx[0], sy[0], sx[1], sy[1]}; } }
                } else {
#pragma unroll
                    for (int bj = 0; bj < 2; ++bj) { const int col = 256 * (t - 12) + 128 * bj + 32 * wc + 8 * fq, hv = col >> 7, c = col & 127;
                        unsigned char* const tv = WS + WS_RVB + (size_t)((b * 4 + hv) * NSTEP + smem) * 16384;
#pragma unroll
                        for (int m = 0; m < 4; ++m) *(u32x4*)(tv + (16 * m + fr_) * 256 + 2 * c) = pack8(acc[ai][bj][m][0] * scale, acc[ai][bj][m][1] * scale); }
                }
            }
        } else {
            static_assert(kInFp8, "the gate tiles run in the fp8 pass");
            unsigned char* const zb = (unsigned char*)Z + (size_t)(pm * BM - TC) * (NZ * 2);
            int rb_ = wr * 64 + fr_;
            const int cl = wc * 64 + fq * 16;
            if (t < 18) {
                const int cb = ((t - 14) >> 1) * 512 + ((t - 14) & 1) * 256 + cl;
#pragma unroll
                for (int ai = 0; ai < 2; ++ai)
#pragma unroll
                    for (int m = 0; m < 4; ++m) { unsigned w[4];
#pragma unroll
                        for (int bj = 0; bj < 2; ++bj)
#pragma unroll
                            for (int n = 0; n < 2; ++n) { const f32x4 x = acc[ai][bj][m][n] * scale; f32x4 s;
#pragma unroll
                                for (int j = 0; j < 4; ++j) s[j] = x[j] * __builtin_amdgcn_rcpf(1.f + __builtin_amdgcn_exp2f(x[j] * -1.44269504f));
                                w[2 * bj + n] = pk4_fp8(s[0], s[1], s[2], s[3]); }
                        *(u32x4*)(zb + (size_t)(ai * HALF + m * 16 + rb_) * (NZ * 2) + cb) = (u32x4){w[0], w[1], w[2], w[3]}; }
            } else {
                const int cg = 2048 + (t - 18) * 256 + cl;
#pragma unroll
                for (int ai = 0; ai < 2; ++ai)
#pragma unroll
                    for (int m = 0; m < 4; ++m) { unsigned w[4];
#pragma unroll
                        for (int bj = 0; bj < 2; ++bj)
#pragma unroll
                            for (int n = 0; n < 2; ++n) { const f32x4 x = acc[ai][bj][m][n] * (scale * -1.44269504f); unsigned pk = 0u;
#pragma unroll
                                for (int j = 0; j < 4; ++j) { const float c = fmaxf(255.f * __builtin_amdgcn_rcpf(1.f + __builtin_amdgcn_exp2f(x[j])), 1.f);
                                    pk = j == 0 ? __builtin_amdgcn_cvt_pk_u8_f32(c, 0, pk) : j == 1 ? __builtin_amdgcn_cvt_pk_u8_f32(c, 1, pk) : j == 2 ? __builtin_amdgcn_cvt_pk_u8_f32(c, 2, pk) : __builtin_amdgcn_cvt_pk_u8_f32(c, 3, pk); }
                                w[2 * bj + n] = pk; }
                        *(u32x4*)(zb + (size_t)(ai * HALF + m * 16 + rb_) * (NZ * 2) + cg) = (u32x4){w[0], w[1], w[2], w[3]}; }
            }
        }
    }
};
__device__ __forceinline__ f32x4 u8x4_f32(unsigned w) { return (f32x4){(float)(w & 255u), (float)((w >> 8) & 255u), (float)((w >> 16) & 255u), (float)(w >> 24)}; }
struct EpiMerge {
    static constexpr bool MID = true; static constexpr int NSTORES = 16;
    const bf16* Zlat; bf16* out;
    __device__ __forceinline__ void mid(f32x4 (&acc)[2][2][4][2], const Unit& u, int wr, int wc, int fr, int fq) const {
        int rb_ = wr * 64 + fr; asm volatile("" : "+v"(rb_));
#pragma unroll
        for (int ai = 0; ai < 2; ++ai)
#pragma unroll
            for (int m = 0; m < 4; ++m) { const int row = u.pm * BM + ai * HALF + m * 16 + rb_; const unsigned char* zg = (const unsigned char*)Zlat + (size_t)row * (NZ * 2) + 2048;
#pragma unroll
                for (int bj = 0; bj < 2; ++bj) { const int col = u.pn * BM + bj * HALF + wc * 32 + 8 * fq;
                    const u32x2 aw = *(const u32x2*)(zg + col), bw = *(const u32x2*)(zg + 1024 + col);
                    const f32x4 a0 = u8x4_f32(aw.x), a1 = u8x4_f32(aw.y), b0 = u8x4_f32(bw.x), b1 = u8x4_f32(bw.y);
#pragma unroll
                    for (int j = 0; j < 4; ++j) { acc[ai][bj][m][0][j] *= a0[j] * __builtin_amdgcn_rcpf(b0[j]); acc[ai][bj][m][1][j] *= a1[j] * __builtin_amdgcn_rcpf(b1[j]); } } }
    }
    __device__ __forceinline__ void operator()(const f32x4 (&acc)[2][2][4][2], const Unit& u, int wr, int wc, int fr, int fq) const {
        EPI_LOOP_BEGIN
            const u32x2 gw = *(const u32x2*)((const unsigned char*)Zlat + (size_t)row * (NZ * 2) + 3072 + col);
            v0 = v0 * (u8x4_f32(gw.x) * (1.f / 255.f)); v1 = v1 * (u8x4_f32(gw.y) * (1.f / 255.f));
            *(u32x4*)(out + (size_t)row * D + col) = pack8(v0, v1);
        EPI_LOOP_END
    }
};
template <bool F8> __device__ __forceinline__ void store8(void* base, size_t idx, f32x4 v0, f32x4 v1) {
    if constexpr (F8) { u32x2 w; w.x = pk4_fp8(v0[0], v0[1], v0[2], v0[3]); w.y = pk4_fp8(v1[0], v1[1], v1[2], v1[3]); *(u32x2*)((unsigned char*)base + idx) = w; }
    else *(u32x4*)((bf16*)base + idx) = pack8(v0, v1);
}
template <bool F8> struct EpiStore {
    static constexpr int NSTORES = 16;
    void* out; int ldc; float scale;
    __device__ __forceinline__ void operator()(const f32x4 (&acc)[2][2][4][2], const Unit& u, int wr, int wc, int fr, int fq) const {
        EPI_LOOP_BEGIN
            store8<F8>(out, (size_t)row * ldc + col, v0 * scale, v1 * scale);
        EPI_LOOP_END
    }
};
struct EpiGateUp {
    static constexpr bool PRE = true; static constexpr int NSTORES = 8;
    bf16* H0; bf16* H1; const float* bg; const float* bu;
    __device__ __forceinline__ void pre(const Unit& u, LAS float* ec, int wc, int lane) const {
        glds4((lane < 32 ? bg : bu) + (size_t)u.e * FF + u.pn * HALF + wc * 32 + (lane & 31), ec); }
    __device__ __forceinline__ void operator()(const f32x4 (&acc)[2][2][4][2], const Unit& u, int wr, int wc, int fr, int fq, const LAS float* ec) const {
        const int ocol = u.pn * HALF + wc * 32 + 8 * fq;
        const f32x4 bg0 = *(const LAS f32x4*)(ec + 8 * fq), bg1 = *(const LAS f32x4*)(ec + 8 * fq + 4), bu0 = *(const LAS f32x4*)(ec + 32 + 8 * fq), bu1 = *(const LAS f32x4*)(ec + 32 + 8 * fq + 4);
        int rb_ = wr * 64 + fr; asm volatile("" : "+v"(rb_));
#pragma unroll
        for (int ai = 0; ai < 2; ++ai)
#pragma unroll
            for (int m = 0; m < 4; ++m) { const int row = u.pm * BM + ai * HALF + m * 16 + rb_;
                constexpr float ws = 1.f / MOE_WSCALE;
                f32x4 g0 = acc[ai][0][m][0] * ws + bg0, g1 = acc[ai][0][m][1] * ws + bg1, u0 = acc[ai][1][m][0] * ws + bu0, u1 = acc[ai][1][m][1] * ws + bu1, o0, o1;
#pragma unroll
                for (int j = 0; j < 4; ++j) { g0[j] = fminf(g0[j], 7.f); g1[j] = fminf(g1[j], 7.f); u0[j] = fminf(fmaxf(u0[j], -7.f), 7.f); u1[j] = fminf(fmaxf(u1[j], -7.f), 7.f); }
                f32x4 e0 = g0 * (-1.702f * 1.44269504f), e1 = g1 * (-1.702f * 1.44269504f);
#pragma unroll
                for (int j = 0; j < 4; ++j) { e0[j] = __builtin_amdgcn_exp2f(e0[j]); e1[j] = __builtin_amdgcn_exp2f(e1[j]); }
                e0 = e0 + 1.f; e1 = e1 + 1.f;
#pragma unroll
                for (int j = 0; j < 4; ++j) { e0[j] = __builtin_amdgcn_rcpf(e0[j]); e1[j] = __builtin_amdgcn_rcpf(e1[j]); }
                o0 = (g0 * e0) * (u0 + 1.f); o1 = (g1 * e1) * (u1 + 1.f);
                if constexpr (kMoeFp8) { unsigned char* hp = (row < H_SPLIT_TILES * BM) ? (unsigned char*)H0 + (size_t)row * FF : (unsigned char*)H1 + (size_t)(row - H_SPLIT_TILES * BM) * FF;
                    u32x2 w; w.x = pk4_fp8(o0[0], o0[1], o0[2], o0[3]); w.y = pk4_fp8(o1[0], o1[1], o1[2], o1[3]); *(u32x2*)(hp + ocol) = w; }
                else { bf16* hp = (row < H_SPLIT_TILES * BM) ? H0 + (size_t)row * FF : H1 + (size_t)(row - H_SPLIT_TILES * BM) * FF;
                    *(u32x4*)(hp + ocol) = pack8(o0, o1); } }
    }
};
struct EpiDown {
    static constexpr bool PRE = true; static constexpr int NSTORES = 8;
    bf16* Y; const float* bd;
    __device__ __forceinline__ void pre(const Unit& u, LAS float* ec, int wc, int lane) const {
        glds4(bd + (size_t)u.e * D + u.pn * BM + wc * 64 + lane, ec); }
    __device__ __forceinline__ void operator()(const f32x4 (&acc)[2][2][4][2], const Unit& u, int wr, int wc, int fr, int fq, const LAS float* ec) const {
        static_assert(kActFp8, "Y rows are fp8");
        f32x4 b0[2], b1[2];
#pragma unroll
        for (int bj = 0; bj < 2; ++bj) { b0[bj] = *(const LAS f32x4*)(ec + 16 * fq + 8 * bj); b1[bj] = *(const LAS f32x4*)(ec + 16 * fq + 8 * bj + 4); }
        int rb_ = wr * 64 + fr; asm volatile("" : "+v"(rb_));
        unsigned char* const yb = (unsigned char*)Y + u.pn * BM + wc * 64 + 16 * fq;
#pragma unroll
        for (int ai = 0; ai < 2; ++ai)
#pragma unroll
            for (int m = 0; m < 4; ++m) { const int row = u.pm * BM + ai * HALF + m * 16 + rb_; u32x4 o;
                { const f32x4 v0 = acc[ai][0][m][0] * (1.f / MOE_WSCALE) + b0[0], v1 = acc[ai][0][m][1] * (1.f / MOE_WSCALE) + b1[0]; o.x = pk4_fp8(v0[0], v0[1], v0[2], v0[3]); o.y = pk4_fp8(v1[0], v1[1], v1[2], v1[3]); }
                { const f32x4 v0 = acc[ai][1][m][0] * (1.f / MOE_WSCALE) + b0[1], v1 = acc[ai][1][m][1] * (1.f / MOE_WSCALE) + b1[1]; o.z = pk4_fp8(v0[0], v0[1], v0[2], v0[3]); o.w = pk4_fp8(v1[0], v1[1], v1[2], v1[3]); }
                *(u32x4*)(yb + (size_t)row * D) = o; }
    }
};
}

constexpr int RING_BYTES = 131072;
constexpr int LDSCTL_OFF = RING_BYTES;
constexpr int LDS_BYTES = 163840;
constexpr int MISC_OFF = LDS_BYTES - 128;

#define XB_TMO      128
#define XB_XCNT(j)  (256  + 64 * (j))
#define XB_XSUB(j)  (1280 + 64 * (j))
#define XB_XGEN(j)  (2304 + 64 * (j))
#define XB_TOP      3328
#define XB_TOPGEN   3392
#define XCD_BAR_WORDS 3456
#define XB_SPIN_CAP (1u << 22)
__device__ __forceinline__ unsigned xb_ld(unsigned* p)              { return __hip_atomic_load(p, __ATOMIC_RELAXED, __HIP_MEMORY_SCOPE_AGENT); }
__device__ __forceinline__ unsigned xb_add(unsigned* p, unsigned v) { return __hip_atomic_fetch_add(p, v, __ATOMIC_RELAXED, __HIP_MEMORY_SCOPE_AGENT); }
__device__ __forceinline__ unsigned xb_xcc_id() { return (unsigned)__builtin_amdgcn_s_getreg((3 << 11) | 20) & 0xFu; }
#define XB_SPIN(cond, bar) do { unsigned _sp = 0; while (cond) { __builtin_amdgcn_s_sleep(1); \
    if ((++_sp & 255u) == 0u) { if (xb_ld(&(bar)[XB_TMO])) break; if (_sp > XB_SPIN_CAP) { atomicAdd(&(bar)[XB_TMO], 1u); break; } } } } while (0)
struct XcdBarrier { unsigned* bar; unsigned x; volatile LAS unsigned* st; };
__device__ __forceinline__ XcdBarrier xcd_barrier_post(unsigned* bar, volatile LAS unsigned* st) {
    XcdBarrier b; b.bar = bar; b.x = xb_xcc_id(); b.st = st;
    if (threadIdx.x == 0) (void)xb_add(&bar[XB_XCNT(b.x)], 1u);
    return b;
}
__device__ __forceinline__ void xcd_barrier_complete(unsigned* bar, unsigned x, unsigned& nloc, unsigned& nx) {
    const unsigned G = gridDim.x * gridDim.y * gridDim.z;
    unsigned sum, cnt, mine, sp = 0u;
    for (;;) {
        sum = 0u; cnt = 0u; mine = 0u;
#pragma unroll
        for (unsigned j = 0; j < 16; ++j) { const unsigned c = xb_ld(&bar[XB_XCNT(j)]); sum += c; cnt += (c > 0u) ? 1u : 0u; mine = (j == x) ? c : mine; }
        if (sum == G) break;
        __builtin_amdgcn_s_sleep(1);
        if ((++sp & 255u) == 0u) { if (xb_ld(&bar[XB_TMO])) break; if (sp > XB_SPIN_CAP) { atomicAdd(&bar[XB_TMO], 1u); break; } }
    }
    nloc = mine > 0u ? mine : 1u; nx = cnt > 0u ? cnt : 1u;
}
__device__ __forceinline__ void xcd_barrier(const XcdBarrier& b) {
    asm volatile("s_waitcnt vmcnt(0)" ::: "memory");
    __syncthreads();
    if (threadIdx.x == 0) {
        unsigned* bar = b.bar;
        __builtin_amdgcn_s_waitcnt(0);
        unsigned nloc = b.st[0], nx = b.st[1];
        if (nloc == 0u) { xcd_barrier_complete(bar, b.x, nloc, nx); b.st[0] = nloc; b.st[1] = nx; }
        const unsigned old = xb_add(&bar[XB_XSUB(b.x)], 1u);
        const unsigned gen = old / nloc;
        if (old + 1u == (gen + 1u) * nloc) {
            __builtin_amdgcn_fence(__ATOMIC_RELEASE, "agent");
            asm volatile("s_waitcnt vmcnt(0)" ::: "memory");
            const unsigned og = xb_add(&bar[XB_TOP], 1u);
            const unsigned tg = og / nx;
            if (og + 1u == (tg + 1u) * nx) xb_add(&bar[XB_TOPGEN], 1u);
            else XB_SPIN(xb_ld(&bar[XB_TOPGEN]) == tg, bar);
            __builtin_amdgcn_fence(__ATOMIC_ACQUIRE, "agent");
            xb_add(&bar[XB_XGEN(b.x)], 1u);
            asm volatile("s_waitcnt vmcnt(0)" ::: "memory");
        } else {
            XB_SPIN(xb_ld(&bar[XB_XGEN(b.x)]) == gen, bar);
            __builtin_amdgcn_fence(__ATOMIC_ACQUIRE, "agent");
            asm volatile("s_waitcnt vmcnt(0)" ::: "memory");
        }
    }
    __syncthreads();
}

struct Args { const float* in[27]; float* out; unsigned char* ws; int ph_lo, ph_hi; };
enum { I_X = 0, I_C, I_CTX, I_CCTX, I_WADA, I_BADA, I_GPREMIX, I_GPOSTMIX, I_GPREFFN, I_GPOSTFFN, I_WIN, I_HLB, I_HNW, I_GKW2, I_GKB, I_GNW, I_WUPA, I_WUPB, I_WO, I_WR, I_BR, I_WG, I_BG, I_WU, I_BU, I_WDN, I_BDN };
struct Frame { LAS unsigned char* lds; int tid, lane, wave, vcu, G; const Args* a; };

__device__ __forceinline__ void transpose_item(const float* src, int ld, bf16* dst, int dpitch, LAS float* scr, int lane) {
    float tv[32];
#pragma unroll
    for (int i = 0; i < 32; ++i) tv[i] = __builtin_nontemporal_load(src + (size_t)(2 * i + (lane >> 5)) * ld + (lane & 31));
#pragma unroll
    for (int i = 0; i < 32; ++i) scr[(2 * i + (lane >> 5)) * 33 + (lane & 31)] = tv[i];
    LDS_WAIT(); asm volatile("" ::: "memory");
    const int c = lane & 7;
#pragma unroll
    for (int j = 0; j < 4; ++j) { const int n = (lane >> 3) + 8 * j; const LAS float* s = scr + (8 * c) * 33 + n;
        u32x4 o; o.x = pk2(s[0 * 33], s[1 * 33]); o.y = pk2(s[2 * 33], s[3 * 33]); o.z = pk2(s[4 * 33], s[5 * 33]); o.w = pk2(s[6 * 33], s[7 * 33]);
        *(u32x4*)(dst + (size_t)n * dpitch + 8 * c) = o; }
    LDS_WAIT(); asm volatile("" ::: "memory");
}

__device__ __forceinline__ void transpose_item_fp8(const float* src, int ld, unsigned char* dst, int dpitch, LAS float* scr, int lane, float sc) {
    float tv[32];
#pragma unroll
    for (int i = 0; i < 32; ++i) tv[i] = __builtin_nontemporal_load(src + (size_t)(2 * i + (lane >> 5)) * ld + (lane & 31));
#pragma unroll
    for (int i = 0; i < 32; ++i) scr[(2 * i + (lane >> 5)) * 33 + (lane & 31)] = tv[i];
    LDS_WAIT(); asm volatile("" ::: "memory");
    const int c = lane & 7;
#pragma unroll
    for (int j = 0; j < 4; ++j) { const int n = (lane >> 3) + 8 * j; const LAS float* s = scr + (8 * c) * 33 + n;
        u32x2 o; o.x = pk4_fp8(s[0 * 33] * sc, s[1 * 33] * sc, s[2 * 33] * sc, s[3 * 33] * sc); o.y = pk4_fp8(s[4 * 33] * sc, s[5 * 33] * sc, s[6 * 33] * sc, s[7 * 33] * sc);
        *(u32x2*)(dst + (size_t)n * dpitch + 8 * c) = o; }
    LDS_WAIT(); asm volatile("" ::: "memory");
}

__device__ __forceinline__ int inproj_src_col(int n) {
    const int t = n >> 8, rho = n & 255;
    if (t < 12) { const int a = 2 * (rho >> 7) + ((rho >> 2) & 1), cc = 16 * ((rho >> 5) & 3) + 4 * ((rho >> 3) & 3) + (rho & 3);
        if (t < 8) return a * 512 + (t >> 1) * 128 + (t & 1) * 64 + cc;
        const int h = t - 8; if (a == 0) return 2560 + h * 64 + cc; if (a == 1) return 2816 + h * 64 + cc; return -1 - ((a - 2) * 256 + h * 64 + cc); }
    if (t < 14) return 3072 + (n - 12 * 256);
    if (t < 16) return 2048 + (n - 14 * 256);
    return 3616 + (n - 16 * 256);
}
__device__ __forceinline__ void transpose_item_cols(const float* Wk, int ld, int col, bf16* dst, int dpitch, LAS float* scr, int lane) {
    float tv[32];
#pragma unroll
    for (int i = 0; i < 32; ++i) tv[i] = Wk[(size_t)(2 * i + (lane >> 5)) * ld + col];
#pragma unroll
    for (int i = 0; i < 32; ++i) scr[(2 * i + (lane >> 5)) * 33 + (lane & 31)] = tv[i];
    LDS_WAIT(); asm volatile("" ::: "memory");
    const int c = lane & 7;
#pragma unroll
    for (int j = 0; j < 4; ++j) { const int n = (lane >> 3) + 8 * j; const LAS float* s = scr + (8 * c) * 33 + n;
        u32x4 o; o.x = pk2(s[0 * 33], s[1 * 33]); o.y = pk2(s[2 * 33], s[3 * 33]); o.z = pk2(s[4 * 33], s[5 * 33]); o.w = pk2(s[6 * 33], s[7 * 33]);
        *(u32x4*)(dst + (size_t)n * dpitch + 8 * c) = o; }
    LDS_WAIT(); asm volatile("" ::: "memory");
}

__device__ __forceinline__ void p0_mod(const Frame& F, int item) {
    const Args& A = *F.a;
    LAS float* sc = (LAS float*)F.lds; LAS float* part = sc + 17 * 1024;
    const float* wp = A.in[I_WADA] + (size_t)(F.wave * 128) * 6144 + item * 64 + F.lane;
    float wv[32], wn[32];
#pragma unroll
    for (int i = 0; i < 32; ++i) wv[i] = wp[(size_t)i * 6144];
    for (int i = F.tid; i < 17 * 1024; i += NTHREADS) { const int r = i >> 10, k = i & 1023; const float v = (r < 16) ? A.in[I_C][r * 1024 + k] : A.in[I_CCTX][k]; sc[i] = v * sigmoidf_(v); }
    __syncthreads();
    const int k0 = F.wave * 128;
    float acc[17];
#pragma unroll
    for (int r = 0; r < 17; ++r) acc[r] = 0.f;
#pragma unroll
    for (int bq = 0; bq < 4; ++bq) {
        if (bq < 3) {
#pragma unroll
            for (int i = 0; i < 32; ++i) wn[i] = wp[(size_t)(32 * (bq + 1) + i) * 6144]; }
#pragma unroll
        for (int i4 = 0; i4 < 8; ++i4) { const int k = k0 + 32 * bq + 4 * i4;
#pragma unroll
            for (int r = 0; r < 17; ++r) { const f32x4 s = *(const LAS f32x4*)(sc + r * 1024 + k); acc[r] += s.x * wv[4 * i4] + s.y * wv[4 * i4 + 1] + s.z * wv[4 * i4 + 2] + s.w * wv[4 * i4 + 3]; } }
        if (bq < 3) {
#pragma unroll
            for (int i = 0; i < 32; ++i) wv[i] = wn[i]; }
    }
#pragma unroll
    for (int r = 0; r < 17; ++r) part[(F.wave * 17 + r) * 64 + F.lane] = acc[r];
    __syncthreads();
    float* mod = (float*)(A.ws + WS_MOD);
    for (int i = F.tid; i < 17 * 64; i += NTHREADS) { const int r = i >> 6, l = i & 63; float s = A.in[I_BADA][item * 64 + l];
#pragma unroll
        for (int w = 0; w < 8; ++w) s += part[(w * 17 + r) * 64 + l];
        mod[r * 6144 + item * 64 + l] = s; }
    __syncthreads();
}

__device__ __forceinline__ void p0_prologue(const Frame& F) {
    const Args& A = *F.a;
    if (F.vcu < 96) p0_mod(F, F.vcu);
    LAS float* scr = (LAS float*)(F.lds + F.wave * 16384);
    const int gw = F.vcu * NWAVES + F.wave, NGW = F.G * NWAVES;
    bf16* win_t = (bf16*)(A.ws + WS_WIN);
    constexpr int I_WIN_ITEMS = 16 * 208, I_WU = 8 * 32, I_WO_ITEMS = 16 * 32;
    for (int it = gw; it < I_WIN_ITEMS + 2 * I_WU + I_WO_ITEMS; it += NGW) {
        int r = it;
        if (r < I_WIN_ITEMS) { const int kb = r / 208, nb = r % 208, n0 = nb * 32;
            if (n0 < NT_HI * 256) { const int col = inproj_src_col(n0 + (F.lane & 31)); if (col < 0) continue;
                transpose_item_cols(A.in[I_WIN] + (size_t)(64 * kb) * IN_DIM, IN_DIM, col, win_t + (size_t)n0 * D + 64 * kb, D, scr, F.lane); }
            else { const int jl = n0 - NT_HI * 256; const float* sp = A.in[I_WIN] + (size_t)(64 * kb) * IN_DIM + (jl < 512 ? 2048 + jl : jl < 1024 ? 3616 + (jl - 512) : 4128 + (jl - 1024));
                if constexpr (kInFp8) transpose_item_fp8(sp, IN_DIM, (unsigned char*)(A.ws + WS_WIN_LO) + (size_t)(n0 - NT_HI * 256) * D + 64 * kb, D, scr, F.lane, IN_WSCALE);
                else transpose_item(sp, IN_DIM, (bf16*)(A.ws + WS_WIN_LO) + (size_t)(n0 - NT_HI * 256) * D + 64 * kb, D, scr, F.lane); }
            continue; }
        r -= I_WIN_ITEMS;
        if (r < I_WU) { const int kb = r / 32, nb = r % 32; transpose_item(A.in[I_WUPA] + (size_t)(64 * kb) * D + 32 * nb, D, (bf16*)(A.ws + WS_WUA) + (size_t)(32 * nb) * 1024 + 64 * kb, 1024, scr, F.lane); continue; }
        r -= I_WU;
        if (r < I_WU) { const int kb = r / 32, nb = r % 32; transpose_item(A.in[I_WUPB] + (size_t)(64 * kb) * D + 32 * nb, D, (bf16*)(A.ws + WS_WUA) + (size_t)(32 * nb) * 1024 + 512 + 64 * kb, 1024, scr, F.lane); continue; }
        r -= I_WU;
        { const int kb = r / 32, nb = r % 32; transpose_item(A.in[I_WO] + (size_t)(64 * kb) * D + 32 * nb, D, (bf16*)(A.ws + WS_WO) + (size_t)(32 * nb) * D + 64 * kb, D, scr, F.lane); }
    }
    const int gt = F.vcu * NTHREADS + F.tid, NGT = F.G * NTHREADS;
    for (int it = gt; it < 2 * 256 * 128; it += NGT) {
        const int k8 = it & 127, n = (it >> 7) & 255, dir = it >> 15;
        float w2[16];
#pragma unroll
        for (int r = 0; r < 16; ++r) w2[r] = A.in[I_GKW2][(dir * 16 + r) * 256 + n];
        float o[8];
#pragma unroll
        for (int kk = 0; kk < 8; ++kk) { const float* wr = A.in[I_WIN] + (size_t)(k8 * 8 + kk) * IN_DIM + 3584 + 16 * dir; float s = 0.f;
#pragma unroll
            for (int r4 = 0; r4 < 4; ++r4) { const f32x4 w = *(const f32x4*)(wr + 4 * r4); s += w.x * w2[4 * r4] + w.y * w2[4 * r4 + 1] + w.z * w2[4 * r4 + 2] + w.w * w2[4 * r4 + 3]; }
            o[kk] = s; }
        { u32x4 pk; pk.x = pk2(o[0], o[1]); pk.y = pk2(o[2], o[3]); pk.z = pk2(o[4], o[5]); pk.w = pk2(o[6], o[7]);
            const int cc = n & 63, rho = 128 + 32 * (cc >> 4) + 8 * ((cc >> 2) & 3) + 4 * dir + (cc & 3);
            *(u32x4*)(win_t + (size_t)(256 * (8 + (n >> 6)) + rho) * D + k8 * 8) = pk; }
    }
    bf16* wrb = (bf16*)(A.ws + WS_WRT);
    for (int it = gt; it < NE * D; it += NGT) { const int e = it >> 10, k = it & 1023; wrb[it] = (bf16)f2bf(A.in[I_WR][k * NE + e]); }
}

template <int WHICH> __device__ __forceinline__ void convert_expert_weights(const Frame& F) {
    static_assert(kMoeFp8, "fp8 expert weights");
    const Args& A = *F.a;
    LAS float* scr = (LAS float*)(F.lds + F.wave * 16384);
    const int gw = F.vcu * NWAVES + F.wave, NGW = F.G * NWAVES, lane = F.lane;
    constexpr int PER_E = WHICH == 0 ? 16 * 64 : 16 * 32, NIT = NE * PER_E;
    auto item = [&](int it, const float*& src, unsigned char*& dst) { const int e = it / PER_E, r = it % PER_E;
        if (WHICH == 0) { const int kb = r / 64, nb = r % 64, n0 = 32 * nb, pn = n0 >> 8, rr = n0 & 255;
            src = (rr < 128 ? A.in[I_WG] : A.in[I_WU]) + (size_t)e * D * FF + (size_t)(64 * kb) * FF + 128 * pn + (rr & 127);
            dst = A.ws + WS_WGU + (size_t)e * 2048 * D + (size_t)n0 * D + 64 * kb; }
        else { const int kb = r / 32, nb = r % 32; src = A.in[I_WDN] + (size_t)e * FF * D + (size_t)(64 * kb) * D + 32 * nb;
            dst = A.ws + WS_WD + (size_t)e * D * FF + (size_t)(32 * nb) * FF + 64 * kb; } };
    constexpr int ld = 1024;
    float tv[32], tn[32]; const float* src; unsigned char* dst; int it = gw;
    if (it < NIT) { item(it, src, dst);
#pragma unroll
        for (int i = 0; i < 32; ++i) tv[i] = __builtin_nontemporal_load(src + (size_t)(2 * i + (lane >> 5)) * ld + (lane & 31)); }
    while (it < NIT) {
        const int itn = it + NGW; const float* srcn = src; unsigned char* dstn = dst;
        if (itn < NIT) { item(itn, srcn, dstn);
#pragma unroll
            for (int i = 0; i < 32; ++i) tn[i] = __builtin_nontemporal_load(srcn + (size_t)(2 * i + (lane >> 5)) * ld + (lane & 31)); }
#pragma unroll
        for (int i = 0; i < 32; ++i) scr[(2 * i + (lane >> 5)) * 33 + (lane & 31)] = tv[i];
        LDS_WAIT(); asm volatile("" ::: "memory");
        { const int c = lane & 7;
#pragma unroll
          for (int j = 0; j < 4; ++j) { const int n = (lane >> 3) + 8 * j; const LAS float* s = scr + (8 * c) * 33 + n;
              u32x2 o; o.x = pk4_fp8(s[0 * 33] * MOE_WSCALE, s[1 * 33] * MOE_WSCALE, s[2 * 33] * MOE_WSCALE, s[3 * 33] * MOE_WSCALE);
              o.y = pk4_fp8(s[4 * 33] * MOE_WSCALE, s[5 * 33] * MOE_WSCALE, s[6 * 33] * MOE_WSCALE, s[7 * 33] * MOE_WSCALE);
              *(u32x2*)(dst + (size_t)n * D + 8 * c) = o; } }
        LDS_WAIT(); asm volatile("" ::: "memory");
        if (itn < NIT) {
#pragma unroll
            for (int i = 0; i < 32; ++i) tv[i] = tn[i]; }
        src = srcn; dst = dstn; it = itn;
    }
}

__device__ __forceinline__ void p1_prenorm(const Frame& F) {
    const Args& A = *F.a;
    const int gw = F.vcu * NWAVES + F.wave, NGW = F.G * NWAVES;
    const float* mod = (const float*)(A.ws + WS_MOD); bf16* hbf = (bf16*)(A.ws + WS_HBF);
    for (int m = gw; m < MALL; m += NGW) {
        const float* xr = (m < TC) ? A.in[I_CTX] + (size_t)m * D : A.in[I_X] + (size_t)(m - TC) * D;
        const float* md = mod + (size_t)((m < TC) ? 16 : (m - TC) / SEQ) * 6144;
        f32x4 v[4]; float ss = 0.f;
#pragma unroll
        for (int j = 0; j < 4; ++j) { v[j] = *((const f32x4*)xr + F.lane + 64 * j); ss += (v[j].x * v[j].x + v[j].y * v[j].y) + (v[j].z * v[j].z + v[j].w * v[j].w); }
        const float rstd = rsqrtf(wave_sum(ss) * (1.f / D) + EPS);
#pragma unroll
        for (int j = 0; j < 4; ++j) { const int k = 4 * (F.lane + 64 * j);
            const f32x4 g = *(const f32x4*)(A.in[I_GPREMIX] + k), sh = *(const f32x4*)(md + k), sc = *(const f32x4*)(md + 1024 + k);
            const f32x4 h = v[j] * rstd * g * (sc + 1.f) + sh;
            { u32x2 o; o.x = pk2(h.x, h.y); o.y = pk2(h.z, h.w); *((u32x2*)(hbf + (size_t)m * D) + F.lane + 64 * j) = o; }
            if (m >= TC) { if constexpr (kInFp8) *((unsigned*)((unsigned char*)A.out + (size_t)(m - TC) * D) + F.lane + 64 * j) = pk4_fp8(h.x, h.y, h.z, h.w);
                           else { u32x2 o; o.x = pk2(h.x, h.y); o.y = pk2(h.z, h.w); *((u32x2*)((bf16*)A.out + (size_t)(m - TC) * D) + F.lane + 64 * j) = o; } } }
    }
}

typedef short v4i16_t __attribute__((ext_vector_type(4)));
typedef short s16x4 __attribute__((ext_vector_type(4)));
__device__ __forceinline__ s16x4 lds_tr16(const LAS unsigned char* p) { return __builtin_bit_cast(s16x4, __builtin_amdgcn_ds_read_tr16_b64_v4i16((LAS v4i16_t*)p)); }
#define LBAR() do { asm volatile("s_waitcnt lgkmcnt(0)" ::: "memory"); __builtin_amdgcn_s_barrier(); asm volatile("" ::: "memory"); } while (0)

template <int DK, bool HGRN> __device__ __forceinline__ void scan_chain(const Frame& F, LAS unsigned char* L, int hv, int wl, int tl, bf16* obase) {
    const Args& A = *F.a;
    const float* ELg = (const float*)(A.ws + WS_EL);
    const int b = hv >> 3, h = (hv >> 1) & 3, dir = hv & 1;
    const int lane = tl & 63, l15 = lane & 15, g = lane >> 4;
    constexpr int PQ = DK * 2 + 16;
    constexpr int PV = 272;
    constexpr int PP = 144;
    constexpr int NCH = DK / 8;
    constexpr int NLD = DK / 64;
    constexpr int KS = DK / 32;
    LAS unsigned char* RQ = L;
    LAS unsigned char* RK = RQ + 64 * PQ;
    LAS unsigned char* VI = RK + 64 * PQ;
    LAS unsigned char* PI = VI + 64 * PV;
    constexpr int TSZ = 64 * DK * 2;
    const unsigned char* const qk0 = A.ws + (HGRN ? WS_RQA : WS_RQB) + (size_t)hv * NSTEP * 2 * TSZ;
    const unsigned char* const v0 = A.ws + (HGRN ? WS_RVA : WS_RVB) + (size_t)(hv >> 1) * NSTEP * 16384;
    const float* elp = ELg + (size_t)dir * NCG * 768 + (HGRN ? 0 : 512) + h * DK;
    f32x4 S[DK / 16];
#pragma unroll
    for (int i = 0; i < DK / 16; ++i) S[i] = (f32x4){0.f, 0.f, 0.f, 0.f};
    u32x4 rq[2][NLD], rk[2][NLD], rv[2][2], rel[2];
    LAS unsigned char* ELs = PI + 64 * PP;
#define SCAN_ISSUE(set, s_) do { const int s__ = (s_); const unsigned char* qt = qk0 + (size_t)s__ * 2 * TSZ; \
        _Pragma("unroll") for (int q = 0; q < NLD; ++q) { const int ci = tl + 512 * q; \
            if (s__ >= 4) rq[set][q] = *(const u32x4*)(qt + 16 * ci); \
            rk[set][q] = *(const u32x4*)(qt + TSZ + 16 * ci); } \
        { const int sm = dir ? (s__ < 4 ? 3 - s__ : 39 - s__) : s__; const unsigned char* vt = v0 + (size_t)sm * 16384; \
          _Pragma("unroll") for (int q = 0; q < 2; ++q) rv[set][q] = *(const u32x4*)(vt + 16 * (tl + 512 * q)); } \
        { const int mc = (s__ < 4) ? (dir ? 3 - s__ : s__) : (dir ? 35 - s__ : s__ - 4), cg = (s__ < 4) ? 4 * b + mc : TC / 64 + 32 * b + mc; \
          if (tl < DK / 4) rel[set] = *(const u32x4*)(elp + (size_t)cg * 768 + 4 * tl); } } while (0)
    SCAN_ISSUE(0, 0); SCAN_ISSUE(1, 1);
#pragma nounroll
    for (int s2 = 0; s2 < 36; s2 += 2) {
#pragma unroll
      for (int par = 0; par < 2; ++par) {
        const int s = s2 + par;
        const bool lat = s >= 4;
#pragma unroll
        for (int q = 0; q < NLD; ++q) { const int ci = tl + 512 * q, h2 = ci >> 9, wcc = (ci >> 7) & 3, t = (ci >> 1) & 63, hf = ci & 1;
            if (lat) { LAS unsigned char* qd = RQ + t * PQ + 64 * (2 * h2 + (wcc >> 1)) + 32 * hf + 8 * (wcc & 1);
                *(LAS u32x2*)qd = (u32x2){rq[par][q].x, rq[par][q].y}; *(LAS u32x2*)(qd + 16) = (u32x2){rq[par][q].z, rq[par][q].w}; }
            *(LAS u32x4*)(RK + t * PQ + 2 * (64 * h2 + 16 * wcc + 8 * hf)) = rk[par][q]; }
#pragma unroll
        for (int q = 0; q < 2; ++q) { const int ci = tl + 512 * q;
            if constexpr (HGRN) { const int h2 = ci >> 9, wcc = (ci >> 7) & 3, tm = (ci >> 1) & 63, hf = ci & 1, t = dir ? 63 - tm : tm; *(LAS u32x4*)(VI + t * PV + 2 * (64 * h2 + 16 * wcc + 8 * hf)) = rv[par][q]; }
            else { const int tm = ci >> 4, t = dir ? 63 - tm : tm, cc = ci & 15; *(LAS u32x4*)(VI + t * PV + 16 * cc) = rv[par][q]; } }
        if (tl < DK / 4) *(LAS u32x4*)(ELs + 16 * tl) = rel[par];
        LBAR();
        if (s + 2 < 36) SCAN_ISSUE(par, s + 2);
        bf16x8 Vf[2];
#pragma unroll
        for (int ks2 = 0; ks2 < 2; ++ks2) { const int q = l15 >> 2, p = l15 & 3;
            const s16x4 lo = lds_tr16(VI + (32 * ks2 + 8 * g + q) * PV + 32 * wl + 8 * p), hi = lds_tr16(VI + (32 * ks2 + 8 * g + 4 + q) * PV + 32 * wl + 8 * p);
            Vf[ks2] = (bf16x8){lo[0], lo[1], lo[2], lo[3], hi[0], hi[1], hi[2], hi[3]}; }
        if (lat) {
            const int ib = (0x12333210 >> (4 * wl)) & 15, jlo = (0x00102110 >> (4 * wl)) & 15, jhi = (0x00103210 >> (4 * wl)) & 15;
            bf16x8 Bq[KS];
#pragma unroll
            for (int ks = 0; ks < KS; ++ks) Bq[ks] = *(const LAS bf16x8*)(RQ + (16 * ib + l15) * PQ + 64 * ks + 16 * g);
#pragma unroll
            for (int jt = 0; jt < 4; ++jt) { if (jt >= jlo && jt <= jhi) {
                f32x4 acc = (f32x4){0.f, 0.f, 0.f, 0.f};
#pragma unroll
                for (int ks = 0; ks < KS; ++ks) { const LAS unsigned char* kp = RK + (16 * jt + l15) * PQ + 64 * ks + 8 * g;
                    const s16x4 lo = *(const LAS s16x4*)kp, hi = *(const LAS s16x4*)(kp + 32);
                    const bf16x8 Ak = (bf16x8){lo[0], lo[1], lo[2], lo[3], hi[0], hi[1], hi[2], hi[3]};
                    acc = __builtin_amdgcn_mfma_f32_16x16x32_bf16(Ak, Bq[ks], acc, 0, 0, 0); }
                if (jt == ib) {
#pragma unroll
                    for (int r = 0; r < 4; ++r) if (4 * g + r > l15) acc[r] = 0.f; }
                u32x2 w; w.x = pk2(acc[0], acc[1]); w.y = pk2(acc[2], acc[3]);
                *(LAS u32x2*)(PI + (16 * ib + l15) * PP + 32 * jt + 8 * g) = w; } }
            if (wl == 0 || wl == 2) *(LAS u32x2*)(PI + (16 * wl + l15) * PP + 32 * (wl + 1) + 8 * g) = (u32x2){0u, 0u};
            LBAR();
            bf16x8 Sb[KS];
#pragma unroll
            for (int ks = 0; ks < KS; ++ks) { const f32x4 a = S[2 * ks], c = S[2 * ks + 1]; u32x4 w; w.x = pk2(a[0], a[1]); w.y = pk2(a[2], a[3]); w.z = pk2(c[0], c[1]); w.w = pk2(c[2], c[3]); Sb[ks] = __builtin_bit_cast(bf16x8, w); }
#pragma unroll
            for (int it = 0; it < 4; ++it) {
                f32x4 acc = (f32x4){0.f, 0.f, 0.f, 0.f};
                { const bf16x8 Pf = *(const LAS bf16x8*)(PI + (16 * it + l15) * PP + 16 * g); acc = __builtin_amdgcn_mfma_f32_16x16x32_bf16(Vf[0], Pf, acc, 0, 0, 0); }
                if (it >= 2) { const bf16x8 Pf = *(const LAS bf16x8*)(PI + (16 * it + l15) * PP + 64 + 16 * g); acc = __builtin_amdgcn_mfma_f32_16x16x32_bf16(Vf[1], Pf, acc, 0, 0, 0); }
#pragma unroll
                for (int ks = 0; ks < KS; ++ks) { const bf16x8 Bi = *(const LAS bf16x8*)(RQ + (16 * it + l15) * PQ + 64 * ks + 16 * g); acc = __builtin_amdgcn_mfma_f32_16x16x32_bf16(Sb[ks], Bi, acc, 0, 0, 0); }
                const int p = 64 * (s - 4) + 16 * it + l15, tok = dir ? SEQ - 1 - p : p;
                u32x2 w; w.x = pk2(acc[0], acc[1]); w.y = pk2(acc[2], acc[3]);
                *(u32x2*)(obase + ((size_t)dir * T + (size_t)b * SEQ + tok) * 512 + h * 128 + 16 * wl + 4 * g) = w;
            }
        }
#pragma unroll
        for (int dt = 0; dt < DK / 16; ++dt) {
#pragma unroll
            for (int ks2 = 0; ks2 < 2; ++ks2) { const int q = l15 >> 2, p = l15 & 3;
                const s16x4 lo = lds_tr16(RK + (32 * ks2 + 8 * g + q) * PQ + 32 * dt + 8 * p), hi = lds_tr16(RK + (32 * ks2 + 8 * g + 4 + q) * PQ + 32 * dt + 8 * p);
                const bf16x8 Kf = (bf16x8){lo[0], lo[1], lo[2], lo[3], hi[0], hi[1], hi[2], hi[3]};
                S[dt] = __builtin_amdgcn_mfma_f32_16x16x32_bf16(Kf, Vf[ks2], S[dt], 0, 0, 0); }
            S[dt] = S[dt] * *(const LAS f32x4*)(ELs + (16 * dt + 4 * g) * 4);
        }
        LBAR();
      }
    }
#undef SCAN_ISSUE
}

__device__ __forceinline__ void p4_readout(const Frame& F) {
    const Args& A = *F.a;
    const int gw = F.vcu * NWAVES + F.wave, NGW = F.G * NWAVES;
    const bf16* Z = (const bf16*)(A.ws + WS_Z); const bf16* O = (const bf16*)A.out;
    for (int it = gw; it < 2 * T; it += NGW) {
        const int br = it & 1, tok = it >> 1;
        const bf16* of = O + ((size_t)(br * 2 + 0) * T + tok) * 512 + 8 * F.lane; const bf16* ob = O + ((size_t)(br * 2 + 1) * T + tok) * 512 + 8 * F.lane;
        const u32x4 wf = *(const u32x4*)of, wb = *(const u32x4*)ob; const u32x2 wg = *(const u32x2*)((const unsigned char*)Z + (size_t)tok * (NZ * 2) + br * 512 + 8 * F.lane);
        f32x4 a0, a1, b0, b1, g0, g1; pg8::unpack8(wf, a0, a1); pg8::unpack8(wb, b0, b1);
        { const f32x2 p0 = __builtin_amdgcn_cvt_pk_f32_fp8((int)wg.x, false), p1 = __builtin_amdgcn_cvt_pk_f32_fp8((int)wg.x, true), p2 = __builtin_amdgcn_cvt_pk_f32_fp8((int)wg.y, false), p3 = __builtin_amdgcn_cvt_pk_f32_fp8((int)wg.y, true);
          g0 = (f32x4){p0.x, p0.y, p1.x, p1.y}; g1 = (f32x4){p2.x, p2.y, p3.x, p3.y}; }
        a0 += b0; a1 += b1;
        float ss = (a0.x * a0.x + a0.y * a0.y) + (a0.z * a0.z + a0.w * a0.w) + (a1.x * a1.x + a1.y * a1.y) + (a1.z * a1.z + a1.w * a1.w);
        ss += __shfl_xor(ss, 1); ss += __shfl_xor(ss, 2); ss += __shfl_xor(ss, 4); ss += __shfl_xor(ss, 8);
        const float rstd = rsqrtf(ss * (1.f / 128.f) + EPS);
        const float* nw = (br ? A.in[I_GNW] : A.in[I_HNW]) + (8 * F.lane & 127);
        const f32x4 n0 = *(const f32x4*)nw, n1 = *(const f32x4*)(nw + 4);
#pragma unroll
        for (int j = 0; j < 4; ++j) { a0[j] = a0[j] * rstd * n0[j] * g0[j]; a1[j] = a1[j] * rstd * n1[j] * g1[j]; }
        bf16* r = (bf16*)(A.ws + WS_RA) + (size_t)tok * 1024 + br * 512 + 8 * F.lane;
        *(u32x4*)r = pg8::pack8(a0, a1);
    }
}

__device__ __forceinline__ void load_row_bf16(const bf16* p, int lane, f32x4 (&v)[4]) {
#pragma unroll
    for (int j = 0; j < 4; ++j) { const u32x2 w = *((const u32x2*)p + lane + 64 * j); v[j] = (f32x4){bflo(w.x), bfhi(w.x), bflo(w.y), bfhi(w.y)}; }
}
__device__ __forceinline__ void load_row_fp8(const unsigned char* p, int lane, f32x4 (&v)[4]) {
#pragma unroll
    for (int j = 0; j < 4; ++j) { const int w = *((const int*)p + lane + 64 * j); const f32x2 a = __builtin_amdgcn_cvt_pk_f32_fp8(w, false), b = __builtin_amdgcn_cvt_pk_f32_fp8(w, true); v[j] = (f32x4){a.x, a.y, b.x, b.y}; }
}
template <bool F8> __device__ __forceinline__ void load_row_act(const void* base, size_t row, int lane, f32x4 (&v)[4]) {
    if constexpr (F8) load_row_fp8((const unsigned char*)base + row * D, lane, v); else load_row_bf16((const bf16*)base + row * D, lane, v);
}
__device__ __forceinline__ float sumsq4(const f32x4 (&v)[4]) { float s = 0.f;
#pragma unroll
    for (int j = 0; j < 4; ++j) s += (v[j].x * v[j].x + v[j].y * v[j].y) + (v[j].z * v[j].z + v[j].w * v[j].w);
    return s; }
__device__ __forceinline__ void compute_x1(const Args& A, int tok, int lane, const float* md, f32x4 (&x1)[4]) {
    f32x4 mx[4]; load_row_act<kMixFp8>(A.ws + WS_MIXB, (size_t)tok, lane, mx);
    const float rstd = rsqrtf(wave_sum(sumsq4(mx)) * (1.f / D) + EPS);
#pragma unroll
    for (int j = 0; j < 4; ++j) { const int k = 4 * (lane + 64 * j);
        const f32x4 xv = *(const f32x4*)(A.in[I_X] + (size_t)tok * D + k), g = *(const f32x4*)(A.in[I_GPOSTMIX] + k), gt = *(const f32x4*)(md + 2048 + k);
        x1[j] = xv + gt * (mx[j] * rstd * g); }
}

__device__ __forceinline__ void p8_router(const Frame& F) {
    const Args& A = *F.a;
    constexpr int WP = 2064;
    LAS unsigned char* WL = F.lds;
    LAS unsigned char* HB = WL + 32 * WP;
    LAS float* LG = (LAS float*)(HB + 16 * WP);
    int* hist = (int*)((unsigned char*)F.lds + 32 * WP + 16 * WP + 16 * 33 * 4);
    const u32x4* wrb = (const u32x4*)(A.ws + WS_WRT);
#pragma unroll
    for (int q = 0; q < 8; ++q) { const int i = F.tid + NTHREADS * q; *(LAS u32x4*)(WL + (i >> 7) * WP + 16 * (i & 127)) = wrb[i]; }
    if (F.tid < NE) hist[F.tid] = 0;
    __syncthreads();
    const float* mod = (const float*)(A.ws + WS_MOD); unsigned char* h2b = (unsigned char*)(A.ws + WS_H2);
    int* topi = (int*)(A.ws + WS_TOPI); float* topp = (float*)(A.ws + WS_TOPP); int* lrank = (int*)(A.ws + WS_LRANK);
    static_assert(kMoeFp8, "the router phase writes fp8 h2 rows");
    if (F.vcu == 0 && F.wave == 0) {
#pragma unroll
        for (int j = 0; j < 4; ++j) *((unsigned*)(h2b + (size_t)T * D) + F.lane + 64 * j) = 0u; }
    const int l15 = F.lane & 15, g = F.lane >> 4;
    for (int r = 0; r < 8; ++r) {
        const int base = 128 * F.vcu + 16 * r;
#pragma unroll
        for (int q = 0; q < 2; ++q) { const int row = 2 * F.wave + q, tok = base + row; const float* md = mod + (size_t)(tok / SEQ) * 6144;
            f32x4 x1[4]; compute_x1(A, tok, F.lane, md, x1);
            const float rstd = rsqrtf(wave_sum(sumsq4(x1)) * (1.f / D) + EPS);
#pragma unroll
            for (int j = 0; j < 4; ++j) { const int k = 4 * (F.lane + 64 * j);
                { u32x2 o; o.x = pk2(x1[j].x, x1[j].y); o.y = pk2(x1[j].z, x1[j].w); *((u32x2*)((bf16*)(A.ws + WS_X1B) + (size_t)tok * D) + F.lane + 64 * j) = o; }
                const f32x4 gg = *(const f32x4*)(A.in[I_GPREFFN] + k), sh = *(const f32x4*)(md + 3072 + k), sc = *(const f32x4*)(md + 4096 + k);
                const f32x4 h = x1[j] * rstd * gg * (sc + 1.f) + sh;
                *((unsigned*)(h2b + (size_t)tok * D) + F.lane + 64 * j) = pk4_fp8(h.x, h.y, h.z, h.w);
                u32x2 o; o.x = pk2(h.x, h.y); o.y = pk2(h.z, h.w); *(LAS u32x2*)(HB + row * WP + 8 * (F.lane + 64 * j)) = o; } }
        LBAR();
        if (F.wave < 2) { const int n = F.wave; f32x4 acc = (f32x4){0.f, 0.f, 0.f, 0.f};
#pragma unroll 8
            for (int ks = 0; ks < 32; ++ks) { const bf16x8 a = *(const LAS bf16x8*)(HB + l15 * WP + 64 * ks + 16 * g), bb = *(const LAS bf16x8*)(WL + (16 * n + l15) * WP + 64 * ks + 16 * g);
                acc = __builtin_amdgcn_mfma_f32_16x16x32_bf16(a, bb, acc, 0, 0, 0); }
            const float bias = A.in[I_BR][16 * n + l15];
#pragma unroll
            for (int rr = 0; rr < 4; ++rr) LG[(4 * g + rr) * 33 + 16 * n + l15] = acc[rr] + bias; }
        LBAR();
        if (F.wave == 2 && F.lane < 16) { const int tok = base + F.lane;
            float v0 = -INFINITY, v1 = -INFINITY, v2 = -INFINITY, v3 = -INFINITY; int i0 = 0, i1 = 0, i2 = 0, i3 = 0;
#pragma unroll 8
            for (int e = 0; e < NE; ++e) { const float x = LG[F.lane * 33 + e]; const bool c0 = x > v0, c1 = x > v1, c2 = x > v2, c3 = x > v3;
                v3 = c3 ? (c2 ? v2 : x) : v3; i3 = c3 ? (c2 ? i2 : e) : i3; v2 = c2 ? (c1 ? v1 : x) : v2; i2 = c2 ? (c1 ? i1 : e) : i2;
                v1 = c1 ? (c0 ? v0 : x) : v1; i1 = c1 ? (c0 ? i0 : e) : i1; v0 = c0 ? x : v0; i0 = c0 ? e : i0; }
            const float e1 = __expf(v1 - v0), e2 = __expf(v2 - v0), e3 = __expf(v3 - v0), inv = 1.f / (1.f + e1 + e2 + e3);
            *(i32x4*)(topi + tok * 4) = (i32x4){i0, i1, i2, i3}; *(f32x4*)(topp + tok * 4) = (f32x4){inv, e1 * inv, e2 * inv, e3 * inv};
            i32x4 lr; lr.x = __hip_atomic_fetch_add(hist + i0, 1, __ATOMIC_RELAXED, __HIP_MEMORY_SCOPE_WORKGROUP); lr.y = __hip_atomic_fetch_add(hist + i1, 1, __ATOMIC_RELAXED, __HIP_MEMORY_SCOPE_WORKGROUP);
            lr.z = __hip_atomic_fetch_add(hist + i2, 1, __ATOMIC_RELAXED, __HIP_MEMORY_SCOPE_WORKGROUP); lr.w = __hip_atomic_fetch_add(hist + i3, 1, __ATOMIC_RELAXED, __HIP_MEMORY_SCOPE_WORKGROUP);
            *(i32x4*)(lrank + tok * 4) = lr; }
    }
    __syncthreads();
    if (F.tid < NE) { unsigned* gc = (unsigned*)(A.ws + WS_CTL) + CW_GCOUNT; const int basec = (int)__hip_atomic_fetch_add(gc + F.tid, (unsigned)hist[F.tid], RLX_AGENT);
        ((int*)(A.ws + WS_BLKBASE))[F.vcu * NE + F.tid] = basec; }
    __syncthreads();
}

__device__ __forceinline__ void p9_slots(const Frame& F) {
    const Args& A = *F.a;
    int* ps = (int*)((unsigned char*)F.lds); int* cn = ps + 64;
    const unsigned* gc = (const unsigned*)(A.ws + WS_CTL) + CW_GCOUNT;
    if (F.tid < NE) cn[F.tid] = (int)__hip_atomic_load(gc + F.tid, RLX_AGENT);
    __syncthreads();
    if (F.tid == 0) { int acc = 0; for (int e = 0; e < NE; ++e) { ps[e] = acc; acc += (cn[e] + 255) & ~255; } ps[NE] = acc; }
    __syncthreads();
    const int* topi = (const int*)(A.ws + WS_TOPI); const int* lrank = (const int*)(A.ws + WS_LRANK); const int* blkbase = (const int*)(A.ws + WS_BLKBASE);
    int* pslot = (int*)(A.ws + WS_PSLOT); int* tokslot = (int*)(A.ws + WS_TOKSLOT);
    for (int p = F.vcu * NTHREADS + F.tid; p < T * TOPK; p += F.G * NTHREADS) {
        const int tok = p >> 2, e = topi[p], slot = ps[e] + blkbase[(tok >> 7) * NE + e] + lrank[p];
        tokslot[slot] = tok; pslot[p] = slot; }
    if (F.vcu < NE) { const int e = F.vcu, pad = ((cn[e] + 255) & ~255); for (int i = cn[e] + F.tid; i < pad; i += NTHREADS) tokslot[ps[e] + i] = T; }
    if (F.vcu == NE) { const int ntile = ps[NE] >> 8; int* tile_e = (int*)(A.ws + WS_TILEE);
        for (int t = F.tid; t < MAXTILES; t += NTHREADS) { int e = 0; for (int q = 0; q < NE; ++q) if (t * 256 >= ps[q]) e = q; tile_e[t] = (t < ntile) ? e : 0; }
        if (F.tid == 0) ((int*)(A.ws + WS_CTL))[CW_NT] = ntile; }
    __syncthreads();
}

__device__ __forceinline__ void p12_final(const Frame& F) {
    const Args& A = *F.a;
    const int gw = F.vcu * NWAVES + F.wave, NGW = F.G * NWAVES;
    const float* mod = (const float*)(A.ws + WS_MOD); const bf16* Y = (const bf16*)(A.ws + WS_Y);
    const int* pslot = (const int*)(A.ws + WS_PSLOT); const float* topp = (const float*)(A.ws + WS_TOPP);
    constexpr int NTK = 4;
    for (int tok0 = gw; tok0 < T; tok0 += NTK * NGW) {
        int tok[NTK]; i32x4 sl[NTK]; f32x4 pw[NTK];
#pragma unroll
        for (int q = 0; q < NTK; ++q) { tok[q] = tok0 + q * NGW; sl[q] = *(const i32x4*)(pslot + tok[q] * 4); pw[q] = *(const f32x4*)(topp + tok[q] * 4); }
        f32x4 x1[NTK][4], f[NTK][4];
#pragma unroll
        for (int q = 0; q < NTK; ++q) { load_row_bf16((const bf16*)(A.ws + WS_X1B) + (size_t)tok[q] * D, F.lane, x1[q]);
#pragma unroll
            for (int j = 0; j < 4; ++j) f[q][j] = (f32x4){0.f, 0.f, 0.f, 0.f};
#pragma unroll
            for (int k = 0; k < 4; ++k) { f32x4 y[4]; load_row_act<kActFp8>(Y, (size_t)sl[q][k], F.lane, y);
#pragma unroll
                for (int j = 0; j < 4; ++j) f[q][j] += y[j] * pw[q][k]; } }
#pragma unroll
        for (int q = 0; q < NTK; ++q) { const float* md = mod + (size_t)(tok[q] / SEQ) * 6144;
            const float rstd = rsqrtf(wave_sum(sumsq4(f[q])) * (1.f / D) + EPS);
#pragma unroll
            for (int j = 0; j < 4; ++j) { const int k = 4 * (F.lane + 64 * j);
                const f32x4 g = *(const f32x4*)(A.in[I_GPOSTFFN] + k), gt = *(const f32x4*)(md + 5120 + k);
                *(f32x4*)(A.out + (size_t)tok[q] * D + k) = x1[q][j] + gt * (f[q][j] * rstd * g); } }
    }
}

constexpr int NPHASES = 12;
__global__ void __launch_bounds__(NTHREADS, 2) fwd_kernel(Args args) {
    extern __shared__ __attribute__((aligned(16))) unsigned char lds_raw[];
    Frame F; F.lds = (LAS unsigned char*)lds_raw; F.tid = threadIdx.x; F.lane = F.tid & 63; F.wave = __builtin_amdgcn_readfirstlane(F.tid >> 6);
    F.G = gridDim.x; { const int bx = blockIdx.x; F.vcu = (F.G % 8 == 0) ? (bx % 8) * (F.G / 8) + bx / 8 : bx; } F.a = &args;
    volatile LAS unsigned* MISC = (volatile LAS unsigned*)(F.lds + MISC_OFF);
    for (int u = F.tid; u < (LDS_BYTES - LDSCTL_OFF) / 4; u += NTHREADS) ((LAS unsigned*)(F.lds + LDSCTL_OFF))[u] = 0u;
    __syncthreads();
    unsigned char* ws = args.ws;
    unsigned* ctl = (unsigned*)(ws + WS_CTL);
    const int lo = args.ph_lo, hi = args.ph_hi;
    XcdBarrier bar; bar.bar = ctl + CW_BAR; bar.x = 0; bar.st = nullptr;
    if (hi - lo > 1) bar = xcd_barrier_post(ctl + CW_BAR, MISC + 8);
#define IN(k) (lo <= (k) && (k) < hi)
#define SEAM(k) do { if (IN(k) && IN((k) + 1)) xcd_barrier(bar); } while (0)
    const int bx = (int)blockIdx.x;

    if (IN(0)) { p0_prologue(F); } SEAM(0);
    if (IN(1)) { p1_prenorm(F); } SEAM(1);
    if (IN(2)) {
        const int nfirst = F.vcu & 1;
#pragma nounroll
        for (int pass = 0; pass < 3; ++pass) {
            if (pass == 1) { pg8::InprojOrder S{F.G, bx, (const char*)(ws + WS_HBF), (const char*)(ws + WS_WIN), (size_t)256 * 2048, (size_t)256 * 2048};
                pg8::EpiInproj E{(bf16*)(ws + WS_Z), ws, (float*)(ws + WS_EL), args.in[I_GKB], args.in[I_HLB], 0, 0, 1.f};
                pg8::gemm_phase<pg8::EpiInproj, pg8::InprojOrder, 0, true, false>(F.lds, 2048, S, E, nullptr, nullptr, S.A, S.B); }
            else { pg8::DenseOrder S; S.init(T, NT_LO * 256, IN_KB, F.G, bx, args.out, ws + WS_WIN_LO);
                if (pass == 0) S.hi = nfirst; else S.lo = nfirst;
                pg8::EpiInproj E{(bf16*)(ws + WS_Z), ws, (float*)(ws + WS_EL), args.in[I_GKB], args.in[I_HLB], TC / 256, NT_HI, 1.f / IN_WSCALE};
                pg8::gemm_phase<pg8::EpiInproj, pg8::DenseOrder, kInFp8 ? 2 : 0, true, kInFp8, 1>(F.lds, IN_KB, S, E, nullptr, (const char*)args.out, S.A, S.B); }
        }
    } SEAM(2);
    if (IN(3)) {
        if (F.vcu < 128) scan_chain<128, true>(F, F.lds, F.vcu, F.wave, F.tid, (bf16*)args.out);
        else scan_chain<64, false>(F, F.lds, F.vcu - 128, F.wave, F.tid, (bf16*)args.out + (size_t)2 * T * 512);
    } SEAM(3);
    if (IN(4)) { p4_readout(F); } SEAM(4);
    if (IN(5)) {
        pg8::DenseOrder S; S.init(T, D, 2048, F.G, bx, ws + WS_RA, ws + WS_WUA);
        pg8::EpiMerge E{(const bf16*)(ws + WS_Z), (bf16*)args.out};
        pg8::gemm_phase<pg8::EpiMerge, pg8::DenseOrder, 0, true, false>(F.lds, 2048, S, E, nullptr, nullptr, S.A, S.B);
    } SEAM(5);
    if (IN(6)) {
        pg8::DenseOrder S; S.init(T, D, D * 2, F.G, bx, (const bf16*)args.out, ws + WS_WO);
        pg8::EpiStore<kMixFp8> E{(void*)(ws + WS_MIXB), D, 1.f};
        const bool conv_first = (F.vcu & 1) != 0;
        if (conv_first) { convert_expert_weights<0>(F); __syncthreads(); }
        pg8::gemm_phase<pg8::EpiStore<kMixFp8>, pg8::DenseOrder, 0, true, false>(F.lds, D * 2, S, E, nullptr, nullptr, S.A, S.B);
        if (!conv_first) { __syncthreads(); convert_expert_weights<0>(F); }
    } SEAM(6);
    if (IN(7)) { p8_router(F); } SEAM(7);
    if (IN(8)) { p9_slots(F); } SEAM(8);
    if (IN(9)) {
        const int ntile = __builtin_amdgcn_readfirstlane(((const int*)ctl)[CW_NT]);
        pg8::MoeOrder S{ntile, 8, F.G, bx, (const int*)(ws + WS_TILEE), (const char*)(ws + WS_WGU), (size_t)2048 * MOE_KB, (size_t)256 * MOE_KB, nullptr, nullptr, 0};
        pg8::EpiGateUp E{(bf16*)args.out, (bf16*)(ws + WS_HREST), args.in[I_BG], args.in[I_BU]};
        const bool conv_first = (F.vcu & 1) != 0;
        if (conv_first) { convert_expert_weights<1>(F); __syncthreads(); }
        pg8::gemm_phase<pg8::EpiGateUp, pg8::MoeOrder, 1, true, kMoeFp8>(F.lds, MOE_KB, S, E, (const int*)(ws + WS_TOKSLOT), (const char*)(ws + WS_H2), nullptr, S.B);
        if (!conv_first) { __syncthreads(); convert_expert_weights<1>(F); }
    } SEAM(9);
    if (IN(10)) {
        const int ntile = __builtin_amdgcn_readfirstlane(((const int*)ctl)[CW_NT]);
        pg8::MoeOrder S{ntile, 4, F.G, bx, (const int*)(ws + WS_TILEE), (const char*)(ws + WS_WD), (size_t)D * MOE_KB, (size_t)256 * MOE_KB, (const char*)args.out, (const char*)(ws + WS_HREST), (size_t)256 * MOE_KB};
        pg8::EpiDown E{(bf16*)(ws + WS_Y), args.in[I_BDN]};
        static_assert(kMoeFp8, "MoE operands are fp8");
        pg8::gemm_phase<pg8::EpiDown, pg8::MoeOrder, 2, true, true, 1>(F.lds, MOE_KB, S, E, nullptr, (const char*)(ws + WS_HREST), nullptr, S.B);
    } SEAM(10);
    if (IN(11)) { p12_final(F); }
#undef IN
#undef SEAM
}

extern "C" void kernel_launch(void* const* d_in, const int* in_sizes, int n_in, void* d_out, int out_size, void* d_ws, size_t ws_size, hipStream_t stream) {
    static int grid = 0;
    if (grid == 0) {
        if (n_in != 27 || out_size != T * D || ws_size < WS_END) { fprintf(stderr, "kernel_launch: unexpected shapes: n_in %d out %d ws %zu (need %zu)\n", n_in, out_size, ws_size, (size_t)WS_END); grid = -1; return; }
        int dev = 0, cus = 0, per_cu = 0;
        if (hipGetDevice(&dev) != hipSuccess || hipDeviceGetAttribute(&cus, hipDeviceAttributeMultiprocessorCount, dev) != hipSuccess) { grid = -1; return; }
        if (hipFuncSetAttribute((const void*)fwd_kernel, hipFuncAttributeMaxDynamicSharedMemorySize, LDS_BYTES) != hipSuccess) { fprintf(stderr, "kernel_launch: hipFuncSetAttribute failed\n"); grid = -1; return; }
        if (hipOccupancyMaxActiveBlocksPerMultiprocessor(&per_cu, (const void*)fwd_kernel, NTHREADS, LDS_BYTES) != hipSuccess || per_cu < 1) { fprintf(stderr, "kernel_launch: occupancy query says %d blocks per CU\n", per_cu); (void)hipGetLastError(); grid = -1; return; }
        grid = cus;
        if (grid > 256) grid = 256;
        if (grid % 8 != 0) grid -= grid % 8;
    }
    if (grid < 0) return;
    (void)hipMemsetAsync((char*)d_ws + WS_CTL, 0, CTL_ZERO_BYTES, stream);
    Args a{};
    for (int i = 0; i < 27; ++i) a.in[i] = (const float*)d_in[i];
    a.out = (float*)d_out; a.ws = (unsigned char*)d_ws;
    if (REPEAT_PHASE >= 0) {
        a.ph_lo = 0; a.ph_hi = REPEAT_PHASE + 1; hipLaunchKernelGGL(fwd_kernel, dim3(grid), dim3(NTHREADS), LDS_BYTES, stream, a);
        (void)hipMemsetAsync((char*)d_ws + WS_CTL + CW_BAR * 4, 0, XCD_BAR_WORDS * 4, stream);
        if (REPEAT_PHASE == 7) (void)hipMemsetAsync((char*)d_ws + WS_CTL + CW_GCOUNT * 4, 0, 256, stream);
        a.ph_lo = REPEAT_PHASE; a.ph_hi = NPHASES; hipLaunchKernelGGL(fwd_kernel, dim3(grid), dim3(NTHREADS), LDS_BYTES, stream, a); }
    else if (MK_N_LAUNCHES == 1) { a.ph_lo = 0; a.ph_hi = NPHASES; hipLaunchKernelGGL(fwd_kernel, dim3(grid), dim3(NTHREADS), LDS_BYTES, stream, a); }
    else for (int p = 0; p < NPHASES; ++p) { a.ph_lo = p; a.ph_hi = p + 1; hipLaunchKernelGGL(fwd_kernel, dim3(grid), dim3(NTHREADS), LDS_BYTES, stream, a); }
}
```

```cpp
#include <hip/hip_runtime.h>
#include <cstdio>
#include <cstdint>

#ifndef MK_N_LAUNCHES
#define MK_N_LAUNCHES 1
#endif

#ifndef REPEAT_PHASE
#define REPEAT_PHASE -1
#endif
#ifndef MOE_FP8
#define MOE_FP8 1
#endif
#ifndef INPROJ_FP8
#define INPROJ_FP8 1
#endif
#ifndef ACT_FP8
#define ACT_FP8 1
#endif
#ifndef USE_NAIVE_SCAN
#define USE_NAIVE_SCAN 0
#endif
#define LAS __attribute__((address_space(3)))
typedef unsigned short bf16;
typedef short bf16x8 __attribute__((ext_vector_type(8)));
typedef float f32x4 __attribute__((ext_vector_type(4)));
typedef float f32x2 __attribute__((ext_vector_type(2)));
typedef unsigned u32x4 __attribute__((ext_vector_type(4)));
typedef unsigned u32x2 __attribute__((ext_vector_type(2)));
typedef int i32x4 __attribute__((ext_vector_type(4)));
typedef int i32x8 __attribute__((ext_vector_type(8)));

constexpr int D = 1024, NB = 16, SEQ = 2048, CTX = 256;
constexpr int T = NB * SEQ, TC = NB * CTX, MALL = T + TC;
constexpr int NZ = 3072;
constexpr int ZC_OGA = 0, ZC_OGB = 512, ZC_MGA = 1024, ZC_MGB = 2048;
constexpr int NSTEP = 36;
constexpr int NT_HI = 14, NT_LO = 12;
constexpr int IN_DIM = 6176;
constexpr int NE = 32, TOPK = 4, FF = 1024;
constexpr int MAXSLOT = T * TOPK + NE * 256, MAXTILES = MAXSLOT / 256;
constexpr float EPS = 1e-6f;
constexpr int NWAVES = 8, NTHREADS = 512;

constexpr size_t MiB = 1u << 20;
constexpr size_t WS_CTL = 0, CTL_ZERO_BYTES = 1 * MiB;
constexpr size_t WS_MOD = 1 * MiB;
constexpr size_t WS_WRT = 1 * MiB + 512 * 1024;
constexpr size_t WS_WIN = 2 * MiB;
constexpr size_t WS_WUA = 15 * MiB, WS_WUB = 16 * MiB, WS_WO = 17 * MiB;
constexpr size_t WS_TOPI = 19 * MiB, WS_TOPP = WS_TOPI + 512 * 1024, WS_LRANK = 20 * MiB, WS_PSLOT = WS_LRANK + 512 * 1024, WS_BLKBASE = 21 * MiB, WS_TOKSLOT = 21 * MiB + 256 * 1024, WS_TILEE = 22 * MiB;
constexpr size_t WS_HBF = 24 * MiB;
constexpr size_t WS_RA = 24 * MiB, WS_RB = 56 * MiB;
constexpr size_t WS_H2 = 24 * MiB;
constexpr size_t WS_Z = 96 * MiB;
constexpr size_t WS_RQA = 288 * MiB;
constexpr size_t WS_RQB = 432 * MiB;
constexpr size_t WS_RVA = 504 * MiB;
constexpr size_t WS_RVB = 540 * MiB;
constexpr size_t WS_EL = 576 * MiB;
constexpr int NCG = MALL / 64;
constexpr size_t WS_WGU = 89 * MiB;
constexpr size_t WS_Y = 24 * MiB;
constexpr size_t WS_X1B = 160 * MiB;
constexpr size_t WS_MIXB = 296 * MiB;
constexpr size_t WS_WD = 360 * MiB;
constexpr size_t WS_HREST = (MOE_FP8 ? 392 : 424) * MiB;
constexpr size_t WS_END = 580 * MiB;
constexpr bool kInFp8 = (INPROJ_FP8 != 0);
constexpr int IN_KB = kInFp8 ? 1024 : 2048;
constexpr float IN_WSCALE = kInFp8 ? 32.f : 1.f;
constexpr size_t WS_WIN_LO = 12 * MiB;
constexpr bool kActFp8 = (ACT_FP8 != 0);
constexpr bool kMixFp8 = false;
constexpr bool kMoeFp8 = (MOE_FP8 != 0);
constexpr int MOE_KB = kMoeFp8 ? 1024 : 2048;
constexpr float MOE_WSCALE = kMoeFp8 ? 32.f : 1.f;
constexpr int H_SPLIT_TILES = kMoeFp8 ? 0 : 256;
constexpr int CW_BAR = 4096, CW_GCOUNT = 16384, CW_NT = 16384 + 64;

#define RLX_AGENT __ATOMIC_RELAXED, __HIP_MEMORY_SCOPE_AGENT
#define LDS_WAIT() asm volatile("s_waitcnt lgkmcnt(0)" ::: "memory")
#define VM_WAIT() asm volatile("s_waitcnt vmcnt(0)" ::: "memory")
__device__ __forceinline__ unsigned f2bf(float f) { unsigned u = __builtin_bit_cast(unsigned, f); return (u + 0x7fffu + ((u >> 16) & 1u)) >> 16; }
__device__ __forceinline__ unsigned pk2(float lo, float hi) { return f2bf(lo) | (f2bf(hi) << 16); }
__device__ __forceinline__ unsigned pk4_fp8(float a, float b, float c, float d) { int w = 0; w = __builtin_amdgcn_cvt_pk_fp8_f32(a, b, w, false); w = __builtin_amdgcn_cvt_pk_fp8_f32(c, d, w, true); return (unsigned)w; }
__device__ __forceinline__ float bf2f(unsigned short b) { return __builtin_bit_cast(float, ((unsigned)b) << 16); }
__device__ __forceinline__ float bflo(unsigned w) { return __builtin_bit_cast(float, w << 16); }
__device__ __forceinline__ float bfhi(unsigned w) { return __builtin_bit_cast(float, w & 0xffff0000u); }
__device__ __forceinline__ float sigmoidf_(float x) { return __builtin_amdgcn_rcpf(1.0f + __expf(-x)); }
template <int CTRL> __device__ __forceinline__ float dpp_mov(float v, float old) { return __builtin_bit_cast(float, __builtin_amdgcn_update_dpp(__builtin_bit_cast(int, old), __builtin_bit_cast(int, v), CTRL, 0xf, 0xf, false)); }
__device__ __forceinline__ float rdlane(float v, int l) { return __builtin_bit_cast(float, __builtin_amdgcn_readlane(__builtin_bit_cast(int, v), l)); }
__device__ __forceinline__ float wave_sum(float v) {
    v += dpp_mov<0x111>(v, 0.f); v += dpp_mov<0x112>(v, 0.f); v += dpp_mov<0x114>(v, 0.f); v += dpp_mov<0x118>(v, 0.f);
    return (rdlane(v, 15) + rdlane(v, 31)) + (rdlane(v, 47) + rdlane(v, 63));
}
__device__ __forceinline__ float wave_max(float v) {
    const float ninf = -INFINITY;
    v = fmaxf(v, dpp_mov<0x111>(v, ninf)); v = fmaxf(v, dpp_mov<0x112>(v, ninf)); v = fmaxf(v, dpp_mov<0x114>(v, ninf)); v = fmaxf(v, dpp_mov<0x118>(v, ninf));
    return fmaxf(fmaxf(rdlane(v, 15), rdlane(v, 31)), fmaxf(rdlane(v, 47), rdlane(v, 63)));
}

__device__ __forceinline__ int qperm(int d) { return (d & ~31) | (((d >> 2) & 3) << 3) | (((d >> 4) & 1) << 2) | (d & 3); }
namespace pg8 {
constexpr int BM = 256, BK = 64, HALF = 128, HTB = HALF * BK * 2, STAGE_BYTES = 8 * HTB;
__device__ __forceinline__ int lds_byte(int r, int c) { const int st = (r >> 4) * 2 + (c >> 5), rr = r & 15, cc = c & 31, ob = rr * 64 + cc * 2; return st * 1024 + (ob ^ (((ob >> 9) & 1) << 5)); }
__device__ __forceinline__ void stage_rc(int b, int& R, int& C) { const int st = b / 1024, sb = b % 1024, swz = sb ^ (((sb >> 9) & 1) << 5); R = (st >> 1) * 16 + swz / 64; C = (st & 1) * 32 + (swz % 64) / 2; }
__device__ __forceinline__ int perm32(int rho) { const int n = rho >> 4, i = rho & 15; return 8 * (i >> 2) + 4 * n + (i & 3); }
__device__ __forceinline__ unsigned cvt_pk_bf16(float lo, float hi) { unsigned r; asm volatile("v_cvt_pk_bf16_f32 %0, %1, %2" : "=v"(r) : "v"(lo), "v"(hi)); return r; }

struct Unit { int pm, pn, e; unsigned a, b; };

template <class E, class = void> struct EpiHasPre { static constexpr bool value = false; };
template <class E> struct EpiHasPre<E, decltype((void)E::PRE)> { static constexpr bool value = E::PRE; };
__device__ __forceinline__ void glds4(const void* g, LAS void* l) { __builtin_amdgcn_global_load_lds((const unsigned*)g, (LAS unsigned*)l, 4, 0, 0); }
template <class E, class = void> struct EpiHasMid { static constexpr bool value = false; };
template <class E> struct EpiHasMid<E, decltype((void)E::MID)> { static constexpr bool value = E::MID; };
template <class Epi, class Sched, int GATHER, bool ALIGN_EPI, bool FP8, int BPERM = 0>
__device__ __forceinline__ void gemm_phase(LAS unsigned char* lds, const int KB, const Sched& S, const Epi& E, const int* __restrict__ rowidx, const char* gatherA, const void* Abase, const void* Bbase) {
    const int tid = threadIdx.x, wid = __builtin_amdgcn_readfirstlane(tid >> 6), lane = tid & 63, wr = wid >> 2, wc = wid & 3, fr = lane & 15, fq = lane >> 4;
    const int nt = KB / (BK * 2);
    unsigned vA[2][2], voffB[2]; int Rr[2], Cc[2];
#pragma unroll
    for (int i = 0; i < 2; ++i) { int R, C; stage_rc(tid * 16 + i * 8192, R, C); Rr[i] = R; Cc[i] = C; const int Rb = (R & ~31) + perm32(R & 31);
        const int Rp = (R >> 5) * 64 + ((R >> 2) & 3) * 16 + ((R >> 4) & 1) * 4 + (R & 3);
        voffB[i] = (unsigned)((BPERM ? Rp : Rb) * KB + 2 * C); vA[0][i] = (unsigned)(R * KB + 2 * C); vA[1][i] = (unsigned)((R + HALF) * KB + 2 * C); }
    const unsigned kstep = (unsigned)(BK * 2);
    const unsigned hstep = (unsigned)(HALF * KB);
    const unsigned hstepB = BPERM ? (unsigned)(8 * KB) : hstep;
    const unsigned ldsw = (unsigned)wid * 1024u;
    const int aoff = lds_byte(wr * 64 + fr, FP8 ? fq * 16 : fq * 8), boff = lds_byte(wc * 32 + fr, FP8 ? fq * 16 : fq * 8);
    constexpr int KSTR = FP8 ? 16 : 1024;
#define PG8_SA(b, h) (((b) * 2 + (h)) * HTB)
#define PG8_SB(b, h) ((4 + (b) * 2 + (h)) * HTB)
#define PG8_STAGE(bufoff, rsrc, soff, voff) do { _Pragma("unroll") for (int _i = 0; _i < 2; ++_i) \
        __builtin_amdgcn_raw_ptr_buffer_load_lds(rsrc, (LAS void*)(lds + (bufoff) + ldsw + _i * 8192), 16, (int)(voff)[_i], (int)(soff), 0, 0); } while (0)
#define PG8_LDA(dst, b, h) do { _Pragma("unroll") for (int m = 0; m < 4; ++m) _Pragma("unroll") for (int k = 0; k < 2; ++k) dst[m][k] = *(const LAS i32x4*)(lds + PG8_SA(b, h) + aoff + m * 2048 + k * KSTR); } while (0)
#define PG8_LDB(dst, b, h) do { _Pragma("unroll") for (int n = 0; n < 2; ++n) _Pragma("unroll") for (int k = 0; k < 2; ++k) dst[n][k] = *(const LAS i32x4*)(lds + PG8_SB(b, h) + boff + n * 2048 + k * KSTR); } while (0)
#define PG8_V8(x) __builtin_shufflevector((x)[0], (x)[1], 0, 1, 2, 3, 4, 5, 6, 7)
#define PG8_MMA(ai, bj, At, Bt) do { __builtin_amdgcn_s_setprio(3); _Pragma("unroll") for (int m = 0; m < 4; ++m) _Pragma("unroll") for (int n = 0; n < 2; ++n) { \
        if constexpr (FP8) acc[ai][bj][m][n] = __builtin_amdgcn_mfma_scale_f32_16x16x128_f8f6f4(PG8_V8(Bt[n]), PG8_V8(At[m]), acc[ai][bj][m][n], 0, 0, 0, 0x7f7f7f7f, 0, 0x7f7f7f7f); \
        else { _Pragma("unroll") for (int k = 0; k < 2; ++k) acc[ai][bj][m][n] = __builtin_amdgcn_mfma_f32_16x16x32_bf16(__builtin_bit_cast(bf16x8, Bt[n][k]), __builtin_bit_cast(bf16x8, At[m][k]), acc[ai][bj][m][n], 0, 0, 0); } } \
        __builtin_amdgcn_s_setprio(0); } while (0)
#define PG8_WAIT_V(n) asm volatile("s_waitcnt vmcnt(" #n ")" ::: "memory")
#define PG8_WAIT_VN(pe) do { if constexpr (Epi::NSTORES >= 16) asm volatile("s_cmp_lg_u32 %0, 0\n\ts_cbranch_scc1 1f\n\ts_waitcnt vmcnt(8)\n1:\n\ts_waitcnt vmcnt(24)" :: "s"(__builtin_amdgcn_readfirstlane((int)(pe))) : "memory", "scc"); \
        else if constexpr (Epi::NSTORES >= 8) asm volatile("s_cmp_lg_u32 %0, 0\n\ts_cbranch_scc1 1f\n\ts_waitcnt vmcnt(8)\n1:\n\ts_waitcnt vmcnt(16)" :: "s"(__builtin_amdgcn_readfirstlane((int)(pe))) : "memory", "scc"); \
        else asm volatile("s_waitcnt vmcnt(8)" ::: "memory"); } while (0)
#define PG8_WAIT_L(n) asm volatile("s_waitcnt lgkmcnt(" #n ")" ::: "memory")
#define PG8_BAR __builtin_amdgcn_s_barrier()
#define PG8_SCHED __builtin_amdgcn_sched_barrier(0)
#define PG8_GATHER_OFFS(dst, unit) do { _Pragma("unroll") for (int _h = 0; _h < 2; ++_h) _Pragma("unroll") for (int _i = 0; _i < 2; ++_i) \
        dst[_h][_i] = (unsigned)((GATHER == 1 ? rowidx[(unit).pm * BM + _h * HALF + Rr[_i]] : (unit).pm * BM + _h * HALF + Rr[_i]) * KB + 2 * Cc[_i]); } while (0)
#define PG8_GATHER_OFFS_LDS(dst, unit) do { _Pragma("unroll") for (int _h = 0; _h < 2; ++_h) _Pragma("unroll") for (int _i = 0; _i < 2; ++_i) \
        dst[_h][_i] = (unsigned)((GATHER == 1 ? IDX[_h * HALF + Rr[_i]] : (unit).pm * BM + _h * HALF + Rr[_i]) * KB + 2 * Cc[_i]); } while (0)
    LAS int* const IDX = (LAS int*)(lds + STAGE_BYTES + 1024);
    LAS float* const EC = (LAS float*)(lds + STAGE_BYTES + 2048) + wid * 64;
    Unit cur, nxt; int ui = 0;
    if (!S.next(0, cur)) return;
    f32x4 acc[2][2][4][2];
#pragma unroll
    for (int a = 0; a < 2; ++a)
#pragma unroll
        for (int b = 0; b < 2; ++b)
#pragma unroll
            for (int m = 0; m < 4; ++m)
#pragma unroll
                for (int n = 0; n < 2; ++n) acc[a][b][m][n] = (f32x4){0.f, 0.f, 0.f, 0.f};
    i32x4 At[4][2], B0[2][2], B1[2][2];
    const __amdgpu_buffer_rsrc_t rA = __builtin_amdgcn_make_buffer_rsrc((void*)(GATHER ? gatherA : Abase), 0, 0x7fffffff, 0x00020000);
    const __amdgpu_buffer_rsrc_t rB = __builtin_amdgcn_make_buffer_rsrc((void*)Bbase, 0, 0x7fffffff, 0x00020000);
    unsigned cA = GATHER ? 0u : cur.a, cB = cur.b;
    if constexpr (GATHER) { PG8_GATHER_OFFS(vA, cur); }
    if constexpr (EpiHasPre<Epi>::value) E.pre(cur, EC, wc, lane);
    PG8_STAGE(PG8_SB(0, 0), rB, cB, voffB); PG8_STAGE(PG8_SB(0, 1), rB, cB + hstepB, voffB); PG8_STAGE(PG8_SA(0, 0), rA, cA, vA[0]); PG8_STAGE(PG8_SA(0, 1), rA, cA, vA[1]);
    if (wr == 1) PG8_BAR;
    PG8_WAIT_V(2); PG8_BAR;
    PG8_STAGE(PG8_SB(1, 0), rB, cB + kstep, voffB); PG8_STAGE(PG8_SA(1, 0), rA, cA + kstep, vA[0]); PG8_STAGE(PG8_SB(1, 1), rB, cB + hstepB + kstep, voffB);
    PG8_WAIT_V(6); PG8_BAR;
    for (;;) {
        const bool has_next = S.next(ui + 1, nxt);
        const unsigned nA = GATHER ? 0u : (has_next ? nxt.a : cA), nB = has_next ? nxt.b : cB;
        if constexpr (GATHER == 1) { if (has_next && wid < 4) glds4(rowidx + nxt.pm * BM + 64 * wid + lane, IDX + 64 * wid); }
#pragma nounroll
        for (int t = 0; t < nt; t += 2) {
            const bool last = (t == nt - 2);
            const unsigned a1 = cA + (unsigned)(t + 1) * kstep;
            const unsigned a2 = last ? nA : cA + (unsigned)(t + 2) * kstep, b2 = last ? nB : cB + (unsigned)(t + 2) * kstep;
            const unsigned a3 = a2 + kstep, b3 = b2 + kstep;
            if constexpr (EpiHasMid<Epi>::value) { if (t == nt / 2) E.mid(acc, cur, wr, wc, fr, fq); }
            unsigned vN[2][2];
            if constexpr (GATHER) { if (last && has_next) { PG8_GATHER_OFFS_LDS(vN, nxt); } }
            const bool post_epi = (t == 0) && (ui > 0);
            PG8_LDB(B0, 0, 0); PG8_LDB(B1, 0, 1); PG8_SCHED; PG8_LDA(At, 0, 0); PG8_STAGE(PG8_SA(1, 1), rA, a1, vA[1]);
            if constexpr (GATHER) { if (last && has_next) {
#pragma unroll
                for (int _h = 0; _h < 2; ++_h)
#pragma unroll
                    for (int _i = 0; _i < 2; ++_i) vA[_h][_i] = vN[_h][_i]; } }
            PG8_WAIT_VN(post_epi);
            PG8_WAIT_L(0); PG8_BAR; PG8_MMA(0, 0, At, B0); PG8_MMA(0, 1, At, B1); PG8_BAR; PG8_SCHED;
            PG8_LDA(At, 0, 1); PG8_STAGE(PG8_SB(0, 0), rB, b2, voffB); PG8_STAGE(PG8_SB(0, 1), rB, b2 + hstepB, voffB); PG8_STAGE(PG8_SA(0, 0), rA, a2, vA[0]);
            PG8_WAIT_VN(post_epi);
            PG8_WAIT_L(0); PG8_BAR; PG8_MMA(1, 0, At, B0); PG8_MMA(1, 1, At, B1); PG8_BAR; PG8_SCHED;
            PG8_LDB(B0, 1, 0); PG8_LDB(B1, 1, 1); PG8_SCHED; PG8_LDA(At, 1, 0); PG8_STAGE(PG8_SA(0, 1), rA, a2, vA[1]);
            PG8_WAIT_V(8); PG8_WAIT_L(0); PG8_BAR; PG8_MMA(0, 0, At, B0); PG8_MMA(0, 1, At, B1); PG8_BAR; PG8_SCHED;
            PG8_LDA(At, 1, 1); PG8_STAGE(PG8_SB(1, 0), rB, b3, voffB); PG8_STAGE(PG8_SB(1, 1), rB, b3 + hstepB, voffB); PG8_STAGE(PG8_SA(1, 0), rA, a3, vA[0]);
            PG8_WAIT_V(8); PG8_WAIT_L(0); PG8_BAR; PG8_MMA(1, 0, At, B0); PG8_MMA(1, 1, At, B1); PG8_BAR; PG8_SCHED;
        }
        if constexpr (ALIGN_EPI) { if (wr == 0) PG8_BAR; }
        if constexpr (EpiHasPre<Epi>::value) E(acc, cur, wr, wc, fr, fq, EC); else E(acc, cur, wr, wc, fr, fq);
        if (!has_next) break;
#pragma unroll
        for (int a = 0; a < 2; ++a)
#pragma unroll
            for (int b = 0; b < 2; ++b)
#pragma unroll
                for (int m = 0; m < 4; ++m)
#pragma unroll
                    for (int n = 0; n < 2; ++n) acc[a][b][m][n] = (f32x4){0.f, 0.f, 0.f, 0.f};
        cur = nxt; cA = nA; cB = nB; ++ui;
        if constexpr (EpiHasPre<Epi>::value) E.pre(cur, EC, wc, lane);
        if constexpr (ALIGN_EPI) { if (wr == 1) PG8_BAR; }
    }
    PG8_WAIT_V(0);
    if constexpr (!ALIGN_EPI) { if (wr == 0) PG8_BAR; }
    PG8_BAR;
#undef PG8_SA
#undef PG8_SB
#undef PG8_STAGE
#undef PG8_LDA
#undef PG8_LDB
#undef PG8_MMA
#undef PG8_V8
#undef PG8_WAIT_V
#undef PG8_WAIT_VN
#undef PG8_WAIT_L
#undef PG8_BAR
#undef PG8_SCHED
#undef PG8_GATHER_OFFS
#undef PG8_GATHER_OFFS_LDS
}

struct DenseOrder {
    int nM, nN, nwg, G, c, lo, hi; const char* A; const char* B; size_t tA, tB;
    __device__ void init(int M, int N, int KB, int G_, int c_, const void* A_, const void* B_) { nM = M / BM; nN = N / BM; nwg = nM * nN; G = G_; c = c_; lo = 0; hi = 1 << 20; A = (const char*)A_; B = (const char*)B_; tA = (size_t)BM * KB; tB = tA; }
    __device__ bool next(int i, Unit& u) const {
        if (i + lo >= hi) return false;
        const long L = (long)(i + lo) * G + c; if (L >= nwg) return false;
        int wgid = (int)L; { const int q = nwg / 8, r = nwg % 8, xcd = wgid % 8, off = wgid / 8; wgid = (xcd < r ? xcd * (q + 1) : r * (q + 1) + (xcd - r) * q) + off; }
        const int nig = 8 * nN, gid = wgid / nig, fm = gid * 8, gsz = (nM - fm) < 8 ? (nM - fm) : 8;
        u.pm = fm + ((wgid % nig) % gsz); u.pn = (wgid % nig) / gsz; u.e = 0; u.a = (unsigned)((size_t)u.pm * tA); u.b = (unsigned)((size_t)u.pn * tB); return true;
    }
};
struct InprojOrder {
    int G, c; const char* A; const char* B; size_t tA, tB;
    __device__ bool next(int i, Unit& u) const {
        const int L = i * G + c; constexpr int NLAT = 128 * NT_HI, NCTX = 16 * 14;
        if (L < NLAT) { const int xcd = L % 8, off = L / 8; const int wgid = xcd * (NLAT / 8) + off; constexpr int nig = 8 * NT_HI; const int gid = wgid / nig;
            u.pm = 16 + gid * 8 + ((wgid % nig) % 8); u.pn = (wgid % nig) / 8; }
        else if (L < NLAT + NCTX) { const int idx = L - NLAT; u.pm = idx / 14; u.pn = idx % 14; }
        else return false;
        u.e = 0; u.a = (unsigned)((size_t)u.pm * tA); u.b = (unsigned)((size_t)u.pn * tB); return true;
    }
};
struct MoeOrder {
    int nt, NPN, G, c; const int* tile_e; const char* B; size_t eB, tB; const char* A0; const char* A1; size_t tA;
    __device__ bool next(int i, Unit& u) const {
        const int nx = (G % 8 == 0) ? 8 : 1, per = G / nx, x = c % nx, j = c / nx;
        const int q = (nt + nx - 1) / nx, s = i * per + j, grp = 4 * NPN;
        const int rl = (s / grp) * 4 + (s & 3), pn = (s % grp) >> 2;
        if (rl >= q) return false;
        const int rt = x * q + rl; if (rt >= nt) return false;
        const int e = __builtin_amdgcn_readfirstlane(tile_e[rt]);
        u.pm = rt; u.pn = pn; u.e = e; u.b = (unsigned)((size_t)e * eB + (size_t)pn * tB); u.a = 0u; return true;
    }
};

#define EPI_LOOP_BEGIN \
    int rb_ = wr * 64 + fr; asm volatile("" : "+v"(rb_));     \
    _Pragma("unroll") for (int ai = 0; ai < 2; ++ai) _Pragma("unroll") for (int m = 0; m < 4; ++m) { const int row = u.pm * BM + ai * HALF + m * 16 + rb_; \
    _Pragma("unroll") for (int bj = 0; bj < 2; ++bj) { const int col = u.pn * BM + bj * HALF + wc * 32 + 8 * fq; f32x4 v0 = acc[ai][bj][m][0], v1 = acc[ai][bj][m][1];
#define EPI_LOOP_END } }
__device__ __forceinline__ u32x4 pack8(f32x4 v0, f32x4 v1) { u32x4 w; w.x = cvt_pk_bf16(v0[0], v0[1]); w.y = cvt_pk_bf16(v0[2], v0[3]); w.z = cvt_pk_bf16(v1[0], v1[1]); w.w = cvt_pk_bf16(v1[2], v1[3]); return w; }
__device__ __forceinline__ void unpack8(u32x4 w, f32x4& a, f32x4& b) { a = (f32x4){bflo(w.x), bfhi(w.x), bflo(w.y), bfhi(w.y)}; b = (f32x4){bflo(w.z), bfhi(w.z), bflo(w.w), bfhi(w.w)}; }

__device__ __forceinline__ float logsigmoidf_(float x) { return fminf(x, 0.f) - __logf(1.f + __expf(-fabsf(x))); }
__device__ __forceinline__ u32x2 pack4(f32x4 v) { u32x2 w; w.x = cvt_pk_bf16(v[0], v[1]); w.y = cvt_pk_bf16(v[2], v[3]); return w; }
struct EpiInproj {
    static constexpr bool PRE = true; static constexpr int NSTORES = 8;
    bf16* Z; unsigned char* WS; float* EL; const float* gkb; const float* hlb; int rowoff_tiles, tileoff; float scale;
    __device__ __forceinline__ void pre(const Unit& uu, LAS float* ec, int wc, int lane) const {
        const int t = uu.pn + tileoff, c = lane & 15, sd = lane >> 4;
        if (t < 8) glds4(hlb + (sd >> 1) * 1024 + (sd & 1) * 512 + (t >> 1) * 128 + (t & 1) * 64 + 16 * wc + c, ec);
        else if (t < 12) glds4(gkb + (sd & 1) * 256 + (t - 8) * 64 + 16 * wc + c, ec);
    }
    __device__ __forceinline__ void operator()(const f32x4 (&acc)[2][2][4][2], const Unit& uu, int wr, int wc, int fr, int fq, const LAS float* ec) const {
        const int pm = uu.pm + rowoff_tiles, t = uu.pn + tileoff;
        int fr_ = fr; asm volatile("" : "+v"(fr_));
        if (t < 14) {
#pragma unroll
            for (int ai = 0; ai < 2; ++ai) {
                const int cg = 4 * pm + 2 * ai + wr;
                const bool ctx = cg < TC / 64; const int b = ctx ? cg >> 2 : (cg - TC / 64) >> 5, mc = ctx ? cg & 3 : (cg - TC / 64) & 31, smem = ctx ? mc : 4 + mc;
                if (t < 12) {
                    const bool hg = t < 8; const int h = hg ? t >> 1 : t - 8, cc0 = 16 * wc + 4 * fq, chh = hg ? (t & 1) * 64 + cc0 : cc0, ch = (hg ? h * 128 : h * 64) + chh;
                    f32x4 c0[2];
#pragma unroll
                    for (int d = 0; d < 2; ++d) { if (hg) { const f32x4 a0 = *(const LAS f32x4*)(ec + 16 * d + 4 * fq), a1 = *(const LAS f32x4*)(ec + 32 + 16 * d + 4 * fq);
#pragma unroll
                            for (int j = 0; j < 4; ++j) c0[d][j] = __builtin_amdgcn_rcpf(1.f + __expf(a1[j] - a0[j])); }
                        else c0[d] = *(const LAS f32x4*)(ec + 16 * d + 4 * fq) * 1.44269504f; }
                    const int tsz = hg ? 16384 : 8192, wbase = ((hg ? (t & 1) * 4 : 0) + wc) * 2048 + 8 * (fq & 2) + 512 * (fq & 1);
                    unsigned char* const qkb = WS + (hg ? WS_RQA : WS_RQB);
#pragma unroll
                    for (int d = 0; d < 2; ++d) {
                        const int sd = d ? (ctx ? 3 - mc : 35 - mc) : smem, chain = (b * 4 + h) * 2 + d;
                        unsigned char* const tq = qkb + (size_t)((chain * NSTEP + sd) * 2) * tsz; unsigned char* const tk = tq + tsz;
                        const float id = hg ? 1.f : 0.f; f32x4 run = (f32x4){id, id, id, id};
                        u32x2 wq0 = (u32x2){0u, 0u}, wk0 = wq0;
#pragma unroll
                        for (int mm = 0; mm < 4; ++mm) { const int m = d ? 3 - mm : mm; f32x4 ky, e, ie;
                            if (hg) { const f32x4 z = acc[ai][d][m][1 - d] * (scale * -1.44269504f);
#pragma unroll
                                for (int j = 0; j < 4; ++j) { const float lb = c0[d][j], oml = 1.f - lb, s = __builtin_amdgcn_rcpf(1.f + __builtin_amdgcn_exp2f(z[j]));
                                    float v = __builtin_fmaf(oml, s, lb), tt = v; ky[j] = __builtin_fmaf(-oml, s, oml);
                                    if (d == 0) { v *= dpp_mov<0x111>(v, 1.f); v *= dpp_mov<0x112>(v, 1.f); v *= dpp_mov<0x114>(v, 1.f); v *= dpp_mov<0x118>(v, 1.f); }
                                    else        { v *= dpp_mov<0x101>(v, 1.f); v *= dpp_mov<0x102>(v, 1.f); v *= dpp_mov<0x104>(v, 1.f); v *= dpp_mov<0x108>(v, 1.f); }
                                    tt *= dpp_mov<0x128>(tt, 1.f); tt *= dpp_mov<0x124>(tt, 1.f); tt *= dpp_mov<0x122>(tt, 1.f); tt *= dpp_mov<0x121>(tt, 1.f);
                                    const float cm = run[j] * v; run[j] *= tt; e[j] = cm; ie[j] = __builtin_amdgcn_rcpf(cm); } }
                            else { const f32x4 x = acc[ai][1][m][d] * (scale * 1.44269504f); ky = acc[ai][0][m][1] * scale;
#pragma unroll
                                for (int j = 0; j < 4; ++j) { const float y2 = x[j] + c0[d][j];
                                    float v = (fminf(y2, 0.f) - __builtin_amdgcn_logf(1.f + __builtin_amdgcn_exp2f(-fabsf(y2)))) * 0.0625f, tt = v;
                                    if (d == 0) { v += dpp_mov<0x111>(v, 0.f); v += dpp_mov<0x112>(v, 0.f); v += dpp_mov<0x114>(v, 0.f); v += dpp_mov<0x118>(v, 0.f); }
                                    else        { v += dpp_mov<0x101>(v, 0.f); v += dpp_mov<0x102>(v, 0.f); v += dpp_mov<0x104>(v, 0.f); v += dpp_mov<0x108>(v, 0.f); }
                                    tt += dpp_mov<0x128>(tt, 0.f); tt += dpp_mov<0x124>(tt, 0.f); tt += dpp_mov<0x122>(tt, 0.f); tt += dpp_mov<0x121>(tt, 0.f);
                                    const float cm = run[j] + v; run[j] += tt; e[j] = __builtin_amdgcn_exp2f(cm); ie[j] = __builtin_amdgcn_exp2f(-cm); } }
                            u32x2 wq = (u32x2){0u, 0u}; const u32x2 wk = pack4(ky * ie);
                            if (!ctx) wq = pack4(acc[ai][0][m][0] * (hg ? scale : scale * 0.125f) * e);
                            if ((mm & 1) == 0) { wq0 = wq; wk0 = wk; }
                            else { const int roff = (16 * (mm - 1) + (d ? 15 - fr_ : fr_)) * 32;
                                if (!ctx) { const auto sx = __builtin_amdgcn_permlane16_swap(wq0.x, wq.x, false, false), sy = __builtin_amdgcn_permlane16_swap(wq0.y, wq.y, false, false);
                                    *(u32x4*)(tq + wbase + roff) = (u32x4){sx[0], sy[0], sx[1], sy[1]}; }
                                const auto sx = __builtin_amdgcn_permlane16_swap(wk0.x, wk.x, false, false), sy = __builtin_amdgcn_permlane16_swap(wk0.y, wk.y, false, false);
                                *(u32x4*)(tk + wbase + roff) = (u32x4){sx[0], sy[0], sx[1], sy[1]}; } }
                        if (fr == 0) { f32x4 el;
#pragma unroll
                            for (int j = 0; j < 4; ++j) el[j] = hg ? run[j] : __builtin_amdgcn_exp2f(run[j]);
                            *(f32x4*)(EL + ((size_t)d * NCG + cg) * 768 + (hg ? 0 : 512) + ch) = el; }
                    }
                    if (hg) { unsigned char* const tv = WS + WS_RVA + (size_t)((b * 4 + h) * NSTEP + smem) * 16384;
#pragma unroll
                        for (int m = 0; m < 4; m += 2) { const u32x2 w0 = pack4(acc[ai][1][m][1] * scale), w1 = pack4(acc[ai][1][m + 1][1] * scale);
                            const auto sx = __builtin_amdgcn_permlane16_swap(w0.x, w1.x, false, false), sy = __builtin_amdgcn_permlane16_swap(w0.y, w1.y, false, false);
                            *(u32x4*)(tv + wbase + (16 * m + fr_) * 32) = (u32x4){sx[0], sy[0], sx[1], sy[1]}; } }
                } else {
#pragma unroll
                    for (int bj = 0; bj < 2; ++bj) { const int col = 256 * (t - 12) + 128 * bj + 32 * wc + 8 * fq, hv = col >> 7, c = col & 127;
                        unsigned char* const tv = WS + WS_RVB + (size_t)((b * 4 + hv) * NSTEP + smem) * 16384;
#pragma unroll
                        for (int m = 0; m < 4; ++m) *(u32x4*)(tv + (16 * m + fr_) * 256 + 2 * c) = pack8(acc[ai][bj][m][0] * scale, acc[ai][bj][m][1] * scale); }
                }
            }
        } else {
            static_assert(kInFp8, "the gate tiles run in the fp8 pass");
            unsigned char* const zb = (unsigned char*)Z + (size_t)(pm * BM - TC) * (NZ * 2);
            int rb_ = wr * 64 + fr_;
            const int cl = wc * 64 + fq * 16;
            if (t < 18) {
                const int cb = ((t - 14) >> 1) * 512 + ((t - 14) & 1) * 256 + cl;
#pragma unroll
                for (int ai = 0; ai < 2; ++ai)
#pragma unroll
                    for (int m = 0; m < 4; ++m) { unsigned w[4];
#pragma unroll
                        for (int bj = 0; bj < 2; ++bj)
#pragma unroll
                            for (int n = 0; n < 2; ++n) { const f32x4 x = acc[ai][bj][m][n] * scale; f32x4 s;
#pragma unroll
                                for (int j = 0; j < 4; ++j) s[j] = x[j] * __builtin_amdgcn_rcpf(1.f + __builtin_amdgcn_exp2f(x[j] * -1.44269504f));
                                w[2 * bj + n] = pk4_fp8(s[0], s[1], s[2], s[3]); }
                        *(u32x4*)(zb + (size_t)(ai * HALF + m * 16 + rb_) * (NZ * 2) + cb) = (u32x4){w[0], w[1], w[2], w[3]}; }
            } else {
                const int cg = 2048 + (t - 18) * 256 + cl;
#pragma unroll
                for (int ai = 0; ai < 2; ++ai)
#pragma unroll
                    for (int m = 0; m < 4; ++m) { unsigned w[4];
#pragma unroll
                        for (int bj = 0; bj < 2; ++bj)
#pragma unroll
                            for (int n = 0; n < 2; ++n) { const f32x4 x = acc[ai][bj][m][n] * (scale * -1.44269504f); unsigned pk = 0u;
#pragma unroll
                                for (int j = 0; j < 4; ++j) { const float c = fmaxf(255.f * __builtin_amdgcn_rcpf(1.f + __builtin_amdgcn_exp2f(x[j])), 1.f);
                                    pk = j == 0 ? __builtin_amdgcn_cvt_pk_u8_f32(c, 0, pk) : j == 1 ? __builtin_amdgcn_cvt_pk_u8_f32(c, 1, pk) : j == 2 ? __builtin_amdgcn_cvt_pk_u8_f32(c, 2, pk) : __builtin_amdgcn_cvt_pk_u8_f32(c, 3, pk); }
                                w[2 * bj + n] = pk; }
                        *(u32x4*)(zb + (size_t)(ai * HALF + m * 16 + rb_) * (NZ * 2) + cg) = (u32x4){w[0], w[1], w[2], w[3]}; }
            }
        }
    }
};
__device__ __forceinline__ f32x4 u8x4_f32(unsigned w) { return (f32x4){(float)(w & 255u), (float)((w >> 8) & 255u), (float)((w >> 16) & 255u), (float)(w >> 24)}; }
struct EpiMerge {
    static constexpr bool MID = true; static constexpr int NSTORES = 16;
    const bf16* Zlat; bf16* out;
    __device__ __forceinline__ void mid(f32x4 (&acc)[2][2][4][2], const Unit& u, int wr, int wc, int fr, int fq) const {
        int rb_ = wr * 64 + fr; asm volatile("" : "+v"(rb_));
#pragma unroll
        for (int ai = 0; ai < 2; ++ai)
#pragma unroll
            for (int m = 0; m < 4; ++m) { const int row = u.pm * BM + ai * HALF + m * 16 + rb_; const unsigned char* zg = (const unsigned char*)Zlat + (size_t)row * (NZ * 2) + 2048;
#pragma unroll
                for (int bj = 0; bj < 2; ++bj) { const int col = u.pn * BM + bj * HALF + wc * 32 + 8 * fq;
                    const u32x2 aw = *(const u32x2*)(zg + col), bw = *(const u32x2*)(zg + 1024 + col);
                    const f32x4 a0 = u8x4_f32(aw.x), a1 = u8x4_f32(aw.y), b0 = u8x4_f32(bw.x), b1 = u8x4_f32(bw.y);
#pragma unroll
                    for (int j = 0; j < 4; ++j) { acc[ai][bj][m][0][j] *= a0[j] * __builtin_amdgcn_rcpf(b0[j]); acc[ai][bj][m][1][j] *= a1[j] * __builtin_amdgcn_rcpf(b1[j]); } } }
    }
    __device__ __forceinline__ void operator()(const f32x4 (&acc)[2][2][4][2], const Unit& u, int wr, int wc, int fr, int fq) const {
        EPI_LOOP_BEGIN
            const u32x2 gw = *(const u32x2*)((const unsigned char*)Zlat + (size_t)row * (NZ * 2) + 3072 + col);
            v0 = v0 * (u8x4_f32(gw.x) * (1.f / 255.f)); v1 = v1 * (u8x4_f32(gw.y) * (1.f / 255.f));
            *(u32x4*)(out + (size_t)row * D + col) = pack8(v0, v1);
        EPI_LOOP_END
    }
};
template <bool F8> __device__ __forceinline__ void store8(void* base, size_t idx, f32x4 v0, f32x4 v1) {
    if constexpr (F8) { u32x2 w; w.x = pk4_fp8(v0[0], v0[1], v0[2], v0[3]); w.y = pk4_fp8(v1[0], v1[1], v1[2], v1[3]); *(u32x2*)((unsigned char*)base + idx) = w; }
    else *(u32x4*)((bf16*)base + idx) = pack8(v0, v1);
}
template <bool F8> struct EpiStore {
    static constexpr int NSTORES = 16;
    void* out; int ldc; float scale;
    __device__ __forceinline__ void operator()(const f32x4 (&acc)[2][2][4][2], const Unit& u, int wr, int wc, int fr, int fq) const {
        EPI_LOOP_BEGIN
            store8<F8>(out, (size_t)row * ldc + col, v0 * scale, v1 * scale);
        EPI_LOOP_END
    }
};
struct EpiGateUp {
    static constexpr bool PRE = true; static constexpr int NSTORES = 8;
    bf16* H0; bf16* H1; const float* bg; const float* bu;
    __device__ __forceinline__ void pre(const Unit& u, LAS float* ec, int wc, int lane) const {
        glds4((lane < 32 ? bg : bu) + (size_t)u.e * FF + u.pn * HALF + wc * 32 + (lane & 31), ec); }
    __device__ __forceinline__ void operator()(const f32x4 (&acc)[2][2][4][2], const Unit& u, int wr, int wc, int fr, int fq, const LAS float* ec) const {
        const int ocol = u.pn * HALF + wc * 32 + 8 * fq;
        const f32x4 bg0 = *(const LAS f32x4*)(ec + 8 * fq), bg1 = *(const LAS f32x4*)(ec + 8 * fq + 4), bu0 = *(const LAS f32x4*)(ec + 32 + 8 * fq), bu1 = *(const LAS f32x4*)(ec + 32 + 8 * fq + 4);
        int rb_ = wr * 64 + fr; asm volatile("" : "+v"(rb_));
#pragma unroll
        for (int ai = 0; ai < 2; ++ai)
#pragma unroll
            for (int m = 0; m < 4; ++m) { const int row = u.pm * BM + ai * HALF + m * 16 + rb_;
                constexpr float ws = 1.f / MOE_WSCALE;
                f32x4 g0 = acc[ai][0][m][0] * ws + bg0, g1 = acc[ai][0][m][1] * ws + bg1, u0 = acc[ai][1][m][0] * ws + bu0, u1 = acc[ai][1][m][1] * ws + bu1, o0, o1;
#pragma unroll
                for (int j = 0; j < 4; ++j) { g0[j] = fminf(g0[j], 7.f); g1[j] = fminf(g1[j], 7.f); u0[j] = fminf(fmaxf(u0[j], -7.f), 7.f); u1[j] = fminf(fmaxf(u1[j], -7.f), 7.f); }
                f32x4 e0 = g0 * (-1.702f * 1.44269504f), e1 = g1 * (-1.702f * 1.44269504f);
#pragma unroll
                for (int j = 0; j < 4; ++j) { e0[j] = __builtin_amdgcn_exp2f(e0[j]); e1[j] = __builtin_amdgcn_exp2f(e1[j]); }
                e0 = e0 + 1.f; e1 = e1 + 1.f;
#pragma unroll
                for (int j = 0; j < 4; ++j) { e0[j] = __builtin_amdgcn_rcpf(e0[j]); e1[j] = __builtin_amdgcn_rcpf(e1[j]); }
                o0 = (g0 * e0) * (u0 + 1.f); o1 = (g1 * e1) * (u1 + 1.f);
                if constexpr (kMoeFp8) { unsigned char* hp = (row < H_SPLIT_TILES * BM) ? (unsigned char*)H0 + (size_t)row * FF : (unsigned char*)H1 + (size_t)(row - H_SPLIT_TILES * BM) * FF;
                    u32x2 w; w.x = pk4_fp8(o0[0], o0[1], o0[2], o0[3]); w.y = pk4_fp8(o1[0], o1[1], o1[2], o1[3]); *(u32x2*)(hp + ocol) = w; }
                else { bf16* hp = (row < H_SPLIT_TILES * BM) ? H0 + (size_t)row * FF : H1 + (size_t)(row - H_SPLIT_TILES * BM) * FF;
                    *(u32x4*)(hp + ocol) = pack8(o0, o1); } }
    }
};
struct EpiDown {
    static constexpr bool PRE = true; static constexpr int NSTORES = 8;
    bf16* Y; const float* bd;
    __device__ __forceinline__ void pre(const Unit& u, LAS float* ec, int wc, int lane) const {
        glds4(bd + (size_t)u.e * D + u.pn * BM + wc * 64 + lane, ec); }
    __device__ __forceinline__ void operator()(const f32x4 (&acc)[2][2][4][2], const Unit& u, int wr, int wc, int fr, int fq, const LAS float* ec) const {
        static_assert(kActFp8, "Y rows are fp8");
        f32x4 b0[2], b1[2];
#pragma unroll
        for (int bj = 0; bj < 2; ++bj) { b0[bj] = *(const LAS f32x4*)(ec + 16 * fq + 8 * bj); b1[bj] = *(const LAS f32x4*)(ec + 16 * fq + 8 * bj + 4); }
        int rb_ = wr * 64 + fr; asm volatile("" : "+v"(rb_));
        unsigned char* const yb = (unsigned char*)Y + u.pn * BM + wc * 64 + 16 * fq;
#pragma unroll
        for (int ai = 0; ai < 2; ++ai)
#pragma unroll
            for (int m = 0; m < 4; ++m) { const int row = u.pm * BM + ai * HALF + m * 16 + rb_; u32x4 o;
                { const f32x4 v0 = acc[ai][0][m][0] * (1.f / MOE_WSCALE) + b0[0], v1 = acc[ai][0][m][1] * (1.f / MOE_WSCALE) + b1[0]; o.x = pk4_fp8(v0[0], v0[1], v0[2], v0[3]); o.y = pk4_fp8(v1[0], v1[1], v1[2], v1[3]); }
                { const f32x4 v0 = acc[ai][1][m][0] * (1.f / MOE_WSCALE) + b0[1], v1 = acc[ai][1][m][1] * (1.f / MOE_WSCALE) + b1[1]; o.z = pk4_fp8(v0[0], v0[1], v0[2], v0[3]); o.w = pk4_fp8(v1[0], v1[1], v1[2], v1[3]); }
                *(u32x4*)(yb + (size_t)row * D) = o; }
    }
};
}

constexpr int RING_BYTES = 131072;
constexpr int LDSCTL_OFF = RING_BYTES;
constexpr int LDS_BYTES = 163840;
constexpr int MISC_OFF = LDS_BYTES - 128;

#define XB_TMO      128
#define XB_XCNT(j)  (256  + 64 * (j))
#define XB_XSUB(j)  (1280 + 64 * (j))
#define XB_XGEN(j)  (2304 + 64 * (j))
#define XB_TOP      3328
#define XB_TOPGEN   3392
#define XCD_BAR_WORDS 3456
#define XB_SPIN_CAP (1u << 22)
__device__ __forceinline__ unsigned xb_ld(unsigned* p)              { return __hip_atomic_load(p, __ATOMIC_RELAXED, __HIP_MEMORY_SCOPE_AGENT); }
__device__ __forceinline__ unsigned xb_add(unsigned* p, unsigned v) { return __hip_atomic_fetch_add(p, v, __ATOMIC_RELAXED, __HIP_MEMORY_SCOPE_AGENT); }
__device__ __forceinline__ unsigned xb_xcc_id() { return (unsigned)__builtin_amdgcn_s_getreg((3 << 11) | 20) & 0xFu; }
#define XB_SPIN(cond, bar) do { unsigned _sp = 0; while (cond) { __builtin_amdgcn_s_sleep(1); \
    if ((++_sp & 255u) == 0u) { if (xb_ld(&(bar)[XB_TMO])) break; if (_sp > XB_SPIN_CAP) { atomicAdd(&(bar)[XB_TMO], 1u); break; } } } } while (0)
struct XcdBarrier { unsigned* bar; unsigned x; volatile LAS unsigned* st; };
__device__ __forceinline__ XcdBarrier xcd_barrier_post(unsigned* bar, volatile LAS unsigned* st) {
    XcdBarrier b; b.bar = bar; b.x = xb_xcc_id(); b.st = st;
    if (threadIdx.x == 0) (void)xb_add(&bar[XB_XCNT(b.x)], 1u);
    return b;
}
__device__ __forceinline__ void xcd_barrier_complete(unsigned* bar, unsigned x, unsigned& nloc, unsigned& nx) {
    const unsigned G = gridDim.x * gridDim.y * gridDim.z;
    unsigned sum, cnt, mine, sp = 0u;
    for (;;) {
        sum = 0u; cnt = 0u; mine = 0u;
#pragma unroll
        for (unsigned j = 0; j < 16; ++j) { const unsigned c = xb_ld(&bar[XB_XCNT(j)]); sum += c; cnt += (c > 0u) ? 1u : 0u; mine = (j == x) ? c : mine; }
        if (sum == G) break;
        __builtin_amdgcn_s_sleep(1);
        if ((++sp & 255u) == 0u) { if (xb_ld(&bar[XB_TMO])) break; if (sp > XB_SPIN_CAP) { atomicAdd(&bar[XB_TMO], 1u); break; } }
    }
    nloc = mine > 0u ? mine : 1u; nx = cnt > 0u ? cnt : 1u;
}
__device__ __forceinline__ void xcd_barrier(const XcdBarrier& b) {
    asm volatile("s_waitcnt vmcnt(0)" ::: "memory");
    __syncthreads();
    if (threadIdx.x == 0) {
        unsigned* bar = b.bar;
        __builtin_amdgcn_s_waitcnt(0);
        unsigned nloc = b.st[0], nx = b.st[1];
        if (nloc == 0u) { xcd_barrier_complete(bar, b.x, nloc, nx); b.st[0] = nloc; b.st[1] = nx; }
        const unsigned old = xb_add(&bar[XB_XSUB(b.x)], 1u);
        const unsigned gen = old / nloc;
        if (old + 1u == (gen + 1u) * nloc) {
            __builtin_amdgcn_fence(__ATOMIC_RELEASE, "agent");
            asm volatile("s_waitcnt vmcnt(0)" ::: "memory");
            const unsigned og = xb_add(&bar[XB_TOP], 1u);
            const unsigned tg = og / nx;
            if (og + 1u == (tg + 1u) * nx) xb_add(&bar[XB_TOPGEN], 1u);
            else XB_SPIN(xb_ld(&bar[XB_TOPGEN]) == tg, bar);
            __builtin_amdgcn_fence(__ATOMIC_ACQUIRE, "agent");
            xb_add(&bar[XB_XGEN(b.x)], 1u);
            asm volatile("s_waitcnt vmcnt(0)" ::: "memory");
        } else {
            XB_SPIN(xb_ld(&bar[XB_XGEN(b.x)]) == gen, bar);
            __builtin_amdgcn_fence(__ATOMIC_ACQUIRE, "agent");
            asm volatile("s_waitcnt vmcnt(0)" ::: "memory");
        }
    }
    __syncthreads();
}

struct Args { const float* in[27]; float* out; unsigned char* ws; int ph_lo, ph_hi; };
enum { I_X = 0, I_C, I_CTX, I_CCTX, I_WADA, I_BADA, I_GPREMIX, I_GPOSTMIX, I_GPREFFN, I_GPOSTFFN, I_WIN, I_HLB, I_HNW, I_GKW2, I_GKB, I_GNW, I_WUPA, I_WUPB, I_WO, I_WR, I_BR, I_WG, I_BG, I_WU, I_BU, I_WDN, I_BDN };
struct Frame { LAS unsigned char* lds; int tid, lane, wave, vcu, G; const Args* a; };

__device__ __forceinline__ void transpose_item(const float* src, int ld, bf16* dst, int dpitch, LAS float* scr, int lane) {
    float tv[32];
#pragma unroll
    for (int i = 0; i < 32; ++i) tv[i] = __builtin_nontemporal_load(src + (size_t)(2 * i + (lane >> 5)) * ld + (lane & 31));
#pragma unroll
    for (int i = 0; i < 32; ++i) scr[(2 * i + (lane >> 5)) * 33 + (lane & 31)] = tv[i];
    LDS_WAIT(); asm volatile("" ::: "memory");
    const int c = lane & 7;
#pragma unroll
    for (int j = 0; j < 4; ++j) { const int n = (lane >> 3) + 8 * j; const LAS float* s = scr + (8 * c) * 33 + n;
        u32x4 o; o.x = pk2(s[0 * 33], s[1 * 33]); o.y = pk2(s[2 * 33], s[3 * 33]); o.z = pk2(s[4 * 33], s[5 * 33]); o.w = pk2(s[6 * 33], s[7 * 33]);
        *(u32x4*)(dst + (size_t)n * dpitch + 8 * c) = o; }
    LDS_WAIT(); asm volatile("" ::: "memory");
}

__device__ __forceinline__ void transpose_item_fp8(const float* src, int ld, unsigned char* dst, int dpitch, LAS float* scr, int lane, float sc) {
    float tv[32];
#pragma unroll
    for (int i = 0; i < 32; ++i) tv[i] = __builtin_nontemporal_load(src + (size_t)(2 * i + (lane >> 5)) * ld + (lane & 31));
#pragma unroll
    for (int i = 0; i < 32; ++i) scr[(2 * i + (lane >> 5)) * 33 + (lane & 31)] = tv[i];
    LDS_WAIT(); asm volatile("" ::: "memory");
    const int c = lane & 7;
#pragma unroll
    for (int j = 0; j < 4; ++j) { const int n = (lane >> 3) + 8 * j; const LAS float* s = scr + (8 * c) * 33 + n;
        u32x2 o; o.x = pk4_fp8(s[0 * 33] * sc, s[1 * 33] * sc, s[2 * 33] * sc, s[3 * 33] * sc); o.y = pk4_fp8(s[4 * 33] * sc, s[5 * 33] * sc, s[6 * 33] * sc, s[7 * 33] * sc);
        *(u32x2*)(dst + (size_t)n * dpitch + 8 * c) = o; }
    LDS_WAIT(); asm volatile("" ::: "memory");
}

__device__ __forceinline__ int inproj_src_col(int n) {
    const int t = n >> 8, rho = n & 255;
    if (t < 12) { const int a = 2 * (rho >> 7) + ((rho >> 2) & 1), cc = 16 * ((rho >> 5) & 3) + 4 * ((rho >> 3) & 3) + (rho & 3);
        if (t < 8) return a * 512 + (t >> 1) * 128 + (t & 1) * 64 + cc;
        const int h = t - 8; if (a == 0) return 2560 + h * 64 + cc; if (a == 1) return 2816 + h * 64 + cc; return -1 - ((a - 2) * 256 + h * 64 + cc); }
    if (t < 14) return 3072 + (n - 12 * 256);
    if (t < 16) return 2048 + (n - 14 * 256);
    return 3616 + (n - 16 * 256);
}
__device__ __forceinline__ void transpose_item_cols(const float* Wk, int ld, int col, bf16* dst, int dpitch, LAS float* scr, int lane) {
    float tv[32];
#pragma unroll
    for (int i = 0; i < 32; ++i) tv[i] = Wk[(size_t)(2 * i + (lane >> 5)) * ld + col];
#pragma unroll
    for (int i = 0; i < 32; ++i) scr[(2 * i + (lane >> 5)) * 33 + (lane & 31)] = tv[i];
    LDS_WAIT(); asm volatile("" ::: "memory");
    const int c = lane & 7;
#pragma unroll
    for (int j = 0; j < 4; ++j) { const int n = (lane >> 3) + 8 * j; const LAS float* s = scr + (8 * c) * 33 + n;
        u32x4 o; o.x = pk2(s[0 * 33], s[1 * 33]); o.y = pk2(s[2 * 33], s[3 * 33]); o.z = pk2(s[4 * 33], s[5 * 33]); o.w = pk2(s[6 * 33], s[7 * 33]);
        *(u32x4*)(dst + (size_t)n * dpitch + 8 * c) = o; }
    LDS_WAIT(); asm volatile("" ::: "memory");
}

__device__ __forceinline__ void p0_mod(const Frame& F, int item) {
    const Args& A = *F.a;
    LAS float* sc = (LAS float*)F.lds; LAS float* part = sc + 17 * 1024;
    const float* wp = A.in[I_WADA] + (size_t)(F.wave * 128) * 6144 + item * 64 + F.lane;
    float wv[32], wn[32];
#pragma unroll
    for (int i = 0; i < 32; ++i) wv[i] = wp[(size_t)i * 6144];
    for (int i = F.tid; i < 17 * 1024; i += NTHREADS) { const int r = i >> 10, k = i & 1023; const float v = (r < 16) ? A.in[I_C][r * 1024 + k] : A.in[I_CCTX][k]; sc[i] = v * sigmoidf_(v); }
    __syncthreads();
    const int k0 = F.wave * 128;
    float acc[17];
#pragma unroll
    for (int r = 0; r < 17; ++r) acc[r] = 0.f;
#pragma unroll
    for (int bq = 0; bq < 4; ++bq) {
        if (bq < 3) {
#pragma unroll
            for (int i = 0; i < 32; ++i) wn[i] = wp[(size_t)(32 * (bq + 1) + i) * 6144]; }
#pragma unroll
        for (int i4 = 0; i4 < 8; ++i4) { const int k = k0 + 32 * bq + 4 * i4;
#pragma unroll
            for (int r = 0; r < 17; ++r) { const f32x4 s = *(const LAS f32x4*)(sc + r * 1024 + k); acc[r] += s.x * wv[4 * i4] + s.y * wv[4 * i4 + 1] + s.z * wv[4 * i4 + 2] + s.w * wv[4 * i4 + 3]; } }
        if (bq < 3) {
#pragma unroll
            for (int i = 0; i < 32; ++i) wv[i] = wn[i]; }
    }
#pragma unroll
    for (int r = 0; r < 17; ++r) part[(F.wave * 17 + r) * 64 + F.lane] = acc[r];
    __syncthreads();
    float* mod = (float*)(A.ws + WS_MOD);
    for (int i = F.tid; i < 17 * 64; i += NTHREADS) { const int r = i >> 6, l = i & 63; float s = A.in[I_BADA][item * 64 + l];
#pragma unroll
        for (int w = 0; w < 8; ++w) s += part[(w * 17 + r) * 64 + l];
        mod[r * 6144 + item * 64 + l] = s; }
    __syncthreads();
}

__device__ __forceinline__ void p0_prologue(const Frame& F) {
    const Args& A = *F.a;
    if (F.vcu < 96) p0_mod(F, F.vcu);
    LAS float* scr = (LAS float*)(F.lds + F.wave * 16384);
    const int gw = F.vcu * NWAVES + F.wave, NGW = F.G * NWAVES;
    bf16* win_t = (bf16*)(A.ws + WS_WIN);
    constexpr int I_WIN_ITEMS = 16 * 208, I_WU = 8 * 32, I_WO_ITEMS = 16 * 32;
    for (int it = gw; it < I_WIN_ITEMS + 2 * I_WU + I_WO_ITEMS; it += NGW) {
        int r = it;
        if (r < I_WIN_ITEMS) { const int kb = r / 208, nb = r % 208, n0 = nb * 32;
            if (n0 < NT_HI * 256) { const int col = inproj_src_col(n0 + (F.lane & 31)); if (col < 0) continue;
                transpose_item_cols(A.in[I_WIN] + (size_t)(64 * kb) * IN_DIM, IN_DIM, col, win_t + (size_t)n0 * D + 64 * kb, D, scr, F.lane); }
            else { const int jl = n0 - NT_HI * 256; const float* sp = A.in[I_WIN] + (size_t)(64 * kb) * IN_DIM + (jl < 512 ? 2048 + jl : jl < 1024 ? 3616 + (jl - 512) : 4128 + (jl - 1024));
                if constexpr (kInFp8) transpose_item_fp8(sp, IN_DIM, (unsigned char*)(A.ws + WS_WIN_LO) + (size_t)(n0 - NT_HI * 256) * D + 64 * kb, D, scr, F.lane, IN_WSCALE);
                else transpose_item(sp, IN_DIM, (bf16*)(A.ws + WS_WIN_LO) + (size_t)(n0 - NT_HI * 256) * D + 64 * kb, D, scr, F.lane); }
            continue; }
        r -= I_WIN_ITEMS;
        if (r < I_WU) { const int kb = r / 32, nb = r % 32; transpose_item(A.in[I_WUPA] + (size_t)(64 * kb) * D + 32 * nb, D, (bf16*)(A.ws + WS_WUA) + (size_t)(32 * nb) * 1024 + 64 * kb, 1024, scr, F.lane); continue; }
        r -= I_WU;
        if (r < I_WU) { const int kb = r / 32, nb = r % 32; transpose_item(A.in[I_WUPB] + (size_t)(64 * kb) * D + 32 * nb, D, (bf16*)(A.ws + WS_WUA) + (size_t)(32 * nb) * 1024 + 512 + 64 * kb, 1024, scr, F.lane); continue; }
        r -= I_WU;
        { const int kb = r / 32, nb = r % 32; transpose_item(A.in[I_WO] + (size_t)(64 * kb) * D + 32 * nb, D, (bf16*)(A.ws + WS_WO) + (size_t)(32 * nb) * D + 64 * kb, D, scr, F.lane); }
    }
    const int gt = F.vcu * NTHREADS + F.tid, NGT = F.G * NTHREADS;
    for (int it = gt; it < 2 * 256 * 128; it += NGT) {
        const int k8 = it & 127, n = (it >> 7) & 255, dir = it >> 15;
        float w2[16];
#pragma unroll
        for (int r = 0; r < 16; ++r) w2[r] = A.in[I_GKW2][(dir * 16 + r) * 256 + n];
        float o[8];
#pragma unroll
        for (int kk = 0; kk < 8; ++kk) { const float* wr = A.in[I_WIN] + (size_t)(k8 * 8 + kk) * IN_DIM + 3584 + 16 * dir; float s = 0.f;
#pragma unroll
            for (int r4 = 0; r4 < 4; ++r4) { const f32x4 w = *(const f32x4*)(wr + 4 * r4); s += w.x * w2[4 * r4] + w.y * w2[4 * r4 + 1] + w.z * w2[4 * r4 + 2] + w.w * w2[4 * r4 + 3]; }
            o[kk] = s; }
        { u32x4 pk; pk.x = pk2(o[0], o[1]); pk.y = pk2(o[2], o[3]); pk.z = pk2(o[4], o[5]); pk.w = pk2(o[6], o[7]);
            const int cc = n & 63, rho = 128 + 32 * (cc >> 4) + 8 * ((cc >> 2) & 3) + 4 * dir + (cc & 3);
            *(u32x4*)(win_t + (size_t)(256 * (8 + (n >> 6)) + rho) * D + k8 * 8) = pk; }
    }
    bf16* wrb = (bf16*)(A.ws + WS_WRT);
    for (int it = gt; it < NE * D; it += NGT) { const int e = it >> 10, k = it & 1023; wrb[it] = (bf16)f2bf(A.in[I_WR][k * NE + e]); }
}

template <int WHICH> __device__ __forceinline__ void convert_expert_weights(const Frame& F) {
    static_assert(kMoeFp8, "fp8 expert weights");
    const Args& A = *F.a;
    LAS float* scr = (LAS float*)(F.lds + F.wave * 16384);
    const int gw = F.vcu * NWAVES + F.wave, NGW = F.G * NWAVES, lane = F.lane;
    constexpr int PER_E = WHICH == 0 ? 16 * 64 : 16 * 32, NIT = NE * PER_E;
    auto item = [&](int it, const float*& src, unsigned char*& dst) { const int e = it / PER_E, r = it % PER_E;
        if (WHICH == 0) { const int kb = r / 64, nb = r % 64, n0 = 32 * nb, pn = n0 >> 8, rr = n0 & 255;
            src = (rr < 128 ? A.in[I_WG] : A.in[I_WU]) + (size_t)e * D * FF + (size_t)(64 * kb) * FF + 128 * pn + (rr & 127);
            dst = A.ws + WS_WGU + (size_t)e * 2048 * D + (size_t)n0 * D + 64 * kb; }
        else { const int kb = r / 32, nb = r % 32; src = A.in[I_WDN] + (size_t)e * FF * D + (size_t)(64 * kb) * D + 32 * nb;
            dst = A.ws + WS_WD + (size_t)e * D * FF + (size_t)(32 * nb) * FF + 64 * kb; } };
    constexpr int ld = 1024;
    float tv[32], tn[32]; const float* src; unsigned char* dst; int it = gw;
    if (it < NIT) { item(it, src, dst);
#pragma unroll
        for (int i = 0; i < 32; ++i) tv[i] = __builtin_nontemporal_load(src + (size_t)(2 * i + (lane >> 5)) * ld + (lane & 31)); }
    while (it < NIT) {
        const int itn = it + NGW; const float* srcn = src; unsigned char* dstn = dst;
        if (itn < NIT) { item(itn, srcn, dstn);
#pragma unroll
            for (int i = 0; i < 32; ++i) tn[i] = __builtin_nontemporal_load(srcn + (size_t)(2 * i + (lane >> 5)) * ld + (lane & 31)); }
#pragma unroll
        for (int i = 0; i < 32; ++i) scr[(2 * i + (lane >> 5)) * 33 + (lane & 31)] = tv[i];
        LDS_WAIT(); asm volatile("" ::: "memory");
        { const int c = lane & 7;
#pragma unroll
          for (int j = 0; j < 4; ++j) { const int n = (lane >> 3) + 8 * j; const LAS float* s = scr + (8 * c) * 33 + n;
              u32x2 o; o.x = pk4_fp8(s[0 * 33] * MOE_WSCALE, s[1 * 33] * MOE_WSCALE, s[2 * 33] * MOE_WSCALE, s[3 * 33] * MOE_WSCALE);
              o.y = pk4_fp8(s[4 * 33] * MOE_WSCALE, s[5 * 33] * MOE_WSCALE, s[6 * 33] * MOE_WSCALE, s[7 * 33] * MOE_WSCALE);
              *(u32x2*)(dst + (size_t)n * D + 8 * c) = o; } }
        LDS_WAIT(); asm volatile("" ::: "memory");
        if (itn < NIT) {
#pragma unroll
            for (int i = 0; i < 32; ++i) tv[i] = tn[i]; }
        src = srcn; dst = dstn; it = itn;
    }
}

__device__ __forceinline__ void p1_prenorm(const Frame& F) {
    const Args& A = *F.a;
    const int gw = F.vcu * NWAVES + F.wave, NGW = F.G * NWAVES;
    const float* mod = (const float*)(A.ws + WS_MOD); bf16* hbf = (bf16*)(A.ws + WS_HBF);
    for (int m = gw; m < MALL; m += NGW) {
        const float* xr = (m < TC) ? A.in[I_CTX] + (size_t)m * D : A.in[I_X] + (size_t)(m - TC) * D;
        const float* md = mod + (size_t)((m < TC) ? 16 : (m - TC) / SEQ) * 6144;
        f32x4 v[4]; float ss = 0.f;
#pragma unroll
        for (int j = 0; j < 4; ++j) { v[j] = *((const f32x4*)xr + F.lane + 64 * j); ss += (v[j].x * v[j].x + v[j].y * v[j].y) + (v[j].z * v[j].z + v[j].w * v[j].w); }
        const float rstd = rsqrtf(wave_sum(ss) * (1.f / D) + EPS);
#pragma unroll
        for (int j = 0; j < 4; ++j) { const int k = 4 * (F.lane + 64 * j);
            const f32x4 g = *(const f32x4*)(A.in[I_GPREMIX] + k), sh = *(const f32x4*)(md + k), sc = *(const f32x4*)(md + 1024 + k);
            const f32x4 h = v[j] * rstd * g * (sc + 1.f) + sh;
            { u32x2 o; o.x = pk2(h.x, h.y); o.y = pk2(h.z, h.w); *((u32x2*)(hbf + (size_t)m * D) + F.lane + 64 * j) = o; }
            if (m >= TC) { if constexpr (kInFp8) *((unsigned*)((unsigned char*)A.out + (size_t)(m - TC) * D) + F.lane + 64 * j) = pk4_fp8(h.x, h.y, h.z, h.w);
                           else { u32x2 o; o.x = pk2(h.x, h.y); o.y = pk2(h.z, h.w); *((u32x2*)((bf16*)A.out + (size_t)(m - TC) * D) + F.lane + 64 * j) = o; } } }
    }
}

typedef short v4i16_t __attribute__((ext_vector_type(4)));
typedef short s16x4 __attribute__((ext_vector_type(4)));
__device__ __forceinline__ s16x4 lds_tr16(const LAS unsigned char* p) { return __builtin_bit_cast(s16x4, __builtin_amdgcn_ds_read_tr16_b64_v4i16((LAS v4i16_t*)p)); }
#define LBAR() do { asm volatile("s_waitcnt lgkmcnt(0)" ::: "memory"); __builtin_amdgcn_s_barrier(); asm volatile("" ::: "memory"); } while (0)

template <int DK, bool HGRN> __device__ __forceinline__ void scan_chain(const Frame& F, LAS unsigned char* L, int hv, int wl, int tl, bf16* obase) {
    const Args& A = *F.a;
    const float* ELg = (const float*)(A.ws + WS_EL);
    const int b = hv >> 3, h = (hv >> 1) & 3, dir = hv & 1;
    const int lane = tl & 63, l15 = lane & 15, g = lane >> 4;
    constexpr int PQ = DK * 2 + 16;
    constexpr int PV = 272;
    constexpr int PP = 144;
    constexpr int NLD = DK / 64;
    constexpr int KS = DK / 32;
    constexpr int IMGB = ((2 * 64 * PQ + 64 * PV + DK * 4 + 1023) / 1024) * 1024;
    constexpr int O_RK = 64 * PQ, O_VI = 2 * 64 * PQ, O_EL = 2 * 64 * PQ + 64 * PV, O_PI = 2 * IMGB;
    static_assert(O_PI + 2 * 64 * PP <= MISC_OFF, "scan images exceed the LDS");
    constexpr int TSZ = 64 * DK * 2;
    const unsigned char* const qk0 = A.ws + (HGRN ? WS_RQA : WS_RQB) + (size_t)hv * NSTEP * 2 * TSZ;
    const unsigned char* const v0 = A.ws + (HGRN ? WS_RVA : WS_RVB) + (size_t)(hv >> 1) * NSTEP * 16384;
    const float* elp = ELg + (size_t)dir * NCG * 768 + (HGRN ? 0 : 512) + h * DK;
    f32x4 S[DK / 16];
#pragma unroll
    for (int i = 0; i < DK / 16; ++i) S[i] = (f32x4){0.f, 0.f, 0.f, 0.f};
    u32x4 rq[2][NLD], rk[2][NLD], rv[2][2], rel[2];
#define SCAN_ISSUE(set, s_) do { const int s__ = (s_); const unsigned char* qt = qk0 + (size_t)s__ * 2 * TSZ; \
        _Pragma("unroll") for (int q = 0; q < NLD; ++q) { const int ci = tl + 512 * q; \
            if (s__ >= 4) rq[set][q] = *(const u32x4*)(qt + 16 * ci); \
            rk[set][q] = *(const u32x4*)(qt + TSZ + 16 * ci); } \
        { const int sm = dir ? (s__ < 4 ? 3 - s__ : 39 - s__) : s__; const unsigned char* vt = v0 + (size_t)sm * 16384; \
          _Pragma("unroll") for (int q = 0; q < 2; ++q) rv[set][q] = *(const u32x4*)(vt + 16 * (tl + 512 * q)); } \
        { const int mc = (s__ < 4) ? (dir ? 3 - s__ : s__) : (dir ? 35 - s__ : s__ - 4), cg = (s__ < 4) ? 4 * b + mc : TC / 64 + 32 * b + mc; \
          if (tl < DK / 4) rel[set] = *(const u32x4*)(elp + (size_t)cg * 768 + 4 * tl); } } while (0)
#define SCAN_WRITE(buf, set, s_) do { LAS unsigned char* const RQw = L + (buf) * IMGB; LAS unsigned char* const RKw = RQw + O_RK; LAS unsigned char* const VIw = RQw + O_VI; const bool latw = (s_) >= 4; \
        _Pragma("unroll") for (int q = 0; q < NLD; ++q) { const int ci = tl + 512 * q, h2 = ci >> 9, wcc = (ci >> 7) & 3, t = (ci >> 1) & 63, hf = ci & 1;        \
            if (latw) { LAS unsigned char* qd = RQw + t * PQ + 64 * (2 * h2 + (wcc >> 1)) + 32 * hf + 8 * (wcc & 1);                                      \
                *(LAS u32x2*)qd = (u32x2){rq[set][q].x, rq[set][q].y}; *(LAS u32x2*)(qd + 16) = (u32x2){rq[set][q].z, rq[set][q].w}; } \
            *(LAS u32x4*)(RKw + t * PQ + 2 * (64 * h2 + 16 * wcc + 8 * hf)) = rk[set][q]; } \
        _Pragma("unroll") for (int q = 0; q < 2; ++q) { const int ci = tl + 512 * q; \
            if constexpr (HGRN) { const int h2 = ci >> 9, wcc = (ci >> 7) & 3, tm = (ci >> 1) & 63, hf = ci & 1, t = dir ? 63 - tm : tm; *(LAS u32x4*)(VIw + t * PV + 2 * (64 * h2 + 16 * wcc + 8 * hf)) = rv[set][q]; } \
            else { const int tm = ci >> 4, t = dir ? 63 - tm : tm, cc = ci & 15; *(LAS u32x4*)(VIw + t * PV + 16 * cc) = rv[set][q]; } } \
        if (tl < DK / 4) *(LAS u32x4*)(RQw + O_EL + 16 * tl) = rel[set]; } while (0)
    SCAN_ISSUE(0, 0); SCAN_ISSUE(1, 1);
    SCAN_WRITE(0, 0, 0); SCAN_ISSUE(0, 2); SCAN_WRITE(1, 1, 1); SCAN_ISSUE(1, 3);
    LBAR();
#pragma nounroll
    for (int s2 = 0; s2 < 36; s2 += 2) {
#pragma unroll
      for (int par = 0; par < 2; ++par) {
        const int s = s2 + par;
        LAS unsigned char* const RQ = L + par * IMGB; LAS unsigned char* const RK = RQ + O_RK; LAS unsigned char* const VI = RQ + O_VI; LAS unsigned char* const ELs = RQ + O_EL;
        LAS unsigned char* const RQn = L + (par ^ 1) * IMGB; LAS unsigned char* const RKn = RQn + O_RK;
        LAS unsigned char* const PI = L + O_PI + par * (64 * PP); LAS unsigned char* const PIn = L + O_PI + (par ^ 1) * (64 * PP);
        bf16x8 Vf[2];
#pragma unroll
        for (int ks2 = 0; ks2 < 2; ++ks2) { const int q = l15 >> 2, p = l15 & 3;
            const s16x4 lo = lds_tr16(VI + (32 * ks2 + 8 * g + q) * PV + 32 * wl + 8 * p), hi = lds_tr16(VI + (32 * ks2 + 8 * g + 4 + q) * PV + 32 * wl + 8 * p);
            Vf[ks2] = (bf16x8){lo[0], lo[1], lo[2], lo[3], hi[0], hi[1], hi[2], hi[3]}; }
        if (s + 1 >= 4 && s + 1 < 36) {
            const int ib = (0x12333210 >> (4 * wl)) & 15, jlo = (0x00102110 >> (4 * wl)) & 15, jhi = (0x00103210 >> (4 * wl)) & 15;
            bf16x8 Bq[KS];
#pragma unroll
            for (int ks = 0; ks < KS; ++ks) Bq[ks] = *(const LAS bf16x8*)(RQn + (16 * ib + l15) * PQ + 64 * ks + 16 * g);
#pragma unroll
            for (int jt = 0; jt < 4; ++jt) { if (jt >= jlo && jt <= jhi) {
                f32x4 acc = (f32x4){0.f, 0.f, 0.f, 0.f};
#pragma unroll
                for (int ks = 0; ks < KS; ++ks) { const LAS unsigned char* kp = RKn + (16 * jt + l15) * PQ + 64 * ks + 8 * g;
                    const s16x4 lo = *(const LAS s16x4*)kp, hi = *(const LAS s16x4*)(kp + 32);
                    const bf16x8 Ak = (bf16x8){lo[0], lo[1], lo[2], lo[3], hi[0], hi[1], hi[2], hi[3]};
                    acc = __builtin_amdgcn_mfma_f32_16x16x32_bf16(Ak, Bq[ks], acc, 0, 0, 0); }
                if (jt == ib) {
#pragma unroll
                    for (int r = 0; r < 4; ++r) if (4 * g + r > l15) acc[r] = 0.f; }
                u32x2 w; w.x = pk2(acc[0], acc[1]); w.y = pk2(acc[2], acc[3]);
                *(LAS u32x2*)(PIn + (16 * ib + l15) * PP + 32 * jt + 8 * g) = w; } }
            if (wl == 0 || wl == 2) *(LAS u32x2*)(PIn + (16 * wl + l15) * PP + 32 * (wl + 1) + 8 * g) = (u32x2){0u, 0u};
        }
        if (s >= 4) {
            bf16x8 Sb[KS];
#pragma unroll
            for (int ks = 0; ks < KS; ++ks) { const f32x4 a = S[2 * ks], c = S[2 * ks + 1]; u32x4 w; w.x = pk2(a[0], a[1]); w.y = pk2(a[2], a[3]); w.z = pk2(c[0], c[1]); w.w = pk2(c[2], c[3]); Sb[ks] = __builtin_bit_cast(bf16x8, w); }
#pragma unroll
            for (int it = 0; it < 4; ++it) {
                f32x4 acc = (f32x4){0.f, 0.f, 0.f, 0.f};
                { const bf16x8 Pf = *(const LAS bf16x8*)(PI + (16 * it + l15) * PP + 16 * g); acc = __builtin_amdgcn_mfma_f32_16x16x32_bf16(Vf[0], Pf, acc, 0, 0, 0); }
                if (it >= 2) { const bf16x8 Pf = *(const LAS bf16x8*)(PI + (16 * it + l15) * PP + 64 + 16 * g); acc = __builtin_amdgcn_mfma_f32_16x16x32_bf16(Vf[1], Pf, acc, 0, 0, 0); }
#pragma unroll
                for (int ks = 0; ks < KS; ++ks) { const bf16x8 Bi = *(const LAS bf16x8*)(RQ + (16 * it + l15) * PQ + 64 * ks + 16 * g); acc = __builtin_amdgcn_mfma_f32_16x16x32_bf16(Sb[ks], Bi, acc, 0, 0, 0); }
                const int p = 64 * (s - 4) + 16 * it + l15, tok = dir ? SEQ - 1 - p : p;
                u32x2 w; w.x = pk2(acc[0], acc[1]); w.y = pk2(acc[2], acc[3]);
                *(u32x2*)(obase + ((size_t)dir * T + (size_t)b * SEQ + tok) * 512 + h * 128 + 16 * wl + 4 * g) = w;
            }
        }
#pragma unroll
        for (int dt = 0; dt < DK / 16; ++dt) {
#pragma unroll
            for (int ks2 = 0; ks2 < 2; ++ks2) { const int q = l15 >> 2, p = l15 & 3;
                const s16x4 lo = lds_tr16(RK + (32 * ks2 + 8 * g + q) * PQ + 32 * dt + 8 * p), hi = lds_tr16(RK + (32 * ks2 + 8 * g + 4 + q) * PQ + 32 * dt + 8 * p);
                const bf16x8 Kf = (bf16x8){lo[0], lo[1], lo[2], lo[3], hi[0], hi[1], hi[2], hi[3]};
                S[dt] = __builtin_amdgcn_mfma_f32_16x16x32_bf16(Kf, Vf[ks2], S[dt], 0, 0, 0); }
            S[dt] = S[dt] * *(const LAS f32x4*)(ELs + (16 * dt + 4 * g) * 4);
        }
        LBAR();
        if (s + 2 < 36) { SCAN_WRITE(par, par, s + 2); if (s + 4 < 36) SCAN_ISSUE(par, s + 4); }
        LBAR();
      }
    }
#undef SCAN_ISSUE
#undef SCAN_WRITE
}

__device__ __forceinline__ void p4_readout(const Frame& F) {
    const Args& A = *F.a;
    const int gw = F.vcu * NWAVES + F.wave, NGW = F.G * NWAVES;
    const bf16* Z = (const bf16*)(A.ws + WS_Z); const bf16* O = (const bf16*)A.out;
    for (int it = gw; it < 2 * T; it += NGW) {
        const int br = it & 1, tok = it >> 1;
        const bf16* of = O + ((size_t)(br * 2 + 0) * T + tok) * 512 + 8 * F.lane; const bf16* ob = O + ((size_t)(br * 2 + 1) * T + tok) * 512 + 8 * F.lane;
        const u32x4 wf = *(const u32x4*)of, wb = *(const u32x4*)ob; const u32x2 wg = *(const u32x2*)((const unsigned char*)Z + (size_t)tok * (NZ * 2) + br * 512 + 8 * F.lane);
        f32x4 a0, a1, b0, b1, g0, g1; pg8::unpack8(wf, a0, a1); pg8::unpack8(wb, b0, b1);
        { const f32x2 p0 = __builtin_amdgcn_cvt_pk_f32_fp8((int)wg.x, false), p1 = __builtin_amdgcn_cvt_pk_f32_fp8((int)wg.x, true), p2 = __builtin_amdgcn_cvt_pk_f32_fp8((int)wg.y, false), p3 = __builtin_amdgcn_cvt_pk_f32_fp8((int)wg.y, true);
          g0 = (f32x4){p0.x, p0.y, p1.x, p1.y}; g1 = (f32x4){p2.x, p2.y, p3.x, p3.y}; }
        a0 += b0; a1 += b1;
        float ss = (a0.x * a0.x + a0.y * a0.y) + (a0.z * a0.z + a0.w * a0.w) + (a1.x * a1.x + a1.y * a1.y) + (a1.z * a1.z + a1.w * a1.w);
        ss += __shfl_xor(ss, 1); ss += __shfl_xor(ss, 2); ss += __shfl_xor(ss, 4); ss += __shfl_xor(ss, 8);
        const float rstd = rsqrtf(ss * (1.f / 128.f) + EPS);
        const float* nw = (br ? A.in[I_GNW] : A.in[I_HNW]) + (8 * F.lane & 127);
        const f32x4 n0 = *(const f32x4*)nw, n1 = *(const f32x4*)(nw + 4);
#pragma unroll
        for (int j = 0; j < 4; ++j) { a0[j] = a0[j] * rstd * n0[j] * g0[j]; a1[j] = a1[j] * rstd * n1[j] * g1[j]; }
        bf16* r = (bf16*)(A.ws + WS_RA) + (size_t)tok * 1024 + br * 512 + 8 * F.lane;
        *(u32x4*)r = pg8::pack8(a0, a1);
    }
}

__device__ __forceinline__ void load_row_bf16(const bf16* p, int lane, f32x4 (&v)[4]) {
#pragma unroll
    for (int j = 0; j < 4; ++j) { const u32x2 w = *((const u32x2*)p + lane + 64 * j); v[j] = (f32x4){bflo(w.x), bfhi(w.x), bflo(w.y), bfhi(w.y)}; }
}
__device__ __forceinline__ void load_row_fp8(const unsigned char* p, int lane, f32x4 (&v)[4]) {
#pragma unroll
    for (int j = 0; j < 4; ++j) { const int w = *((const int*)p + lane + 64 * j); const f32x2 a = __builtin_amdgcn_cvt_pk_f32_fp8(w, false), b = __builtin_amdgcn_cvt_pk_f32_fp8(w, true); v[j] = (f32x4){a.x, a.y, b.x, b.y}; }
}
template <bool F8> __device__ __forceinline__ void load_row_act(const void* base, size_t row, int lane, f32x4 (&v)[4]) {
    if constexpr (F8) load_row_fp8((const unsigned char*)base + row * D, lane, v); else load_row_bf16((const bf16*)base + row * D, lane, v);
}
__device__ __forceinline__ float sumsq4(const f32x4 (&v)[4]) { float s = 0.f;
#pragma unroll
    for (int j = 0; j < 4; ++j) s += (v[j].x * v[j].x + v[j].y * v[j].y) + (v[j].z * v[j].z + v[j].w * v[j].w);
    return s; }
__device__ __forceinline__ void compute_x1(const Args& A, int tok, int lane, const float* md, f32x4 (&x1)[4]) {
    f32x4 mx[4]; load_row_act<kMixFp8>(A.ws + WS_MIXB, (size_t)tok, lane, mx);
    const float rstd = rsqrtf(wave_sum(sumsq4(mx)) * (1.f / D) + EPS);
#pragma unroll
    for (int j = 0; j < 4; ++j) { const int k = 4 * (lane + 64 * j);
        const f32x4 xv = *(const f32x4*)(A.in[I_X] + (size_t)tok * D + k), g = *(const f32x4*)(A.in[I_GPOSTMIX] + k), gt = *(const f32x4*)(md + 2048 + k);
        x1[j] = xv + gt * (mx[j] * rstd * g); }
}

__device__ __forceinline__ void p8_router(const Frame& F) {
    const Args& A = *F.a;
    constexpr int WP = 2064;
    LAS unsigned char* WL = F.lds;
    LAS unsigned char* HB = WL + 32 * WP;
    LAS float* LG = (LAS float*)(HB + 16 * WP);
    int* hist = (int*)((unsigned char*)F.lds + 32 * WP + 16 * WP + 16 * 33 * 4);
    const u32x4* wrb = (const u32x4*)(A.ws + WS_WRT);
#pragma unroll
    for (int q = 0; q < 8; ++q) { const int i = F.tid + NTHREADS * q; *(LAS u32x4*)(WL + (i >> 7) * WP + 16 * (i & 127)) = wrb[i]; }
    if (F.tid < NE) hist[F.tid] = 0;
    __syncthreads();
    const float* mod = (const float*)(A.ws + WS_MOD); unsigned char* h2b = (unsigned char*)(A.ws + WS_H2);
    int* topi = (int*)(A.ws + WS_TOPI); float* topp = (float*)(A.ws + WS_TOPP); int* lrank = (int*)(A.ws + WS_LRANK);
    static_assert(kMoeFp8, "the router phase writes fp8 h2 rows");
    if (F.vcu == 0 && F.wave == 0) {
#pragma unroll
        for (int j = 0; j < 4; ++j) *((unsigned*)(h2b + (size_t)T * D) + F.lane + 64 * j) = 0u; }
    const int l15 = F.lane & 15, g = F.lane >> 4;
    for (int r = 0; r < 8; ++r) {
        const int base = 128 * F.vcu + 16 * r;
#pragma unroll
        for (int q = 0; q < 2; ++q) { const int row = 2 * F.wave + q, tok = base + row; const float* md = mod + (size_t)(tok / SEQ) * 6144;
            f32x4 x1[4]; compute_x1(A, tok, F.lane, md, x1);
            const float rstd = rsqrtf(wave_sum(sumsq4(x1)) * (1.f / D) + EPS);
#pragma unroll
            for (int j = 0; j < 4; ++j) { const int k = 4 * (F.lane + 64 * j);
                { u32x2 o; o.x = pk2(x1[j].x, x1[j].y); o.y = pk2(x1[j].z, x1[j].w); *((u32x2*)((bf16*)(A.ws + WS_X1B) + (size_t)tok * D) + F.lane + 64 * j) = o; }
                const f32x4 gg = *(const f32x4*)(A.in[I_GPREFFN] + k), sh = *(const f32x4*)(md + 3072 + k), sc = *(const f32x4*)(md + 4096 + k);
                const f32x4 h = x1[j] * rstd * gg * (sc + 1.f) + sh;
                *((unsigned*)(h2b + (size_t)tok * D) + F.lane + 64 * j) = pk4_fp8(h.x, h.y, h.z, h.w);
                u32x2 o; o.x = pk2(h.x, h.y); o.y = pk2(h.z, h.w); *(LAS u32x2*)(HB + row * WP + 8 * (F.lane + 64 * j)) = o; } }
        LBAR();
        if (F.wave < 2) { const int n = F.wave; f32x4 acc = (f32x4){0.f, 0.f, 0.f, 0.f};
#pragma unroll 8
            for (int ks = 0; ks < 32; ++ks) { const bf16x8 a = *(const LAS bf16x8*)(HB + l15 * WP + 64 * ks + 16 * g), bb = *(const LAS bf16x8*)(WL + (16 * n + l15) * WP + 64 * ks + 16 * g);
                acc = __builtin_amdgcn_mfma_f32_16x16x32_bf16(a, bb, acc, 0, 0, 0); }
            const float bias = A.in[I_BR][16 * n + l15];
#pragma unroll
            for (int rr = 0; rr < 4; ++rr) LG[(4 * g + rr) * 33 + 16 * n + l15] = acc[rr] + bias; }
        LBAR();
        if (F.wave == 2 && F.lane < 16) { const int tok = base + F.lane;
            float v0 = -INFINITY, v1 = -INFINITY, v2 = -INFINITY, v3 = -INFINITY; int i0 = 0, i1 = 0, i2 = 0, i3 = 0;
#pragma unroll 8
            for (int e = 0; e < NE; ++e) { const float x = LG[F.lane * 33 + e]; const bool c0 = x > v0, c1 = x > v1, c2 = x > v2, c3 = x > v3;
                v3 = c3 ? (c2 ? v2 : x) : v3; i3 = c3 ? (c2 ? i2 : e) : i3; v2 = c2 ? (c1 ? v1 : x) : v2; i2 = c2 ? (c1 ? i1 : e) : i2;
                v1 = c1 ? (c0 ? v0 : x) : v1; i1 = c1 ? (c0 ? i0 : e) : i1; v0 = c0 ? x : v0; i0 = c0 ? e : i0; }
            const float e1 = __expf(v1 - v0), e2 = __expf(v2 - v0), e3 = __expf(v3 - v0), inv = 1.f / (1.f + e1 + e2 + e3);
            *(i32x4*)(topi + tok * 4) = (i32x4){i0, i1, i2, i3}; *(f32x4*)(topp + tok * 4) = (f32x4){inv, e1 * inv, e2 * inv, e3 * inv};
            i32x4 lr; lr.x = __hip_atomic_fetch_add(hist + i0, 1, __ATOMIC_RELAXED, __HIP_MEMORY_SCOPE_WORKGROUP); lr.y = __hip_atomic_fetch_add(hist + i1, 1, __ATOMIC_RELAXED, __HIP_MEMORY_SCOPE_WORKGROUP);
            lr.z = __hip_atomic_fetch_add(hist + i2, 1, __ATOMIC_RELAXED, __HIP_MEMORY_SCOPE_WORKGROUP); lr.w = __hip_atomic_fetch_add(hist + i3, 1, __ATOMIC_RELAXED, __HIP_MEMORY_SCOPE_WORKGROUP);
            *(i32x4*)(lrank + tok * 4) = lr; }
    }
    __syncthreads();
    if (F.tid < NE) { unsigned* gc = (unsigned*)(A.ws + WS_CTL) + CW_GCOUNT; const int basec = (int)__hip_atomic_fetch_add(gc + F.tid, (unsigned)hist[F.tid], RLX_AGENT);
        ((int*)(A.ws + WS_BLKBASE))[F.vcu * NE + F.tid] = basec; }
    __syncthreads();
}

__device__ __forceinline__ void p9_slots(const Frame& F) {
    const Args& A = *F.a;
    int* ps = (int*)((unsigned char*)F.lds); int* cn = ps + 64;
    const unsigned* gc = (const unsigned*)(A.ws + WS_CTL) + CW_GCOUNT;
    if (F.tid < NE) cn[F.tid] = (int)__hip_atomic_load(gc + F.tid, RLX_AGENT);
    __syncthreads();
    if (F.tid == 0) { int acc = 0; for (int e = 0; e < NE; ++e) { ps[e] = acc; acc += (cn[e] + 255) & ~255; } ps[NE] = acc; }
    __syncthreads();
    const int* topi = (const int*)(A.ws + WS_TOPI); const int* lrank = (const int*)(A.ws + WS_LRANK); const int* blkbase = (const int*)(A.ws + WS_BLKBASE);
    int* pslot = (int*)(A.ws + WS_PSLOT); int* tokslot = (int*)(A.ws + WS_TOKSLOT);
    for (int p = F.vcu * NTHREADS + F.tid; p < T * TOPK; p += F.G * NTHREADS) {
        const int tok = p >> 2, e = topi[p], slot = ps[e] + blkbase[(tok >> 7) * NE + e] + lrank[p];
        tokslot[slot] = tok; pslot[p] = slot; }
    if (F.vcu < NE) { const int e = F.vcu, pad = ((cn[e] + 255) & ~255); for (int i = cn[e] + F.tid; i < pad; i += NTHREADS) tokslot[ps[e] + i] = T; }
    if (F.vcu == NE) { const int ntile = ps[NE] >> 8; int* tile_e = (int*)(A.ws + WS_TILEE);
        for (int t = F.tid; t < MAXTILES; t += NTHREADS) { int e = 0; for (int q = 0; q < NE; ++q) if (t * 256 >= ps[q]) e = q; tile_e[t] = (t < ntile) ? e : 0; }
        if (F.tid == 0) ((int*)(A.ws + WS_CTL))[CW_NT] = ntile; }
    __syncthreads();
}

__device__ __forceinline__ void p12_final(const Frame& F) {
    const Args& A = *F.a;
    const int gw = F.vcu * NWAVES + F.wave, NGW = F.G * NWAVES;
    const float* mod = (const float*)(A.ws + WS_MOD); const bf16* Y = (const bf16*)(A.ws + WS_Y);
    const int* pslot = (const int*)(A.ws + WS_PSLOT); const float* topp = (const float*)(A.ws + WS_TOPP);
    constexpr int NTK = 4;
    for (int tok0 = gw; tok0 < T; tok0 += NTK * NGW) {
        int tok[NTK]; i32x4 sl[NTK]; f32x4 pw[NTK];
#pragma unroll
        for (int q = 0; q < NTK; ++q) { tok[q] = tok0 + q * NGW; sl[q] = *(const i32x4*)(pslot + tok[q] * 4); pw[q] = *(const f32x4*)(topp + tok[q] * 4); }
        f32x4 x1[NTK][4], f[NTK][4];
#pragma unroll
        for (int q = 0; q < NTK; ++q) { load_row_bf16((const bf16*)(A.ws + WS_X1B) + (size_t)tok[q] * D, F.lane, x1[q]);
#pragma unroll
            for (int j = 0; j < 4; ++j) f[q][j] = (f32x4){0.f, 0.f, 0.f, 0.f};
#pragma unroll
            for (int k = 0; k < 4; ++k) { f32x4 y[4]; load_row_act<kActFp8>(Y, (size_t)sl[q][k], F.lane, y);
#pragma unroll
                for (int j = 0; j < 4; ++j) f[q][j] += y[j] * pw[q][k]; } }
#pragma unroll
        for (int q = 0; q < NTK; ++q) { const float* md = mod + (size_t)(tok[q] / SEQ) * 6144;
            const float rstd = rsqrtf(wave_sum(sumsq4(f[q])) * (1.f / D) + EPS);
#pragma unroll
            for (int j = 0; j < 4; ++j) { const int k = 4 * (F.lane + 64 * j);
                const f32x4 g = *(const f32x4*)(A.in[I_GPOSTFFN] + k), gt = *(const f32x4*)(md + 5120 + k);
                *(f32x4*)(A.out + (size_t)tok[q] * D + k) = x1[q][j] + gt * (f[q][j] * rstd * g); } }
    }
}

constexpr int NPHASES = 12;
__global__ void __launch_bounds__(NTHREADS, 2) fwd_kernel(Args args) {
    extern __shared__ __attribute__((aligned(16))) unsigned char lds_raw[];
    Frame F; F.lds = (LAS unsigned char*)lds_raw; F.tid = threadIdx.x; F.lane = F.tid & 63; F.wave = __builtin_amdgcn_readfirstlane(F.tid >> 6);
    F.G = gridDim.x; { const int bx = blockIdx.x; F.vcu = (F.G % 8 == 0) ? (bx % 8) * (F.G / 8) + bx / 8 : bx; } F.a = &args;
    volatile LAS unsigned* MISC = (volatile LAS unsigned*)(F.lds + MISC_OFF);
    for (int u = F.tid; u < (LDS_BYTES - LDSCTL_OFF) / 4; u += NTHREADS) ((LAS unsigned*)(F.lds + LDSCTL_OFF))[u] = 0u;
    __syncthreads();
    unsigned char* ws = args.ws;
    unsigned* ctl = (unsigned*)(ws + WS_CTL);
    const int lo = args.ph_lo, hi = args.ph_hi;
    XcdBarrier bar; bar.bar = ctl + CW_BAR; bar.x = 0; bar.st = nullptr;
    if (hi - lo > 1) bar = xcd_barrier_post(ctl + CW_BAR, MISC + 8);
#define IN(k) (lo <= (k) && (k) < hi)
#define SEAM(k) do { if (IN(k) && IN((k) + 1)) xcd_barrier(bar); } while (0)
    const int bx = (int)blockIdx.x;

    if (IN(0)) { p0_prologue(F); } SEAM(0);
    if (IN(1)) { p1_prenorm(F); } SEAM(1);
    if (IN(2)) {
        const int nfirst = F.vcu & 1;
#pragma nounroll
        for (int pass = 0; pass < 3; ++pass) {
            if (pass == 1) { pg8::InprojOrder S{F.G, bx, (const char*)(ws + WS_HBF), (const char*)(ws + WS_WIN), (size_t)256 * 2048, (size_t)256 * 2048};
                pg8::EpiInproj E{(bf16*)(ws + WS_Z), ws, (float*)(ws + WS_EL), args.in[I_GKB], args.in[I_HLB], 0, 0, 1.f};
                pg8::gemm_phase<pg8::EpiInproj, pg8::InprojOrder, 0, true, false>(F.lds, 2048, S, E, nullptr, nullptr, S.A, S.B); }
            else { pg8::DenseOrder S; S.init(T, NT_LO * 256, IN_KB, F.G, bx, args.out, ws + WS_WIN_LO);
                if (pass == 0) S.hi = nfirst; else S.lo = nfirst;
                pg8::EpiInproj E{(bf16*)(ws + WS_Z), ws, (float*)(ws + WS_EL), args.in[I_GKB], args.in[I_HLB], TC / 256, NT_HI, 1.f / IN_WSCALE};
                pg8::gemm_phase<pg8::EpiInproj, pg8::DenseOrder, kInFp8 ? 2 : 0, true, kInFp8, 1>(F.lds, IN_KB, S, E, nullptr, (const char*)args.out, S.A, S.B); }
        }
    } SEAM(2);
    if (IN(3)) {
        if (F.vcu < 128) scan_chain<128, true>(F, F.lds, F.vcu, F.wave, F.tid, (bf16*)args.out);
        else scan_chain<64, false>(F, F.lds, F.vcu - 128, F.wave, F.tid, (bf16*)args.out + (size_t)2 * T * 512);
    } SEAM(3);
    if (IN(4)) { p4_readout(F); } SEAM(4);
    if (IN(5)) {
        pg8::DenseOrder S; S.init(T, D, 2048, F.G, bx, ws + WS_RA, ws + WS_WUA);
        pg8::EpiMerge E{(const bf16*)(ws + WS_Z), (bf16*)args.out};
        pg8::gemm_phase<pg8::EpiMerge, pg8::DenseOrder, 0, true, false>(F.lds, 2048, S, E, nullptr, nullptr, S.A, S.B);
    } SEAM(5);
    if (IN(6)) {
        pg8::DenseOrder S; S.init(T, D, D * 2, F.G, bx, (const bf16*)args.out, ws + WS_WO);
        pg8::EpiStore<kMixFp8> E{(void*)(ws + WS_MIXB), D, 1.f};
        const bool conv_first = (F.vcu & 1) != 0;
        if (conv_first) { convert_expert_weights<0>(F); __syncthreads(); }
        pg8::gemm_phase<pg8::EpiStore<kMixFp8>, pg8::DenseOrder, 0, true, false>(F.lds, D * 2, S, E, nullptr, nullptr, S.A, S.B);
        if (!conv_first) { __syncthreads(); convert_expert_weights<0>(F); }
    } SEAM(6);
    if (IN(7)) { p8_router(F); } SEAM(7);
    if (IN(8)) { p9_slots(F); } SEAM(8);
    if (IN(9)) {
        const int ntile = __builtin_amdgcn_readfirstlane(((const int*)ctl)[CW_NT]);
        pg8::MoeOrder S{ntile, 8, F.G, bx, (const int*)(ws + WS_TILEE), (const char*)(ws + WS_WGU), (size_t)2048 * MOE_KB, (size_t)256 * MOE_KB, nullptr, nullptr, 0};
        pg8::EpiGateUp E{(bf16*)args.out, (bf16*)(ws + WS_HREST), args.in[I_BG], args.in[I_BU]};
        const bool conv_first = (F.vcu & 1) != 0;
        if (conv_first) { convert_expert_weights<1>(F); __syncthreads(); }
        pg8::gemm_phase<pg8::EpiGateUp, pg8::MoeOrder, 1, true, kMoeFp8>(F.lds, MOE_KB, S, E, (const int*)(ws + WS_TOKSLOT), (const char*)(ws + WS_H2), nullptr, S.B);
        if (!conv_first) { __syncthreads(); convert_expert_weights<1>(F); }
    } SEAM(9);
    if (IN(10)) {
        const int ntile = __builtin_amdgcn_readfirstlane(((const int*)ctl)[CW_NT]);
        pg8::MoeOrder S{ntile, 4, F.G, bx, (const int*)(ws + WS_TILEE), (const char*)(ws + WS_WD), (size_t)D * MOE_KB, (size_t)256 * MOE_KB, (const char*)args.out, (const char*)(ws + WS_HREST), (size_t)256 * MOE_KB};
        pg8::EpiDown E{(bf16*)(ws + WS_Y), args.in[I_BDN]};
        static_assert(kMoeFp8, "MoE operands are fp8");
        pg8::gemm_phase<pg8::EpiDown, pg8::MoeOrder, 2, true, true, 1>(F.lds, MOE_KB, S, E, nullptr, (const char*)(ws + WS_HREST), nullptr, S.B);
    } SEAM(10);
    if (IN(11)) { p12_final(F); }
#undef IN
#undef SEAM
}

extern "C" void kernel_launch(void* const* d_in, const int* in_sizes, int n_in, void* d_out, int out_size, void* d_ws, size_t ws_size, hipStream_t stream) {
    static int grid = 0;
    if (grid == 0) {
        if (n_in != 27 || out_size != T * D || ws_size < WS_END) { fprintf(stderr, "kernel_launch: unexpected shapes: n_in %d out %d ws %zu (need %zu)\n", n_in, out_size, ws_size, (size_t)WS_END); grid = -1; return; }
        int dev = 0, cus = 0, per_cu = 0;
        if (hipGetDevice(&dev) != hipSuccess || hipDeviceGetAttribute(&cus, hipDeviceAttributeMultiprocessorCount, dev) != hipSuccess) { grid = -1; return; }
        if (hipFuncSetAttribute((const void*)fwd_kernel, hipFuncAttributeMaxDynamicSharedMemorySize, LDS_BYTES) != hipSuccess) { fprintf(stderr, "kernel_launch: hipFuncSetAttribute failed\n"); grid = -1; return; }
        if (hipOccupancyMaxActiveBlocksPerMultiprocessor(&per_cu, (const void*)fwd_kernel, NTHREADS, LDS_BYTES) != hipSuccess || per_cu < 1) { fprintf(stderr, "kernel_launch: occupancy query says %d blocks per CU\n", per_cu); (void)hipGetLastError(); grid = -1; return; }
        grid = cus;
        if (grid > 256) grid = 256;
        if (grid % 8 != 0) grid -= grid % 8;
    }
    if (grid < 0) return;
    (void)hipMemsetAsync((char*)d_ws + WS_CTL, 0, CTL_ZERO_BYTES, stream);
    Args a{};
    for (int i = 0; i < 27; ++i) a.in[i] = (const float*)d_in[i];
    a.out = (float*)d_out; a.ws = (unsigned char*)d_ws;
    if (REPEAT_PHASE >= 0) {
        a.ph_lo = 0; a.ph_hi = REPEAT_PHASE + 1; hipLaunchKernelGGL(fwd_kernel, dim3(grid), dim3(NTHREADS), LDS_BYTES, stream, a);
        (void)hipMemsetAsync((char*)d_ws + WS_CTL + CW_BAR * 4, 0, XCD_BAR_WORDS * 4, stream);
        if (REPEAT_PHASE == 7) (void)hipMemsetAsync((char*)d_ws + WS_CTL + CW_GCOUNT * 4, 0, 256, stream);
        a.ph_lo = REPEAT_PHASE; a.ph_hi = NPHASES; hipLaunchKernelGGL(fwd_kernel, dim3(grid), dim3(NTHREADS), LDS_BYTES, stream, a); }
    else if (MK_N_LAUNCHES == 1) { a.ph_lo = 0; a.ph_hi = NPHASES; hipLaunchKernelGGL(fwd_kernel, dim3(grid), dim3(NTHREADS), LDS_BYTES, stream, a); }
    else for (int p = 0; p < NPHASES; ++p) { a.ph_lo = p; a.ph_hi = p + 1; hipLaunchKernelGGL(fwd_kernel, dim3(grid), dim3(NTHREADS), LDS_BYTES, stream, a); }
}
```

```cpp
#include <hip/hip_runtime.h>
#include <cstdio>
#include <cstdint>

#ifndef MK_N_LAUNCHES
#define MK_N_LAUNCHES 1
#endif

#ifndef REPEAT_PHASE
#define REPEAT_PHASE -1
#endif
#ifndef MOE_FP8
#define MOE_FP8 1
#endif
#ifndef INPROJ_FP8
#define INPROJ_FP8 1
#endif
#ifndef ACT_FP8
#define ACT_FP8 1
#endif
#ifndef USE_NAIVE_SCAN
#define USE_NAIVE_SCAN 0
#endif
#define LAS __attribute__((address_space(3)))
typedef unsigned short bf16;
typedef short bf16x8 __attribute__((ext_vector_type(8)));
typedef float f32x4 __attribute__((ext_vector_type(4)));
typedef float f32x2 __attribute__((ext_vector_type(2)));
typedef unsigned u32x4 __attribute__((ext_vector_type(4)));
typedef unsigned u32x2 __attribute__((ext_vector_type(2)));
typedef int i32x4 __attribute__((ext_vector_type(4)));
typedef int i32x8 __attribute__((ext_vector_type(8)));

constexpr int D = 1024, NB = 16, SEQ = 2048, CTX = 256;
constexpr int T = NB * SEQ, TC = NB * CTX, MALL = T + TC;
constexpr int NZ = 3072;
constexpr int ZC_OGA = 0, ZC_OGB = 512, ZC_MGA = 1024, ZC_MGB = 2048;
constexpr int NSTEP = 36;
constexpr int NT_HI = 14, NT_LAT = 12, NT_LO = 14;
constexpr int IN_DIM = 6176;
constexpr int NE = 32, TOPK = 4, FF = 1024;
constexpr int MAXSLOT = T * TOPK + NE * 256, MAXTILES = MAXSLOT / 256;
constexpr float EPS = 1e-6f;
constexpr int NWAVES = 8, NTHREADS = 512;

constexpr size_t MiB = 1u << 20;
constexpr size_t WS_CTL = 0, CTL_ZERO_BYTES = 1 * MiB;
constexpr size_t WS_MOD = 1 * MiB;
constexpr size_t WS_WRT = 1 * MiB + 512 * 1024;
constexpr size_t WS_WIN = 2 * MiB;
constexpr size_t WS_WUA = 15 * MiB, WS_WUB = 16 * MiB, WS_WO = 17 * MiB;
constexpr size_t WS_TOPI = 19 * MiB, WS_TOPP = WS_TOPI + 512 * 1024, WS_LRANK = 20 * MiB, WS_PSLOT = WS_LRANK + 512 * 1024, WS_BLKBASE = 21 * MiB, WS_TOKSLOT = 21 * MiB + 256 * 1024, WS_TILEE = 22 * MiB;
constexpr size_t WS_HBF = 24 * MiB;
constexpr size_t WS_RA = 24 * MiB, WS_RB = 56 * MiB;
constexpr size_t WS_H2 = 24 * MiB;
constexpr size_t WS_Z = 96 * MiB;
constexpr size_t WS_RQA = 288 * MiB;
constexpr size_t WS_RQB = 432 * MiB;
constexpr size_t WS_RVA = 504 * MiB;
constexpr size_t WS_RVB = 540 * MiB;
constexpr size_t WS_EL = 576 * MiB;
constexpr int NCG = MALL / 64;
constexpr size_t WS_WGU = 89 * MiB;
constexpr size_t WS_Y = 24 * MiB;
constexpr size_t WS_X1B = 160 * MiB;
constexpr size_t WS_MIXB = 296 * MiB;
constexpr size_t WS_WD = 360 * MiB;
constexpr size_t WS_HREST = (MOE_FP8 ? 392 : 424) * MiB;
constexpr size_t WS_END = 584 * MiB;
constexpr bool kInFp8 = (INPROJ_FP8 != 0);
constexpr int IN_KB = kInFp8 ? 1024 : 2048;
constexpr float IN_WSCALE = kInFp8 ? 32.f : 1.f;
constexpr size_t WS_WIN_LO = 580 * MiB;
constexpr bool kActFp8 = (ACT_FP8 != 0);
constexpr bool kMixFp8 = false;
constexpr bool kMoeFp8 = (MOE_FP8 != 0);
constexpr int MOE_KB = kMoeFp8 ? 1024 : 2048;
constexpr float MOE_WSCALE = kMoeFp8 ? 32.f : 1.f;
constexpr int H_SPLIT_TILES = kMoeFp8 ? 0 : 256;
constexpr int CW_BAR = 4096, CW_BAR2 = 8192, CW_GCOUNT = 16384, CW_NT = 16384 + 64;

#define RLX_AGENT __ATOMIC_RELAXED, __HIP_MEMORY_SCOPE_AGENT
#define LDS_WAIT() asm volatile("s_waitcnt lgkmcnt(0)" ::: "memory")
#define VM_WAIT() asm volatile("s_waitcnt vmcnt(0)" ::: "memory")
__device__ __forceinline__ unsigned f2bf(float f) { unsigned u = __builtin_bit_cast(unsigned, f); return (u + 0x7fffu + ((u >> 16) & 1u)) >> 16; }
__device__ __forceinline__ unsigned pk2(float lo, float hi) { return f2bf(lo) | (f2bf(hi) << 16); }
__device__ __forceinline__ unsigned pk4_fp8(float a, float b, float c, float d) { int w = 0; w = __builtin_amdgcn_cvt_pk_fp8_f32(a, b, w, false); w = __builtin_amdgcn_cvt_pk_fp8_f32(c, d, w, true); return (unsigned)w; }
__device__ __forceinline__ float bf2f(unsigned short b) { return __builtin_bit_cast(float, ((unsigned)b) << 16); }
__device__ __forceinline__ float bflo(unsigned w) { return __builtin_bit_cast(float, w << 16); }
__device__ __forceinline__ float bfhi(unsigned w) { return __builtin_bit_cast(float, w & 0xffff0000u); }
__device__ __forceinline__ float sigmoidf_(float x) { return __builtin_amdgcn_rcpf(1.0f + __expf(-x)); }
template <int CTRL> __device__ __forceinline__ float dpp_mov(float v, float old) { return __builtin_bit_cast(float, __builtin_amdgcn_update_dpp(__builtin_bit_cast(int, old), __builtin_bit_cast(int, v), CTRL, 0xf, 0xf, false)); }
__device__ __forceinline__ float rdlane(float v, int l) { return __builtin_bit_cast(float, __builtin_amdgcn_readlane(__builtin_bit_cast(int, v), l)); }
__device__ __forceinline__ float wave_sum(float v) {
    v += dpp_mov<0x111>(v, 0.f); v += dpp_mov<0x112>(v, 0.f); v += dpp_mov<0x114>(v, 0.f); v += dpp_mov<0x118>(v, 0.f);
    return (rdlane(v, 15) + rdlane(v, 31)) + (rdlane(v, 47) + rdlane(v, 63));
}
__device__ __forceinline__ float wave_max(float v) {
    const float ninf = -INFINITY;
    v = fmaxf(v, dpp_mov<0x111>(v, ninf)); v = fmaxf(v, dpp_mov<0x112>(v, ninf)); v = fmaxf(v, dpp_mov<0x114>(v, ninf)); v = fmaxf(v, dpp_mov<0x118>(v, ninf));
    return fmaxf(fmaxf(rdlane(v, 15), rdlane(v, 31)), fmaxf(rdlane(v, 47), rdlane(v, 63)));
}

__device__ __forceinline__ int qperm(int d) { return (d & ~31) | (((d >> 2) & 3) << 3) | (((d >> 4) & 1) << 2) | (d & 3); }
namespace pg8 {
constexpr int BM = 256, BK = 64, HALF = 128, HTB = HALF * BK * 2, STAGE_BYTES = 8 * HTB;
__device__ __forceinline__ int lds_byte(int r, int c) { const int st = (r >> 4) * 2 + (c >> 5), rr = r & 15, cc = c & 31, ob = rr * 64 + cc * 2; return st * 1024 + (ob ^ (((ob >> 9) & 1) << 5)); }
__device__ __forceinline__ void stage_rc(int b, int& R, int& C) { const int st = b / 1024, sb = b % 1024, swz = sb ^ (((sb >> 9) & 1) << 5); R = (st >> 1) * 16 + swz / 64; C = (st & 1) * 32 + (swz % 64) / 2; }
__device__ __forceinline__ int perm32(int rho) { const int n = rho >> 4, i = rho & 15; return 8 * (i >> 2) + 4 * n + (i & 3); }
__device__ __forceinline__ unsigned cvt_pk_bf16(float lo, float hi) { unsigned r; asm volatile("v_cvt_pk_bf16_f32 %0, %1, %2" : "=v"(r) : "v"(lo), "v"(hi)); return r; }

struct Unit { int pm, pn, e; unsigned a, b; };

template <class E, class = void> struct EpiHasPre { static constexpr bool value = false; };
template <class E> struct EpiHasPre<E, decltype((void)E::PRE)> { static constexpr bool value = E::PRE; };
__device__ __forceinline__ void glds4(const void* g, LAS void* l) { __builtin_amdgcn_global_load_lds((const unsigned*)g, (LAS unsigned*)l, 4, 0, 0); }
template <class E, class = void> struct EpiHasMid { static constexpr bool value = false; };
template <class E> struct EpiHasMid<E, decltype((void)E::MID)> { static constexpr bool value = E::MID; };
template <class Epi, class Sched, int GATHER, bool ALIGN_EPI, bool FP8, int BPERM = 0>
__device__ __forceinline__ void gemm_phase(LAS unsigned char* lds, const int KB, const Sched& S, const Epi& E, const int* __restrict__ rowidx, const char* gatherA, const void* Abase, const void* Bbase) {
    const int tid = threadIdx.x, wid = __builtin_amdgcn_readfirstlane(tid >> 6), lane = tid & 63, wr = wid >> 2, wc = wid & 3, fr = lane & 15, fq = lane >> 4;
    const int nt = KB / (BK * 2);
    unsigned vA[2][2], voffB[2]; int Rr[2], Cc[2];
#pragma unroll
    for (int i = 0; i < 2; ++i) { int R, C; stage_rc(tid * 16 + i * 8192, R, C); Rr[i] = R; Cc[i] = C; const int Rb = (R & ~31) + perm32(R & 31);
        const int Rp = (R >> 5) * 64 + ((R >> 2) & 3) * 16 + ((R >> 4) & 1) * 4 + (R & 3);
        voffB[i] = (unsigned)((BPERM ? Rp : Rb) * KB + 2 * C); vA[0][i] = (unsigned)(R * KB + 2 * C); vA[1][i] = (unsigned)((R + HALF) * KB + 2 * C); }
    const unsigned kstep = (unsigned)(BK * 2);
    const unsigned hstep = (unsigned)(HALF * KB);
    const unsigned hstepB = BPERM ? (unsigned)(8 * KB) : hstep;
    const unsigned ldsw = (unsigned)wid * 1024u;
    const int aoff = lds_byte(wr * 64 + fr, FP8 ? fq * 16 : fq * 8), boff = lds_byte(wc * 32 + fr, FP8 ? fq * 16 : fq * 8);
    constexpr int KSTR = FP8 ? 16 : 1024;
#define PG8_SA(b, h) (((b) * 2 + (h)) * HTB)
#define PG8_SB(b, h) ((4 + (b) * 2 + (h)) * HTB)
#define PG8_STAGE(bufoff, rsrc, soff, voff) do { _Pragma("unroll") for (int _i = 0; _i < 2; ++_i) \
        __builtin_amdgcn_raw_ptr_buffer_load_lds(rsrc, (LAS void*)(lds + (bufoff) + ldsw + _i * 8192), 16, (int)(voff)[_i], (int)(soff), 0, 0); } while (0)
#define PG8_LDA(dst, b, h) do { _Pragma("unroll") for (int m = 0; m < 4; ++m) _Pragma("unroll") for (int k = 0; k < 2; ++k) dst[m][k] = *(const LAS i32x4*)(lds + PG8_SA(b, h) + aoff + m * 2048 + k * KSTR); } while (0)
#define PG8_LDB(dst, b, h) do { _Pragma("unroll") for (int n = 0; n < 2; ++n) _Pragma("unroll") for (int k = 0; k < 2; ++k) dst[n][k] = *(const LAS i32x4*)(lds + PG8_SB(b, h) + boff + n * 2048 + k * KSTR); } while (0)
#define PG8_V8(x) __builtin_shufflevector((x)[0], (x)[1], 0, 1, 2, 3, 4, 5, 6, 7)
#define PG8_MMA(ai, bj, At, Bt) do { __builtin_amdgcn_s_setprio(3); _Pragma("unroll") for (int m = 0; m < 4; ++m) _Pragma("unroll") for (int n = 0; n < 2; ++n) { \
        if constexpr (FP8) acc[ai][bj][m][n] = __builtin_amdgcn_mfma_scale_f32_16x16x128_f8f6f4(PG8_V8(Bt[n]), PG8_V8(At[m]), acc[ai][bj][m][n], 0, 0, 0, 0x7f7f7f7f, 0, 0x7f7f7f7f); \
        else { _Pragma("unroll") for (int k = 0; k < 2; ++k) acc[ai][bj][m][n] = __builtin_amdgcn_mfma_f32_16x16x32_bf16(__builtin_bit_cast(bf16x8, Bt[n][k]), __builtin_bit_cast(bf16x8, At[m][k]), acc[ai][bj][m][n], 0, 0, 0); } } \
        __builtin_amdgcn_s_setprio(0); } while (0)
#define PG8_WAIT_V(n) asm volatile("s_waitcnt vmcnt(" #n ")" ::: "memory")
#define PG8_WAIT_VN(pe) do { if constexpr (Epi::NSTORES >= 16) asm volatile("s_cmp_lg_u32 %0, 0\n\ts_cbranch_scc1 1f\n\ts_waitcnt vmcnt(8)\n1:\n\ts_waitcnt vmcnt(24)" :: "s"(__builtin_amdgcn_readfirstlane((int)(pe))) : "memory", "scc"); \
        else if constexpr (Epi::NSTORES >= 8) asm volatile("s_cmp_lg_u32 %0, 0\n\ts_cbranch_scc1 1f\n\ts_waitcnt vmcnt(8)\n1:\n\ts_waitcnt vmcnt(16)" :: "s"(__builtin_amdgcn_readfirstlane((int)(pe))) : "memory", "scc"); \
        else asm volatile("s_waitcnt vmcnt(8)" ::: "memory"); } while (0)
#define PG8_WAIT_L(n) asm volatile("s_waitcnt lgkmcnt(" #n ")" ::: "memory")
#define PG8_BAR __builtin_amdgcn_s_barrier()
#define PG8_SCHED __builtin_amdgcn_sched_barrier(0)
#define PG8_GATHER_OFFS(dst, unit) do { _Pragma("unroll") for (int _h = 0; _h < 2; ++_h) _Pragma("unroll") for (int _i = 0; _i < 2; ++_i) \
        dst[_h][_i] = (unsigned)((GATHER == 1 ? rowidx[(unit).pm * BM + _h * HALF + Rr[_i]] : (unit).pm * BM + _h * HALF + Rr[_i]) * KB + 2 * Cc[_i]); } while (0)
#define PG8_GATHER_OFFS_LDS(dst, unit) do { _Pragma("unroll") for (int _h = 0; _h < 2; ++_h) _Pragma("unroll") for (int _i = 0; _i < 2; ++_i) \
        dst[_h][_i] = (unsigned)((GATHER == 1 ? IDX[_h * HALF + Rr[_i]] : (unit).pm * BM + _h * HALF + Rr[_i]) * KB + 2 * Cc[_i]); } while (0)
    LAS int* const IDX = (LAS int*)(lds + STAGE_BYTES + 1024);
    LAS float* const EC = (LAS float*)(lds + STAGE_BYTES + 2048) + wid * 64;
    Unit cur, nxt; int ui = 0;
    if (!S.next(0, cur)) return;
    f32x4 acc[2][2][4][2];
#pragma unroll
    for (int a = 0; a < 2; ++a)
#pragma unroll
        for (int b = 0; b < 2; ++b)
#pragma unroll
            for (int m = 0; m < 4; ++m)
#pragma unroll
                for (int n = 0; n < 2; ++n) acc[a][b][m][n] = (f32x4){0.f, 0.f, 0.f, 0.f};
    i32x4 At[4][2], B0[2][2], B1[2][2];
    const __amdgpu_buffer_rsrc_t rA = __builtin_amdgcn_make_buffer_rsrc((void*)(GATHER ? gatherA : Abase), 0, 0x7fffffff, 0x00020000);
    const __amdgpu_buffer_rsrc_t rB = __builtin_amdgcn_make_buffer_rsrc((void*)Bbase, 0, 0x7fffffff, 0x00020000);
    unsigned cA = GATHER ? 0u : cur.a, cB = cur.b;
    if constexpr (GATHER) { PG8_GATHER_OFFS(vA, cur); }
    if constexpr (EpiHasPre<Epi>::value) E.pre(cur, EC, wc, lane);
    PG8_STAGE(PG8_SB(0, 0), rB, cB, voffB); PG8_STAGE(PG8_SB(0, 1), rB, cB + hstepB, voffB); PG8_STAGE(PG8_SA(0, 0), rA, cA, vA[0]); PG8_STAGE(PG8_SA(0, 1), rA, cA, vA[1]);
    if (wr == 1) PG8_BAR;
    PG8_WAIT_V(2); PG8_BAR;
    PG8_STAGE(PG8_SB(1, 0), rB, cB + kstep, voffB); PG8_STAGE(PG8_SA(1, 0), rA, cA + kstep, vA[0]); PG8_STAGE(PG8_SB(1, 1), rB, cB + hstepB + kstep, voffB);
    PG8_WAIT_V(6); PG8_BAR;
    for (;;) {
        const bool has_next = S.next(ui + 1, nxt);
        const unsigned nA = GATHER ? 0u : (has_next ? nxt.a : cA), nB = has_next ? nxt.b : cB;
        if constexpr (GATHER == 1) { if (has_next && wid < 4) glds4(rowidx + nxt.pm * BM + 64 * wid + lane, IDX + 64 * wid); }
#pragma nounroll
        for (int t = 0; t < nt; t += 2) {
            const bool last = (t == nt - 2);
            const unsigned a1 = cA + (unsigned)(t + 1) * kstep;
            const unsigned a2 = last ? nA : cA + (unsigned)(t + 2) * kstep, b2 = last ? nB : cB + (unsigned)(t + 2) * kstep;
            const unsigned a3 = a2 + kstep, b3 = b2 + kstep;
            if constexpr (EpiHasMid<Epi>::value) { if (t == nt / 2) E.mid(acc, cur, wr, wc, fr, fq); }
            unsigned vN[2][2];
            if constexpr (GATHER) { if (last && has_next) { PG8_GATHER_OFFS_LDS(vN, nxt); } }
            const bool post_epi = (t == 0) && (ui > 0);
            PG8_LDB(B0, 0, 0); PG8_LDB(B1, 0, 1); PG8_SCHED; PG8_LDA(At, 0, 0); PG8_STAGE(PG8_SA(1, 1), rA, a1, vA[1]);
            if constexpr (GATHER) { if (last && has_next) {
#pragma unroll
                for (int _h = 0; _h < 2; ++_h)
#pragma unroll
                    for (int _i = 0; _i < 2; ++_i) vA[_h][_i] = vN[_h][_i]; } }
            PG8_WAIT_VN(post_epi);
            PG8_WAIT_L(0); PG8_BAR; PG8_MMA(0, 0, At, B0); PG8_MMA(0, 1, At, B1); PG8_BAR; PG8_SCHED;
            PG8_LDA(At, 0, 1); PG8_STAGE(PG8_SB(0, 0), rB, b2, voffB); PG8_STAGE(PG8_SB(0, 1), rB, b2 + hstepB, voffB); PG8_STAGE(PG8_SA(0, 0), rA, a2, vA[0]);
            PG8_WAIT_VN(post_epi);
            PG8_WAIT_L(0); PG8_BAR; PG8_MMA(1, 0, At, B0); PG8_MMA(1, 1, At, B1); PG8_BAR; PG8_SCHED;
            PG8_LDB(B0, 1, 0); PG8_LDB(B1, 1, 1); PG8_SCHED; PG8_LDA(At, 1, 0); PG8_STAGE(PG8_SA(0, 1), rA, a2, vA[1]);
            PG8_WAIT_V(8); PG8_WAIT_L(0); PG8_BAR; PG8_MMA(0, 0, At, B0); PG8_MMA(0, 1, At, B1); PG8_BAR; PG8_SCHED;
            PG8_LDA(At, 1, 1); PG8_STAGE(PG8_SB(1, 0), rB, b3, voffB); PG8_STAGE(PG8_SB(1, 1), rB, b3 + hstepB, voffB); PG8_STAGE(PG8_SA(1, 0), rA, a3, vA[0]);
            PG8_WAIT_V(8); PG8_WAIT_L(0); PG8_BAR; PG8_MMA(1, 0, At, B0); PG8_MMA(1, 1, At, B1); PG8_BAR; PG8_SCHED;
        }
        if constexpr (ALIGN_EPI) { if (wr == 0) PG8_BAR; }
        if constexpr (EpiHasPre<Epi>::value) E(acc, cur, wr, wc, fr, fq, EC); else E(acc, cur, wr, wc, fr, fq);
        if (!has_next) break;
#pragma unroll
        for (int a = 0; a < 2; ++a)
#pragma unroll
            for (int b = 0; b < 2; ++b)
#pragma unroll
                for (int m = 0; m < 4; ++m)
#pragma unroll
                    for (int n = 0; n < 2; ++n) acc[a][b][m][n] = (f32x4){0.f, 0.f, 0.f, 0.f};
        cur = nxt; cA = nA; cB = nB; ++ui;
        if constexpr (EpiHasPre<Epi>::value) E.pre(cur, EC, wc, lane);
        if constexpr (ALIGN_EPI) { if (wr == 1) PG8_BAR; }
    }
    PG8_WAIT_V(0);
    if constexpr (!ALIGN_EPI) { if (wr == 0) PG8_BAR; }
    PG8_BAR;
#undef PG8_SA
#undef PG8_SB
#undef PG8_STAGE
#undef PG8_LDA
#undef PG8_LDB
#undef PG8_MMA
#undef PG8_V8
#undef PG8_WAIT_V
#undef PG8_WAIT_VN
#undef PG8_WAIT_L
#undef PG8_BAR
#undef PG8_SCHED
#undef PG8_GATHER_OFFS
#undef PG8_GATHER_OFFS_LDS
}

struct DenseOrder {
    int nM, nN, nwg, G, c, lo, hi; const char* A; const char* B; size_t tA, tB;
    __device__ void init(int M, int N, int KB, int G_, int c_, const void* A_, const void* B_) { nM = M / BM; nN = N / BM; nwg = nM * nN; G = G_; c = c_; lo = 0; hi = 1 << 20; A = (const char*)A_; B = (const char*)B_; tA = (size_t)BM * KB; tB = tA; }
    __device__ bool next(int i, Unit& u) const {
        if (i + lo >= hi) return false;
        const long L = (long)(i + lo) * G + c; if (L >= nwg) return false;
        int wgid = (int)L; { const int q = nwg / 8, r = nwg % 8, xcd = wgid % 8, off = wgid / 8; wgid = (xcd < r ? xcd * (q + 1) : r * (q + 1) + (xcd - r) * q) + off; }
        const int nig = 8 * nN, gid = wgid / nig, fm = gid * 8, gsz = (nM - fm) < 8 ? (nM - fm) : 8;
        u.pm = fm + ((wgid % nig) % gsz); u.pn = (wgid % nig) / gsz; u.e = 0; u.a = (unsigned)((size_t)u.pm * tA); u.b = (unsigned)((size_t)u.pn * tB); return true;
    }
};
struct InprojOrder {
    int G, c; const char* A; const char* B; size_t tA, tB;
    __device__ bool next(int i, Unit& u) const {
        const int L = i * G + c; constexpr int NLAT = 128 * NT_LAT, NCTX = 16 * 14;
        if (L < NLAT) { const int xcd = L % 8, off = L / 8; const int wgid = xcd * (NLAT / 8) + off; constexpr int nig = 8 * NT_LAT; const int gid = wgid / nig;
            u.pm = 16 + gid * 8 + ((wgid % nig) % 8); u.pn = (wgid % nig) / 8; }
        else if (L < NLAT + NCTX) { const int idx = L - NLAT; u.pm = idx / 14; u.pn = idx % 14; }
        else return false;
        u.e = 0; u.a = (unsigned)((size_t)u.pm * tA); u.b = (unsigned)((size_t)u.pn * tB); return true;
    }
};
struct MoeOrder {
    int nt, NPN, G, c; const int* tile_e; const char* B; size_t eB, tB; const char* A0; const char* A1; size_t tA;
    __device__ bool next(int i, Unit& u) const {
        const int nx = (G % 8 == 0) ? 8 : 1, per = G / nx, x = c % nx, j = c / nx;
        const int q = (nt + nx - 1) / nx, s = i * per + j, grp = 4 * NPN;
        const int rl = (s / grp) * 4 + (s & 3), pn = (s % grp) >> 2;
        if (rl >= q) return false;
        const int rt = x * q + rl; if (rt >= nt) return false;
        const int e = __builtin_amdgcn_readfirstlane(tile_e[rt]);
        u.pm = rt; u.pn = pn; u.e = e; u.b = (unsigned)((size_t)e * eB + (size_t)pn * tB); u.a = 0u; return true;
    }
};

#define EPI_LOOP_BEGIN \
    int rb_ = wr * 64 + fr; asm volatile("" : "+v"(rb_));     \
    _Pragma("unroll") for (int ai = 0; ai < 2; ++ai) _Pragma("unroll") for (int m = 0; m < 4; ++m) { const int row = u.pm * BM + ai * HALF + m * 16 + rb_; \
    _Pragma("unroll") for (int bj = 0; bj < 2; ++bj) { const int col = u.pn * BM + bj * HALF + wc * 32 + 8 * fq; f32x4 v0 = acc[ai][bj][m][0], v1 = acc[ai][bj][m][1];
#define EPI_LOOP_END } }
__device__ __forceinline__ u32x4 pack8(f32x4 v0, f32x4 v1) { u32x4 w; w.x = cvt_pk_bf16(v0[0], v0[1]); w.y = cvt_pk_bf16(v0[2], v0[3]); w.z = cvt_pk_bf16(v1[0], v1[1]); w.w = cvt_pk_bf16(v1[2], v1[3]); return w; }
__device__ __forceinline__ void unpack8(u32x4 w, f32x4& a, f32x4& b) { a = (f32x4){bflo(w.x), bfhi(w.x), bflo(w.y), bfhi(w.y)}; b = (f32x4){bflo(w.z), bfhi(w.z), bflo(w.w), bfhi(w.w)}; }

__device__ __forceinline__ float logsigmoidf_(float x) { return fminf(x, 0.f) - __logf(1.f + __expf(-fabsf(x))); }
__device__ __forceinline__ u32x2 pack4(f32x4 v) { u32x2 w; w.x = cvt_pk_bf16(v[0], v[1]); w.y = cvt_pk_bf16(v[2], v[3]); return w; }
struct EpiInproj {
    static constexpr bool PRE = true; static constexpr int NSTORES = 8;
    bf16* Z; unsigned char* WS; float* EL; const float* gkb; const float* hlb; int rowoff_tiles, tileoff; float scale;
    __device__ __forceinline__ void pre(const Unit& uu, LAS float* ec, int wc, int lane) const {
        const int t = uu.pn + tileoff, c = lane & 15, sd = lane >> 4;
        if (t < 8) glds4(hlb + (sd >> 1) * 1024 + (sd & 1) * 512 + (t >> 1) * 128 + (t & 1) * 64 + 16 * wc + c, ec);
        else if (t < 12) glds4(gkb + (sd & 1) * 256 + (t - 8) * 64 + 16 * wc + c, ec);
    }
    __device__ __forceinline__ void operator()(const f32x4 (&acc)[2][2][4][2], const Unit& uu, int wr, int wc, int fr, int fq, const LAS float* ec) const {
        const int pm = uu.pm + rowoff_tiles, t = uu.pn + tileoff;
        int fr_ = fr; asm volatile("" : "+v"(fr_));
        if (t < 14) {
#pragma unroll
            for (int ai = 0; ai < 2; ++ai) {
                const int cg = 4 * pm + 2 * ai + wr;
                const bool ctx = cg < TC / 64; const int b = ctx ? cg >> 2 : (cg - TC / 64) >> 5, mc = ctx ? cg & 3 : (cg - TC / 64) & 31, smem = ctx ? mc : 4 + mc;
                if (t < 12) {
                    const bool hg = t < 8; const int h = hg ? t >> 1 : t - 8, cc0 = 16 * wc + 4 * fq, chh = hg ? (t & 1) * 64 + cc0 : cc0, ch = (hg ? h * 128 : h * 64) + chh;
                    f32x4 c0[2];
#pragma unroll
                    for (int d = 0; d < 2; ++d) { if (hg) { const f32x4 a0 = *(const LAS f32x4*)(ec + 16 * d + 4 * fq), a1 = *(const LAS f32x4*)(ec + 32 + 16 * d + 4 * fq);
#pragma unroll
                            for (int j = 0; j < 4; ++j) c0[d][j] = __builtin_amdgcn_rcpf(1.f + __expf(a1[j] - a0[j])); }
                        else c0[d] = *(const LAS f32x4*)(ec + 16 * d + 4 * fq) * 1.44269504f; }
                    const int tsz = hg ? 16384 : 8192, wbase = ((hg ? (t & 1) * 4 : 0) + wc) * 2048 + 8 * (fq & 2) + 512 * (fq & 1);
                    unsigned char* const qkb = WS + (hg ? WS_RQA : WS_RQB);
#pragma unroll
                    for (int d = 0; d < 2; ++d) {
                        const int sd = d ? (ctx ? 3 - mc : 35 - mc) : smem, chain = (b * 4 + h) * 2 + d;
                        unsigned char* const tq = qkb + (size_t)((chain * NSTEP + sd) * 2) * tsz; unsigned char* const tk = tq + tsz;
                        const float id = hg ? 1.f : 0.f; f32x4 run = (f32x4){id, id, id, id};
                        u32x2 wq0 = (u32x2){0u, 0u}, wk0 = wq0;
#pragma unroll
                        for (int mm = 0; mm < 4; ++mm) { const int m = d ? 3 - mm : mm; f32x4 ky, e, ie;
                            if (hg) { const f32x4 z = acc[ai][d][m][1 - d] * (scale * -1.44269504f);
#pragma unroll
                                for (int j = 0; j < 4; ++j) { const float lb = c0[d][j], oml = 1.f - lb, s = __builtin_amdgcn_rcpf(1.f + __builtin_amdgcn_exp2f(z[j]));
                                    float v = __builtin_fmaf(oml, s, lb), tt = v; ky[j] = __builtin_fmaf(-oml, s, oml);
                                    if (d == 0) { v *= dpp_mov<0x111>(v, 1.f); v *= dpp_mov<0x112>(v, 1.f); v *= dpp_mov<0x114>(v, 1.f); v *= dpp_mov<0x118>(v, 1.f); }
                                    else        { v *= dpp_mov<0x101>(v, 1.f); v *= dpp_mov<0x102>(v, 1.f); v *= dpp_mov<0x104>(v, 1.f); v *= dpp_mov<0x108>(v, 1.f); }
                                    tt *= dpp_mov<0x128>(tt, 1.f); tt *= dpp_mov<0x124>(tt, 1.f); tt *= dpp_mov<0x122>(tt, 1.f); tt *= dpp_mov<0x121>(tt, 1.f);
                                    const float cm = run[j] * v; run[j] *= tt; e[j] = cm; ie[j] = __builtin_amdgcn_rcpf(cm); } }
                            else { const f32x4 x = acc[ai][1][m][d] * (scale * 1.44269504f); ky = acc[ai][0][m][1] * scale;
#pragma unroll
                                for (int j = 0; j < 4; ++j) { const float y2 = x[j] + c0[d][j];
                                    float v = (fminf(y2, 0.f) - __builtin_amdgcn_logf(1.f + __builtin_amdgcn_exp2f(-fabsf(y2)))) * 0.0625f, tt = v;
                                    if (d == 0) { v += dpp_mov<0x111>(v, 0.f); v += dpp_mov<0x112>(v, 0.f); v += dpp_mov<0x114>(v, 0.f); v += dpp_mov<0x118>(v, 0.f); }
                                    else        { v += dpp_mov<0x101>(v, 0.f); v += dpp_mov<0x102>(v, 0.f); v += dpp_mov<0x104>(v, 0.f); v += dpp_mov<0x108>(v, 0.f); }
                                    tt += dpp_mov<0x128>(tt, 0.f); tt += dpp_mov<0x124>(tt, 0.f); tt += dpp_mov<0x122>(tt, 0.f); tt += dpp_mov<0x121>(tt, 0.f);
                                    const float cm = run[j] + v; run[j] += tt; e[j] = __builtin_amdgcn_exp2f(cm); ie[j] = __builtin_amdgcn_exp2f(-cm); } }
                            u32x2 wq = (u32x2){0u, 0u}; const u32x2 wk = pack4(ky * ie);
                            if (!ctx) wq = pack4(acc[ai][0][m][0] * (hg ? scale : scale * 0.125f) * e);
                            if ((mm & 1) == 0) { wq0 = wq; wk0 = wk; }
                            else { const int roff = (16 * (mm - 1) + (d ? 15 - fr_ : fr_)) * 32;
                                if (!ctx) { const auto sx = __builtin_amdgcn_permlane16_swap(wq0.x, wq.x, false, false), sy = __builtin_amdgcn_permlane16_swap(wq0.y, wq.y, false, false);
                                    *(u32x4*)(tq + wbase + roff) = (u32x4){sx[0], sy[0], sx[1], sy[1]}; }
                                const auto sx = __builtin_amdgcn_permlane16_swap(wk0.x, wk.x, false, false), sy = __builtin_amdgcn_permlane16_swap(wk0.y, wk.y, false, false);
                                *(u32x4*)(tk + wbase + roff) = (u32x4){sx[0], sy[0], sx[1], sy[1]}; } }
                        if (fr == 0) { f32x4 el;
#pragma unroll
                            for (int j = 0; j < 4; ++j) el[j] = hg ? run[j] : __builtin_amdgcn_exp2f(run[j]);
                            *(f32x4*)(EL + ((size_t)d * NCG + cg) * 768 + (hg ? 0 : 512) + ch) = el; }
                    }
                    if (hg) { unsigned char* const tv = WS + WS_RVA + (size_t)((b * 4 + h) * NSTEP + smem) * 16384;
#pragma unroll
                        for (int m = 0; m < 4; m += 2) { const u32x2 w0 = pack4(acc[ai][1][m][1] * scale), w1 = pack4(acc[ai][1][m + 1][1] * scale);
                            const auto sx = __builtin_amdgcn_permlane16_swap(w0.x, w1.x, false, false), sy = __builtin_amdgcn_permlane16_swap(w0.y, w1.y, false, false);
                            *(u32x4*)(tv + wbase + (16 * m + fr_) * 32) = (u32x4){sx[0], sy[0], sx[1], sy[1]}; } }
                } else {
#pragma unroll
                    for (int bj = 0; bj < 2; ++bj) { const int col = 256 * (t - 12) + (tileoff ? 64 * wc + 16 * fq + 8 * bj : 128 * bj + 32 * wc + 8 * fq), hv = col >> 7, c = col & 127;
                        unsigned char* const tv = WS + WS_RVB + (size_t)((b * 4 + hv) * NSTEP + smem) * 16384;
#pragma unroll
                        for (int m = 0; m < 4; ++m) *(u32x4*)(tv + (16 * m + fr_) * 256 + 2 * c) = pack8(acc[ai][bj][m][0] * scale, acc[ai][bj][m][1] * scale); }
                }
            }
        } else {
            static_assert(kInFp8, "the gate tiles run in the fp8 pass");
            unsigned char* const zb = (unsigned char*)Z + (size_t)(pm * BM - TC) * (NZ * 2);
            int rb_ = wr * 64 + fr_;
            const int cl = wc * 64 + fq * 16;
            if (t < 18) {
                const int cb = ((t - 14) >> 1) * 512 + ((t - 14) & 1) * 256 + cl;
#pragma unroll
                for (int ai = 0; ai < 2; ++ai)
#pragma unroll
                    for (int m = 0; m < 4; ++m) { unsigned w[4];
#pragma unroll
                        for (int bj = 0; bj < 2; ++bj)
#pragma unroll
                            for (int n = 0; n < 2; ++n) { const f32x4 x = acc[ai][bj][m][n] * scale; f32x4 s;
#pragma unroll
                                for (int j = 0; j < 4; ++j) s[j] = x[j] * __builtin_amdgcn_rcpf(1.f + __builtin_amdgcn_exp2f(x[j] * -1.44269504f));
                                w[2 * bj + n] = pk4_fp8(s[0], s[1], s[2], s[3]); }
                        *(u32x4*)(zb + (size_t)(ai * HALF + m * 16 + rb_) * (NZ * 2) + cb) = (u32x4){w[0], w[1], w[2], w[3]}; }
            } else {
                const int cg = 2048 + (t - 18) * 256 + cl;
#pragma unroll
                for (int ai = 0; ai < 2; ++ai)
#pragma unroll
                    for (int m = 0; m < 4; ++m) { unsigned w[4];
#pragma unroll
                        for (int bj = 0; bj < 2; ++bj)
#pragma unroll
                            for (int n = 0; n < 2; ++n) { const f32x4 x = acc[ai][bj][m][n] * (scale * -1.44269504f); unsigned pk = 0u;
#pragma unroll
                                for (int j = 0; j < 4; ++j) { const float c = fmaxf(255.f * __builtin_amdgcn_rcpf(1.f + __builtin_amdgcn_exp2f(x[j])), 1.f);
                                    pk = j == 0 ? __builtin_amdgcn_cvt_pk_u8_f32(c, 0, pk) : j == 1 ? __builtin_amdgcn_cvt_pk_u8_f32(c, 1, pk) : j == 2 ? __builtin_amdgcn_cvt_pk_u8_f32(c, 2, pk) : __builtin_amdgcn_cvt_pk_u8_f32(c, 3, pk); }
                                w[2 * bj + n] = pk; }
                        *(u32x4*)(zb + (size_t)(ai * HALF + m * 16 + rb_) * (NZ * 2) + cg) = (u32x4){w[0], w[1], w[2], w[3]}; }
            }
        }
    }
};
__device__ __forceinline__ f32x4 u8x4_f32(unsigned w) { return (f32x4){(float)(w & 255u), (float)((w >> 8) & 255u), (float)((w >> 16) & 255u), (float)(w >> 24)}; }
struct EpiMerge {
    static constexpr bool MID = true; static constexpr int NSTORES = 16;
    const bf16* Zlat; bf16* out;
    __device__ __forceinline__ void mid(f32x4 (&acc)[2][2][4][2], const Unit& u, int wr, int wc, int fr, int fq) const {
        int rb_ = wr * 64 + fr; asm volatile("" : "+v"(rb_));
#pragma unroll
        for (int ai = 0; ai < 2; ++ai) {
            u32x2 aw[4][2], bw[4][2];
#pragma unroll
            for (int m = 0; m < 4; ++m) { const int row = u.pm * BM + ai * HALF + m * 16 + rb_; const unsigned char* zg = (const unsigned char*)Zlat + (size_t)row * (NZ * 2) + 2048;
#pragma unroll
                for (int bj = 0; bj < 2; ++bj) { const int col = u.pn * BM + bj * HALF + wc * 32 + 8 * fq; aw[m][bj] = *(const u32x2*)(zg + col); bw[m][bj] = *(const u32x2*)(zg + 1024 + col); } }
            asm volatile("" :: "v"(bw[3][1]));
            __builtin_amdgcn_sched_barrier(0);
#pragma unroll
            for (int m = 0; m < 4; ++m)
#pragma unroll
                for (int bj = 0; bj < 2; ++bj) { const f32x4 a0 = u8x4_f32(aw[m][bj].x), a1 = u8x4_f32(aw[m][bj].y), b0 = u8x4_f32(bw[m][bj].x), b1 = u8x4_f32(bw[m][bj].y);
#pragma unroll
                    for (int j = 0; j < 4; ++j) { acc[ai][bj][m][0][j] *= a0[j] * __builtin_amdgcn_rcpf(b0[j]); acc[ai][bj][m][1][j] *= a1[j] * __builtin_amdgcn_rcpf(b1[j]); } }
        }
    }
    __device__ __forceinline__ void operator()(const f32x4 (&acc)[2][2][4][2], const Unit& u, int wr, int wc, int fr, int fq) const {
        int rb_ = wr * 64 + fr; asm volatile("" : "+v"(rb_));
#pragma unroll
        for (int ai = 0; ai < 2; ++ai) {
            u32x2 gw[4][2];
#pragma unroll
            for (int m = 0; m < 4; ++m) { const int row = u.pm * BM + ai * HALF + m * 16 + rb_;
#pragma unroll
                for (int bj = 0; bj < 2; ++bj) { const int col = u.pn * BM + bj * HALF + wc * 32 + 8 * fq; gw[m][bj] = *(const u32x2*)((const unsigned char*)Zlat + (size_t)row * (NZ * 2) + 3072 + col); } }
            asm volatile("" :: "v"(gw[3][1]));
            __builtin_amdgcn_sched_barrier(0);
#pragma unroll
            for (int m = 0; m < 4; ++m) { const int row = u.pm * BM + ai * HALF + m * 16 + rb_;
#pragma unroll
                for (int bj = 0; bj < 2; ++bj) { const int col = u.pn * BM + bj * HALF + wc * 32 + 8 * fq;
                    const f32x4 v0 = acc[ai][bj][m][0] * (u8x4_f32(gw[m][bj].x) * (1.f / 255.f)), v1 = acc[ai][bj][m][1] * (u8x4_f32(gw[m][bj].y) * (1.f / 255.f));
                    *(u32x4*)(out + (size_t)row * D + col) = pack8(v0, v1); } }
        }
    }
};
template <bool F8> __device__ __forceinline__ void store8(void* base, size_t idx, f32x4 v0, f32x4 v1) {
    if constexpr (F8) { u32x2 w; w.x = pk4_fp8(v0[0], v0[1], v0[2], v0[3]); w.y = pk4_fp8(v1[0], v1[1], v1[2], v1[3]); *(u32x2*)((unsigned char*)base + idx) = w; }
    else *(u32x4*)((bf16*)base + idx) = pack8(v0, v1);
}
template <bool F8> struct EpiStore {
    static constexpr int NSTORES = 16;
    void* out; int ldc; float scale;
    __device__ __forceinline__ void operator()(const f32x4 (&acc)[2][2][4][2], const Unit& u, int wr, int wc, int fr, int fq) const {
        EPI_LOOP_BEGIN
            store8<F8>(out, (size_t)row * ldc + col, v0 * scale, v1 * scale);
        EPI_LOOP_END
    }
};
struct EpiGateUp {
    static constexpr bool PRE = true; static constexpr int NSTORES = 8;
    bf16* H0; bf16* H1; const float* bg; const float* bu;
    __device__ __forceinline__ void pre(const Unit& u, LAS float* ec, int wc, int lane) const {
        glds4((lane < 32 ? bg : bu) + (size_t)u.e * FF + u.pn * HALF + wc * 32 + (lane & 31), ec); }
    __device__ __forceinline__ void operator()(const f32x4 (&acc)[2][2][4][2], const Unit& u, int wr, int wc, int fr, int fq, const LAS float* ec) const {
        const int ocol = u.pn * HALF + wc * 32 + 8 * fq;
        const f32x4 bg0 = *(const LAS f32x4*)(ec + 8 * fq), bg1 = *(const LAS f32x4*)(ec + 8 * fq + 4), bu0 = *(const LAS f32x4*)(ec + 32 + 8 * fq), bu1 = *(const LAS f32x4*)(ec + 32 + 8 * fq + 4);
        int rb_ = wr * 64 + fr; asm volatile("" : "+v"(rb_));
#pragma unroll
        for (int ai = 0; ai < 2; ++ai)
#pragma unroll
            for (int m = 0; m < 4; ++m) { const int row = u.pm * BM + ai * HALF + m * 16 + rb_;
                constexpr float ws = 1.f / MOE_WSCALE;
                f32x4 g0 = acc[ai][0][m][0] * ws + bg0, g1 = acc[ai][0][m][1] * ws + bg1, u0 = acc[ai][1][m][0] * ws + bu0, u1 = acc[ai][1][m][1] * ws + bu1, o0, o1;
#pragma unroll
                for (int j = 0; j < 4; ++j) { g0[j] = fminf(g0[j], 7.f); g1[j] = fminf(g1[j], 7.f); u0[j] = fminf(fmaxf(u0[j], -7.f), 7.f); u1[j] = fminf(fmaxf(u1[j], -7.f), 7.f); }
                f32x4 e0 = g0 * (-1.702f * 1.44269504f), e1 = g1 * (-1.702f * 1.44269504f);
#pragma unroll
                for (int j = 0; j < 4; ++j) { e0[j] = __builtin_amdgcn_exp2f(e0[j]); e1[j] = __builtin_amdgcn_exp2f(e1[j]); }
                e0 = e0 + 1.f; e1 = e1 + 1.f;
#pragma unroll
                for (int j = 0; j < 4; ++j) { e0[j] = __builtin_amdgcn_rcpf(e0[j]); e1[j] = __builtin_amdgcn_rcpf(e1[j]); }
                o0 = (g0 * e0) * (u0 + 1.f); o1 = (g1 * e1) * (u1 + 1.f);
                if constexpr (kMoeFp8) { unsigned char* hp = (row < H_SPLIT_TILES * BM) ? (unsigned char*)H0 + (size_t)row * FF : (unsigned char*)H1 + (size_t)(row - H_SPLIT_TILES * BM) * FF;
                    u32x2 w; w.x = pk4_fp8(o0[0], o0[1], o0[2], o0[3]); w.y = pk4_fp8(o1[0], o1[1], o1[2], o1[3]); *(u32x2*)(hp + ocol) = w; }
                else { bf16* hp = (row < H_SPLIT_TILES * BM) ? H0 + (size_t)row * FF : H1 + (size_t)(row - H_SPLIT_TILES * BM) * FF;
                    *(u32x4*)(hp + ocol) = pack8(o0, o1); } }
    }
};
struct EpiDown {
    static constexpr bool PRE = true; static constexpr int NSTORES = 8;
    bf16* Y; const float* bd;
    __device__ __forceinline__ void pre(const Unit& u, LAS float* ec, int wc, int lane) const {
        glds4(bd + (size_t)u.e * D + u.pn * BM + wc * 64 + lane, ec); }
    __device__ __forceinline__ void operator()(const f32x4 (&acc)[2][2][4][2], const Unit& u, int wr, int wc, int fr, int fq, const LAS float* ec) const {
        static_assert(kActFp8, "Y rows are fp8");
        f32x4 b0[2], b1[2];
#pragma unroll
        for (int bj = 0; bj < 2; ++bj) { b0[bj] = *(const LAS f32x4*)(ec + 16 * fq + 8 * bj); b1[bj] = *(const LAS f32x4*)(ec + 16 * fq + 8 * bj + 4); }
        int rb_ = wr * 64 + fr; asm volatile("" : "+v"(rb_));
        unsigned char* const yb = (unsigned char*)Y + u.pn * BM + wc * 64 + 16 * fq;
#pragma unroll
        for (int ai = 0; ai < 2; ++ai)
#pragma unroll
            for (int m = 0; m < 4; ++m) { const int row = u.pm * BM + ai * HALF + m * 16 + rb_; u32x4 o;
                { const f32x4 v0 = acc[ai][0][m][0] * (1.f / MOE_WSCALE) + b0[0], v1 = acc[ai][0][m][1] * (1.f / MOE_WSCALE) + b1[0]; o.x = pk4_fp8(v0[0], v0[1], v0[2], v0[3]); o.y = pk4_fp8(v1[0], v1[1], v1[2], v1[3]); }
                { const f32x4 v0 = acc[ai][1][m][0] * (1.f / MOE_WSCALE) + b0[1], v1 = acc[ai][1][m][1] * (1.f / MOE_WSCALE) + b1[1]; o.z = pk4_fp8(v0[0], v0[1], v0[2], v0[3]); o.w = pk4_fp8(v1[0], v1[1], v1[2], v1[3]); }
                *(u32x4*)(yb + (size_t)row * D) = o; }
    }
};
}

constexpr int RING_BYTES = 131072;
constexpr int LDSCTL_OFF = RING_BYTES;
constexpr int LDS_BYTES = 163840;
constexpr int MISC_OFF = LDS_BYTES - 128;

#define XB_TMO      128
#define XB_XCNT(j)  (256  + 64 * (j))
#define XB_XSUB(j)  (1280 + 64 * (j))
#define XB_XGEN(j)  (2304 + 64 * (j))
#define XB_TOP      3328
#define XB_TOPGEN   3392
#define XCD_BAR_WORDS 3456
#define XB_SPIN_CAP (1u << 22)
__device__ __forceinline__ unsigned xb_ld(unsigned* p)              { return __hip_atomic_load(p, __ATOMIC_RELAXED, __HIP_MEMORY_SCOPE_AGENT); }
__device__ __forceinline__ unsigned xb_add(unsigned* p, unsigned v) { return __hip_atomic_fetch_add(p, v, __ATOMIC_RELAXED, __HIP_MEMORY_SCOPE_AGENT); }
__device__ __forceinline__ unsigned xb_xcc_id() { return (unsigned)__builtin_amdgcn_s_getreg((3 << 11) | 20) & 0xFu; }
#define XB_SPIN(cond, bar) do { unsigned _sp = 0; while (cond) { __builtin_amdgcn_s_sleep(1); \
    if ((++_sp & 255u) == 0u) { if (xb_ld(&(bar)[XB_TMO])) break; if (_sp > XB_SPIN_CAP) { atomicAdd(&(bar)[XB_TMO], 1u); break; } } } } while (0)
struct XcdBarrier { unsigned* bar; unsigned x; volatile LAS unsigned* st; unsigned expect; };
__device__ __forceinline__ XcdBarrier xcd_barrier_post(unsigned* bar, volatile LAS unsigned* st, unsigned expect) {
    XcdBarrier b; b.bar = bar; b.x = xb_xcc_id(); b.st = st; b.expect = expect;
    if (threadIdx.x == 0) (void)xb_add(&bar[XB_XCNT(b.x)], 1u);
    return b;
}
__device__ __forceinline__ void xcd_barrier_complete(unsigned* bar, unsigned x, unsigned& nloc, unsigned& nx, unsigned G) {
    unsigned sum, cnt, mine, sp = 0u;
    for (;;) {
        sum = 0u; cnt = 0u; mine = 0u;
#pragma unroll
        for (unsigned j = 0; j < 16; ++j) { const unsigned c = xb_ld(&bar[XB_XCNT(j)]); sum += c; cnt += (c > 0u) ? 1u : 0u; mine = (j == x) ? c : mine; }
        if (sum == G) break;
        __builtin_amdgcn_s_sleep(1);
        if ((++sp & 255u) == 0u) { if (xb_ld(&bar[XB_TMO])) break; if (sp > XB_SPIN_CAP) { atomicAdd(&bar[XB_TMO], 1u); break; } }
    }
    nloc = mine > 0u ? mine : 1u; nx = cnt > 0u ? cnt : 1u;
}
__device__ __forceinline__ void xcd_barrier(const XcdBarrier& b) {
    asm volatile("s_waitcnt vmcnt(0)" ::: "memory");
    __syncthreads();
    if (threadIdx.x == 0) {
        unsigned* bar = b.bar;
        __builtin_amdgcn_s_waitcnt(0);
        unsigned nloc = b.st[0], nx = b.st[1];
        if (nloc == 0u) { xcd_barrier_complete(bar, b.x, nloc, nx, b.expect); b.st[0] = nloc; b.st[1] = nx; }
        const unsigned old = xb_add(&bar[XB_XSUB(b.x)], 1u);
        const unsigned gen = old / nloc;
        if (old + 1u == (gen + 1u) * nloc) {
            __builtin_amdgcn_fence(__ATOMIC_RELEASE, "agent");
            asm volatile("s_waitcnt vmcnt(0)" ::: "memory");
            const unsigned og = xb_add(&bar[XB_TOP], 1u);
            const unsigned tg = og / nx;
            if (og + 1u == (tg + 1u) * nx) { xb_add(&bar[XB_TOPGEN], 1u); __builtin_amdgcn_fence(__ATOMIC_ACQUIRE, "agent"); }
            else { __builtin_amdgcn_fence(__ATOMIC_ACQUIRE, "agent"); XB_SPIN(xb_ld(&bar[XB_TOPGEN]) == tg, bar); }
            asm volatile("s_waitcnt vmcnt(0)" ::: "memory");
        } else {
            __builtin_amdgcn_fence(__ATOMIC_ACQUIRE, "agent");
            XB_SPIN(xb_ld(&bar[XB_TOPGEN]) == gen, bar);
            asm volatile("s_waitcnt vmcnt(0)" ::: "memory");
        }
    }
    __syncthreads();
}

struct Args { const float* in[27]; float* out; unsigned char* ws; int ph_lo, ph_hi; };
enum { I_X = 0, I_C, I_CTX, I_CCTX, I_WADA, I_BADA, I_GPREMIX, I_GPOSTMIX, I_GPREFFN, I_GPOSTFFN, I_WIN, I_HLB, I_HNW, I_GKW2, I_GKB, I_GNW, I_WUPA, I_WUPB, I_WO, I_WR, I_BR, I_WG, I_BG, I_WU, I_BU, I_WDN, I_BDN };
struct Frame { LAS unsigned char* lds; int tid, lane, wave, vcu, G; const Args* a; };

__device__ __forceinline__ void transpose_item(const float* src, int ld, bf16* dst, int dpitch, LAS float* scr, int lane) {
    float tv[32];
#pragma unroll
    for (int i = 0; i < 32; ++i) tv[i] = __builtin_nontemporal_load(src + (size_t)(2 * i + (lane >> 5)) * ld + (lane & 31));
#pragma unroll
    for (int i = 0; i < 32; ++i) scr[(2 * i + (lane >> 5)) * 33 + (lane & 31)] = tv[i];
    LDS_WAIT(); asm volatile("" ::: "memory");
    const int c = lane & 7;
#pragma unroll
    for (int j = 0; j < 4; ++j) { const int n = (lane >> 3) + 8 * j; const LAS float* s = scr + (8 * c) * 33 + n;
        u32x4 o; o.x = pk2(s[0 * 33], s[1 * 33]); o.y = pk2(s[2 * 33], s[3 * 33]); o.z = pk2(s[4 * 33], s[5 * 33]); o.w = pk2(s[6 * 33], s[7 * 33]);
        *(u32x4*)(dst + (size_t)n * dpitch + 8 * c) = o; }
    LDS_WAIT(); asm volatile("" ::: "memory");
}

__device__ __forceinline__ void transpose_item_fp8(const float* src, int ld, unsigned char* dst, int dpitch, LAS float* scr, int lane, float sc) {
    float tv[32];
#pragma unroll
    for (int i = 0; i < 32; ++i) tv[i] = __builtin_nontemporal_load(src + (size_t)(2 * i + (lane >> 5)) * ld + (lane & 31));
#pragma unroll
    for (int i = 0; i < 32; ++i) scr[(2 * i + (lane >> 5)) * 33 + (lane & 31)] = tv[i];
    LDS_WAIT(); asm volatile("" ::: "memory");
    const int c = lane & 7;
#pragma unroll
    for (int j = 0; j < 4; ++j) { const int n = (lane >> 3) + 8 * j; const LAS float* s = scr + (8 * c) * 33 + n;
        u32x2 o; o.x = pk4_fp8(s[0 * 33] * sc, s[1 * 33] * sc, s[2 * 33] * sc, s[3 * 33] * sc); o.y = pk4_fp8(s[4 * 33] * sc, s[5 * 33] * sc, s[6 * 33] * sc, s[7 * 33] * sc);
        *(u32x2*)(dst + (size_t)n * dpitch + 8 * c) = o; }
    LDS_WAIT(); asm volatile("" ::: "memory");
}

__device__ __forceinline__ int inproj_src_col(int n) {
    const int t = n >> 8, rho = n & 255;
    if (t < 12) { const int a = 2 * (rho >> 7) + ((rho >> 2) & 1), cc = 16 * ((rho >> 5) & 3) + 4 * ((rho >> 3) & 3) + (rho & 3);
        if (t < 8) return a * 512 + (t >> 1) * 128 + (t & 1) * 64 + cc;
        const int h = t - 8; if (a == 0) return 2560 + h * 64 + cc; if (a == 1) return 2816 + h * 64 + cc; return -1 - ((a - 2) * 256 + h * 64 + cc); }
    if (t < 14) return 3072 + (n - 12 * 256);
    if (t < 16) return 2048 + (n - 14 * 256);
    return 3616 + (n - 16 * 256);
}
__device__ __forceinline__ void transpose_item_cols(const float* Wk, int ld, int col, bf16* dst, int dpitch, LAS float* scr, int lane) {
    float tv[32];
#pragma unroll
    for (int i = 0; i < 32; ++i) tv[i] = Wk[(size_t)(2 * i + (lane >> 5)) * ld + col];
#pragma unroll
    for (int i = 0; i < 32; ++i) scr[(2 * i + (lane >> 5)) * 33 + (lane & 31)] = tv[i];
    LDS_WAIT(); asm volatile("" ::: "memory");
    const int c = lane & 7;
#pragma unroll
    for (int j = 0; j < 4; ++j) { const int n = (lane >> 3) + 8 * j; const LAS float* s = scr + (8 * c) * 33 + n;
        u32x4 o; o.x = pk2(s[0 * 33], s[1 * 33]); o.y = pk2(s[2 * 33], s[3 * 33]); o.z = pk2(s[4 * 33], s[5 * 33]); o.w = pk2(s[6 * 33], s[7 * 33]);
        *(u32x4*)(dst + (size_t)n * dpitch + 8 * c) = o; }
    LDS_WAIT(); asm volatile("" ::: "memory");
}

__device__ __forceinline__ void p0_mod(const Frame& F, int item) {
    const Args& A = *F.a;
    LAS float* sc = (LAS float*)F.lds; LAS float* part = sc + 17 * 1024;
    const float* wp = A.in[I_WADA] + (size_t)(F.wave * 128) * 6144 + item * 64 + F.lane;
    float wv[32], wn[32];
#pragma unroll
    for (int i = 0; i < 32; ++i) wv[i] = wp[(size_t)i * 6144];
    for (int i = F.tid; i < 17 * 1024; i += NTHREADS) { const int r = i >> 10, k = i & 1023; const float v = (r < 16) ? A.in[I_C][r * 1024 + k] : A.in[I_CCTX][k]; sc[i] = v * sigmoidf_(v); }
    __syncthreads();
    const int k0 = F.wave * 128;
    float acc[17];
#pragma unroll
    for (int r = 0; r < 17; ++r) acc[r] = 0.f;
#pragma unroll
    for (int bq = 0; bq < 4; ++bq) {
        if (bq < 3) {
#pragma unroll
            for (int i = 0; i < 32; ++i) wn[i] = wp[(size_t)(32 * (bq + 1) + i) * 6144]; }
#pragma unroll
        for (int i4 = 0; i4 < 8; ++i4) { const int k = k0 + 32 * bq + 4 * i4;
#pragma unroll
            for (int r = 0; r < 17; ++r) { const f32x4 s = *(const LAS f32x4*)(sc + r * 1024 + k); acc[r] += s.x * wv[4 * i4] + s.y * wv[4 * i4 + 1] + s.z * wv[4 * i4 + 2] + s.w * wv[4 * i4 + 3]; } }
        if (bq < 3) {
#pragma unroll
            for (int i = 0; i < 32; ++i) wv[i] = wn[i]; }
    }
#pragma unroll
    for (int r = 0; r < 17; ++r) part[(F.wave * 17 + r) * 64 + F.lane] = acc[r];
    __syncthreads();
    float* mod = (float*)(A.ws + WS_MOD);
    for (int i = F.tid; i < 17 * 64; i += NTHREADS) { const int r = i >> 6, l = i & 63; float s = A.in[I_BADA][item * 64 + l];
#pragma unroll
        for (int w = 0; w < 8; ++w) s += part[(w * 17 + r) * 64 + l];
        mod[r * 6144 + item * 64 + l] = s; }
    __syncthreads();
}

__device__ __forceinline__ void p0_prologue(const Frame& F, bool skip_uo) {
    const Args& A = *F.a;
    const bool split = F.G >= 192;
    if (F.vcu < 96) { p0_mod(F, F.vcu); if (split) return; }
    LAS float* scr = (LAS float*)(F.lds + F.wave * 16384);
    const int wv = split ? F.vcu - 96 : F.vcu, nwg = split ? F.G - 96 : F.G;
    const int gw = wv * NWAVES + F.wave, NGW = nwg * NWAVES;
    bf16* win_t = (bf16*)(A.ws + WS_WIN);
    constexpr int NWB = 8 * (NT_HI + NT_LO); constexpr int I_WIN_ITEMS = 16 * NWB, I_WU = 8 * 32, I_WO_ITEMS = 16 * 32;
    for (int it = gw; it < (skip_uo ? I_WIN_ITEMS : I_WIN_ITEMS + 2 * I_WU + I_WO_ITEMS); it += NGW) {
        int r = it;
        if (r < I_WIN_ITEMS) { const int kb = r / NWB, nb = r % NWB, n0 = nb * 32;
            if (n0 < NT_HI * 256) { const int col = inproj_src_col(n0 + (F.lane & 31)); if (col < 0) continue;
                transpose_item_cols(A.in[I_WIN] + (size_t)(64 * kb) * IN_DIM, IN_DIM, col, win_t + (size_t)n0 * D + 64 * kb, D, scr, F.lane); }
            else { const int jl = n0 - NT_HI * 256; const float* sp = A.in[I_WIN] + (size_t)(64 * kb) * IN_DIM + (jl < 512 ? 3072 + jl : jl < 1024 ? 2048 + (jl - 512) : jl < 1536 ? 3616 + (jl - 1024) : 4128 + (jl - 1536));
                if constexpr (kInFp8) transpose_item_fp8(sp, IN_DIM, (unsigned char*)(A.ws + WS_WIN_LO) + (size_t)(n0 - NT_HI * 256) * D + 64 * kb, D, scr, F.lane, IN_WSCALE);
                else transpose_item(sp, IN_DIM, (bf16*)(A.ws + WS_WIN_LO) + (size_t)(n0 - NT_HI * 256) * D + 64 * kb, D, scr, F.lane); }
            continue; }
        r -= I_WIN_ITEMS;
        if (r < I_WU) { const int kb = r / 32, nb = r % 32; transpose_item(A.in[I_WUPA] + (size_t)(64 * kb) * D + 32 * nb, D, (bf16*)(A.ws + WS_WUA) + (size_t)(32 * nb) * 1024 + 64 * kb, 1024, scr, F.lane); continue; }
        r -= I_WU;
        if (r < I_WU) { const int kb = r / 32, nb = r % 32; transpose_item(A.in[I_WUPB] + (size_t)(64 * kb) * D + 32 * nb, D, (bf16*)(A.ws + WS_WUA) + (size_t)(32 * nb) * 1024 + 512 + 64 * kb, 1024, scr, F.lane); continue; }
        r -= I_WU;
        { const int kb = r / 32, nb = r % 32; transpose_item(A.in[I_WO] + (size_t)(64 * kb) * D + 32 * nb, D, (bf16*)(A.ws + WS_WO) + (size_t)(32 * nb) * D + 64 * kb, D, scr, F.lane); }
    }
    const int gt = wv * NTHREADS + F.tid, NGT = nwg * NTHREADS;
    for (int it = gt; it < 2 * 256 * 128; it += NGT) {
        const int k8 = it & 127, n = (it >> 7) & 255, dir = it >> 15;
        float w2[16];
#pragma unroll
        for (int r = 0; r < 16; ++r) w2[r] = A.in[I_GKW2][(dir * 16 + r) * 256 + n];
        float o[8];
#pragma unroll
        for (int kk = 0; kk < 8; ++kk) { const float* wr = A.in[I_WIN] + (size_t)(k8 * 8 + kk) * IN_DIM + 3584 + 16 * dir; float s = 0.f;
#pragma unroll
            for (int r4 = 0; r4 < 4; ++r4) { const f32x4 w = *(const f32x4*)(wr + 4 * r4); s += w.x * w2[4 * r4] + w.y * w2[4 * r4 + 1] + w.z * w2[4 * r4 + 2] + w.w * w2[4 * r4 + 3]; }
            o[kk] = s; }
        { u32x4 pk; pk.x = pk2(o[0], o[1]); pk.y = pk2(o[2], o[3]); pk.z = pk2(o[4], o[5]); pk.w = pk2(o[6], o[7]);
            const int cc = n & 63, rho = 128 + 32 * (cc >> 4) + 8 * ((cc >> 2) & 3) + 4 * dir + (cc & 3);
            *(u32x4*)(win_t + (size_t)(256 * (8 + (n >> 6)) + rho) * D + k8 * 8) = pk; }
    }
    bf16* wrb = (bf16*)(A.ws + WS_WRT);
    for (int it = gt; it < NE * D; it += NGT) { const int e = it >> 10, k = it & 1023; wrb[it] = (bf16)f2bf(A.in[I_WR][k * NE + e]); }
}

__device__ __forceinline__ void p0_copies_uo(const Frame& F, int gw, int NGW) {
    const Args& A = *F.a;
    LAS float* scr = (LAS float*)(F.lds + F.wave * 16384);
    constexpr int I_WU = 8 * 32, I_WO_ITEMS = 16 * 32;
    for (int it = gw; it < 2 * I_WU + I_WO_ITEMS; it += NGW) {
        int r = it;
        if (r < I_WU) { const int kb = r / 32, nb = r % 32; transpose_item(A.in[I_WUPA] + (size_t)(64 * kb) * D + 32 * nb, D, (bf16*)(A.ws + WS_WUA) + (size_t)(32 * nb) * 1024 + 64 * kb, 1024, scr, F.lane); continue; }
        r -= I_WU;
        if (r < I_WU) { const int kb = r / 32, nb = r % 32; transpose_item(A.in[I_WUPB] + (size_t)(64 * kb) * D + 32 * nb, D, (bf16*)(A.ws + WS_WUA) + (size_t)(32 * nb) * 1024 + 512 + 64 * kb, 1024, scr, F.lane); continue; }
        r -= I_WU;
        { const int kb = r / 32, nb = r % 32; transpose_item(A.in[I_WO] + (size_t)(64 * kb) * D + 32 * nb, D, (bf16*)(A.ws + WS_WO) + (size_t)(32 * nb) * D + 64 * kb, D, scr, F.lane); }
    }
}

template <int WHICH> __device__ __forceinline__ void convert_expert_weights(const Frame& F) {
    static_assert(kMoeFp8, "fp8 expert weights");
    const Args& A = *F.a;
    LAS float* scr = (LAS float*)(F.lds + F.wave * 16384);
    const int gw = F.vcu * NWAVES + F.wave, NGW = F.G * NWAVES, lane = F.lane;
    constexpr int PER_E = WHICH == 0 ? 16 * 64 : 16 * 32, NIT = NE * PER_E;
    auto item = [&](int it, const float*& src, unsigned char*& dst) { const int e = it / PER_E, r = it % PER_E;
        if (WHICH == 0) { const int kb = r / 64, nb = r % 64, n0 = 32 * nb, pn = n0 >> 8, rr = n0 & 255;
            src = (rr < 128 ? A.in[I_WG] : A.in[I_WU]) + (size_t)e * D * FF + (size_t)(64 * kb) * FF + 128 * pn + (rr & 127);
            dst = A.ws + WS_WGU + (size_t)e * 2048 * D + (size_t)n0 * D + 64 * kb; }
        else { const int kb = r / 32, nb = r % 32; src = A.in[I_WDN] + (size_t)e * FF * D + (size_t)(64 * kb) * D + 32 * nb;
            dst = A.ws + WS_WD + (size_t)e * D * FF + (size_t)(32 * nb) * FF + 64 * kb; } };
    constexpr int ld = 1024;
    float tv[32], tn[32]; const float* src; unsigned char* dst; int it = gw;
    if (it < NIT) { item(it, src, dst);
#pragma unroll
        for (int i = 0; i < 32; ++i) tv[i] = __builtin_nontemporal_load(src + (size_t)(2 * i + (lane >> 5)) * ld + (lane & 31)); }
    while (it < NIT) {
        const int itn = it + NGW; const float* srcn = src; unsigned char* dstn = dst;
        if (itn < NIT) { item(itn, srcn, dstn);
#pragma unroll
            for (int i = 0; i < 32; ++i) tn[i] = __builtin_nontemporal_load(srcn + (size_t)(2 * i + (lane >> 5)) * ld + (lane & 31)); }
#pragma unroll
        for (int i = 0; i < 32; ++i) scr[(2 * i + (lane >> 5)) * 33 + (lane & 31)] = tv[i];
        LDS_WAIT(); asm volatile("" ::: "memory");
        { const int c = lane & 7;
#pragma unroll
          for (int j = 0; j < 4; ++j) { const int n = (lane >> 3) + 8 * j; const LAS float* s = scr + (8 * c) * 33 + n;
              u32x2 o; o.x = pk4_fp8(s[0 * 33] * MOE_WSCALE, s[1 * 33] * MOE_WSCALE, s[2 * 33] * MOE_WSCALE, s[3 * 33] * MOE_WSCALE);
              o.y = pk4_fp8(s[4 * 33] * MOE_WSCALE, s[5 * 33] * MOE_WSCALE, s[6 * 33] * MOE_WSCALE, s[7 * 33] * MOE_WSCALE);
              *(u32x2*)(dst + (size_t)n * D + 8 * c) = o; } }
        LDS_WAIT(); asm volatile("" ::: "memory");
        if (itn < NIT) {
#pragma unroll
            for (int i = 0; i < 32; ++i) tv[i] = tn[i]; }
        src = srcn; dst = dstn; it = itn;
    }
}

__device__ __forceinline__ void p1_prenorm(const Frame& F) {
    const Args& A = *F.a;
    const int gw = F.vcu * NWAVES + F.wave, NGW = F.G * NWAVES;
    const float* mod = (const float*)(A.ws + WS_MOD); bf16* hbf = (bf16*)(A.ws + WS_HBF);
    const int per = (MALL + NGW - 1) / NGW, m0 = gw * per, m1 = (m0 + per < MALL) ? m0 + per : MALL;
    f32x4 cgs[4], csh[4]; int curb = -1;
    f32x4 v[2][4];
#define P1_LOAD(set, m_) do { const int mm_ = (m_); const float* xr_ = (mm_ < TC) ? A.in[I_CTX] + (size_t)mm_ * D : A.in[I_X] + (size_t)(mm_ - TC) * D; \
        _Pragma("unroll") for (int j = 0; j < 4; ++j) v[set][j] = *((const f32x4*)xr_ + F.lane + 64 * j); } while (0)
    if (m0 < m1) P1_LOAD(0, m0);
#pragma nounroll
    for (int mb = m0; mb < m1; mb += 2) {
#pragma unroll
      for (int par = 0; par < 2; ++par) { const int m = mb + par;
        if (m < m1) {
            const int bi = (m < TC) ? 16 : (m - TC) / SEQ;
            if (bi != curb) { curb = bi; const float* md = mod + (size_t)bi * 6144;
#pragma unroll
                for (int j = 0; j < 4; ++j) { const int k = 4 * (F.lane + 64 * j); cgs[j] = *(const f32x4*)(A.in[I_GPREMIX] + k) * (*(const f32x4*)(md + 1024 + k) + 1.f); csh[j] = *(const f32x4*)(md + k); } }
            asm volatile("" :: "v"(v[par][3]), "v"(csh[3]));
            __builtin_amdgcn_sched_barrier(0);
            if (m + 1 < m1) P1_LOAD(par ^ 1, m + 1);
            __builtin_amdgcn_sched_barrier(0);
            float ss = 0.f;
#pragma unroll
            for (int j = 0; j < 4; ++j) ss += (v[par][j].x * v[par][j].x + v[par][j].y * v[par][j].y) + (v[par][j].z * v[par][j].z + v[par][j].w * v[par][j].w);
            const float rstd = rsqrtf(wave_sum(ss) * (1.f / D) + EPS);
#pragma unroll
            for (int j = 0; j < 4; ++j) {
                const f32x4 h = v[par][j] * rstd * cgs[j] + csh[j];
                { u32x2 o; o.x = pk2(h.x, h.y); o.y = pk2(h.z, h.w); *((u32x2*)(hbf + (size_t)m * D) + F.lane + 64 * j) = o; }
                if (m >= TC) { if constexpr (kInFp8) *((unsigned*)((unsigned char*)A.out + (size_t)(m - TC) * D) + F.lane + 64 * j) = pk4_fp8(h.x, h.y, h.z, h.w);
                               else { u32x2 o; o.x = pk2(h.x, h.y); o.y = pk2(h.z, h.w); *((u32x2*)((bf16*)A.out + (size_t)(m - TC) * D) + F.lane + 64 * j) = o; } } }
        } }
    }
#undef P1_LOAD
}

typedef short v4i16_t __attribute__((ext_vector_type(4)));
typedef short s16x4 __attribute__((ext_vector_type(4)));
__device__ __forceinline__ s16x4 lds_tr16(const LAS unsigned char* p) { return __builtin_bit_cast(s16x4, __builtin_amdgcn_ds_read_tr16_b64_v4i16((LAS v4i16_t*)p)); }
#define LBAR() do { asm volatile("s_waitcnt lgkmcnt(0)" ::: "memory"); __builtin_amdgcn_s_barrier(); asm volatile("" ::: "memory"); } while (0)

template <int DK, bool HGRN> __device__ __forceinline__ void scan_chain(const Frame& F, LAS unsigned char* L, int hv, int wl, int tl, bf16* obase) {
    const Args& A = *F.a;
    const float* ELg = (const float*)(A.ws + WS_EL);
    const int b = hv >> 3, h = (hv >> 1) & 3, dir = hv & 1;
    const int lane = tl & 63, l15 = lane & 15, g = lane >> 4;
    constexpr int PQ = DK * 2 + 16;
    constexpr int PV = 272;
    constexpr int PP = 144;
    constexpr int NLD = DK / 64;
    constexpr int KS = DK / 32;
    constexpr int IMGB = ((2 * 64 * PQ + 64 * PV + DK * 4 + 1023) / 1024) * 1024;
    constexpr int O_RK = 64 * PQ, O_VI = 2 * 64 * PQ, O_EL = 2 * 64 * PQ + 64 * PV, O_PI = 2 * IMGB;
    static_assert(O_PI + 2 * 64 * PP <= MISC_OFF, "scan images exceed the LDS");
    constexpr int TSZ = 64 * DK * 2;
    const unsigned char* const qk0 = A.ws + (HGRN ? WS_RQA : WS_RQB) + (size_t)hv * NSTEP * 2 * TSZ;
    const unsigned char* const v0 = A.ws + (HGRN ? WS_RVA : WS_RVB) + (size_t)(hv >> 1) * NSTEP * 16384;
    const float* elp = ELg + (size_t)dir * NCG * 768 + (HGRN ? 0 : 512) + h * DK;
    f32x4 S[DK / 16];
#pragma unroll
    for (int i = 0; i < DK / 16; ++i) S[i] = (f32x4){0.f, 0.f, 0.f, 0.f};
    u32x4 rq[2][NLD], rk[2][NLD], rv[2][2], rel[2];
#define SCAN_ISSUE(set, s_) do { const int s__ = (s_); const unsigned char* qt = qk0 + (size_t)s__ * 2 * TSZ; \
        _Pragma("unroll") for (int q = 0; q < NLD; ++q) { const int ci = tl + 512 * q; \
            if (s__ >= 4) rq[set][q] = *(const u32x4*)(qt + 16 * ci); \
            rk[set][q] = *(const u32x4*)(qt + TSZ + 16 * ci); } \
        { const int sm = dir ? (s__ < 4 ? 3 - s__ : 39 - s__) : s__; const unsigned char* vt = v0 + (size_t)sm * 16384; \
          _Pragma("unroll") for (int q = 0; q < 2; ++q) rv[set][q] = *(const u32x4*)(vt + 16 * (tl + 512 * q)); } \
        { const int mc = (s__ < 4) ? (dir ? 3 - s__ : s__) : (dir ? 35 - s__ : s__ - 4), cg = (s__ < 4) ? 4 * b + mc : TC / 64 + 32 * b + mc; \
          if (tl < DK / 4) rel[set] = *(const u32x4*)(elp + (size_t)cg * 768 + 4 * tl); } } while (0)
#define SCAN_WRITE(buf, set, s_) do { LAS unsigned char* const RQw = L + (buf) * IMGB; LAS unsigned char* const RKw = RQw + O_RK; LAS unsigned char* const VIw = RQw + O_VI; const bool latw = (s_) >= 4; \
        _Pragma("unroll") for (int q = 0; q < NLD; ++q) { const int ci = tl + 512 * q, h2 = ci >> 9, wcc = (ci >> 7) & 3, t = (ci >> 1) & 63, hf = ci & 1;        \
            if (latw) { LAS unsigned char* qd = RQw + t * PQ + 64 * (2 * h2 + (wcc >> 1)) + 32 * hf + 8 * (wcc & 1);                                      \
                *(LAS u32x2*)qd = (u32x2){rq[set][q].x, rq[set][q].y}; *(LAS u32x2*)(qd + 16) = (u32x2){rq[set][q].z, rq[set][q].w}; } \
            *(LAS u32x4*)(RKw + t * PQ + 2 * (64 * h2 + 16 * wcc + 8 * hf)) = rk[set][q]; } \
        _Pragma("unroll") for (int q = 0; q < 2; ++q) { const int ci = tl + 512 * q; \
            if constexpr (HGRN) { const int h2 = ci >> 9, wcc = (ci >> 7) & 3, tm = (ci >> 1) & 63, hf = ci & 1, t = dir ? 63 - tm : tm; *(LAS u32x4*)(VIw + t * PV + 2 * (64 * h2 + 16 * wcc + 8 * hf)) = rv[set][q]; } \
            else { const int tm = ci >> 4, t = dir ? 63 - tm : tm, cc = ci & 15; *(LAS u32x4*)(VIw + t * PV + 16 * cc) = rv[set][q]; } } \
        if (tl < DK / 4) *(LAS u32x4*)(RQw + O_EL + 16 * tl) = rel[set]; } while (0)
    SCAN_ISSUE(0, 0); SCAN_ISSUE(1, 1);
    SCAN_WRITE(0, 0, 0); SCAN_ISSUE(0, 2); SCAN_WRITE(1, 1, 1); SCAN_ISSUE(1, 3);
    LBAR();
#pragma nounroll
    for (int s2 = 0; s2 < 36; s2 += 2) {
#pragma unroll
      for (int par = 0; par < 2; ++par) {
        const int s = s2 + par;
        LAS unsigned char* const RQ = L + par * IMGB; LAS unsigned char* const RK = RQ + O_RK; LAS unsigned char* const VI = RQ + O_VI; LAS unsigned char* const ELs = RQ + O_EL;
        LAS unsigned char* const RQn = L + (par ^ 1) * IMGB; LAS unsigned char* const RKn = RQn + O_RK;
        LAS unsigned char* const PI = L + O_PI + par * (64 * PP); LAS unsigned char* const PIn = L + O_PI + (par ^ 1) * (64 * PP);
        bf16x8 Vf[2];
#pragma unroll
        for (int ks2 = 0; ks2 < 2; ++ks2) { const int q = l15 >> 2, p = l15 & 3;
            const s16x4 lo = lds_tr16(VI + (32 * ks2 + 8 * g + q) * PV + 32 * wl + 8 * p), hi = lds_tr16(VI + (32 * ks2 + 8 * g + 4 + q) * PV + 32 * wl + 8 * p);
            Vf[ks2] = (bf16x8){lo[0], lo[1], lo[2], lo[3], hi[0], hi[1], hi[2], hi[3]}; }
        if (s + 1 >= 4 && s + 1 < 36) {
            const int ib = (0x12333210 >> (4 * wl)) & 15, jlo = (0x00102110 >> (4 * wl)) & 15, jhi = (0x00103210 >> (4 * wl)) & 15;
            bf16x8 Bq[KS];
#pragma unroll
            for (int ks = 0; ks < KS; ++ks) Bq[ks] = *(const LAS bf16x8*)(RQn + (16 * ib + l15) * PQ + 64 * ks + 16 * g);
#pragma unroll
            for (int jt = 0; jt < 4; ++jt) { if (jt >= jlo && jt <= jhi) {
                f32x4 acc = (f32x4){0.f, 0.f, 0.f, 0.f};
#pragma unroll
                for (int ks = 0; ks < KS; ++ks) { const LAS unsigned char* kp = RKn + (16 * jt + l15) * PQ + 64 * ks + 8 * g;
                    const s16x4 lo = *(const LAS s16x4*)kp, hi = *(const LAS s16x4*)(kp + 32);
                    const bf16x8 Ak = (bf16x8){lo[0], lo[1], lo[2], lo[3], hi[0], hi[1], hi[2], hi[3]};
                    acc = __builtin_amdgcn_mfma_f32_16x16x32_bf16(Ak, Bq[ks], acc, 0, 0, 0); }
                if (jt == ib) {
#pragma unroll
                    for (int r = 0; r < 4; ++r) if (4 * g + r > l15) acc[r] = 0.f; }
                u32x2 w; w.x = pk2(acc[0], acc[1]); w.y = pk2(acc[2], acc[3]);
                *(LAS u32x2*)(PIn + (16 * ib + l15) * PP + 32 * jt + 8 * g) = w; } }
            if (wl == 0 || wl == 2) *(LAS u32x2*)(PIn + (16 * wl + l15) * PP + 32 * (wl + 1) + 8 * g) = (u32x2){0u, 0u};
        }
        if (s >= 4) {
            bf16x8 Sb[KS];
#pragma unroll
            for (int ks = 0; ks < KS; ++ks) { const f32x4 a = S[2 * ks], c = S[2 * ks + 1]; u32x4 w; w.x = pk2(a[0], a[1]); w.y = pk2(a[2], a[3]); w.z = pk2(c[0], c[1]); w.w = pk2(c[2], c[3]); Sb[ks] = __builtin_bit_cast(bf16x8, w); }
#pragma unroll
            for (int it = 0; it < 4; ++it) {
                f32x4 acc = (f32x4){0.f, 0.f, 0.f, 0.f};
                { const bf16x8 Pf = *(const LAS bf16x8*)(PI + (16 * it + l15) * PP + 16 * g); acc = __builtin_amdgcn_mfma_f32_16x16x32_bf16(Vf[0], Pf, acc, 0, 0, 0); }
                if (it >= 2) { const bf16x8 Pf = *(const LAS bf16x8*)(PI + (16 * it + l15) * PP + 64 + 16 * g); acc = __builtin_amdgcn_mfma_f32_16x16x32_bf16(Vf[1], Pf, acc, 0, 0, 0); }
#pragma unroll
                for (int ks = 0; ks < KS; ++ks) { const bf16x8 Bi = *(const LAS bf16x8*)(RQ + (16 * it + l15) * PQ + 64 * ks + 16 * g); acc = __builtin_amdgcn_mfma_f32_16x16x32_bf16(Sb[ks], Bi, acc, 0, 0, 0); }
                const int p = 64 * (s - 4) + 16 * it + l15, tok = dir ? SEQ - 1 - p : p;
                u32x2 w; w.x = pk2(acc[0], acc[1]); w.y = pk2(acc[2], acc[3]);
                *(u32x2*)(obase + ((size_t)dir * T + (size_t)b * SEQ + tok) * 512 + h * 128 + 16 * wl + 4 * g) = w;
            }
        }
#pragma unroll
        for (int dt = 0; dt < DK / 16; ++dt) {
#pragma unroll
            for (int ks2 = 0; ks2 < 2; ++ks2) { const int q = l15 >> 2, p = l15 & 3;
                const s16x4 lo = lds_tr16(RK + (32 * ks2 + 8 * g + q) * PQ + 32 * dt + 8 * p), hi = lds_tr16(RK + (32 * ks2 + 8 * g + 4 + q) * PQ + 32 * dt + 8 * p);
                const bf16x8 Kf = (bf16x8){lo[0], lo[1], lo[2], lo[3], hi[0], hi[1], hi[2], hi[3]};
                S[dt] = __builtin_amdgcn_mfma_f32_16x16x32_bf16(Kf, Vf[ks2], S[dt], 0, 0, 0); }
            S[dt] = S[dt] * *(const LAS f32x4*)(ELs + (16 * dt + 4 * g) * 4);
        }
        LBAR();
        if (s + 2 < 36) { SCAN_WRITE(par, par, s + 2); if (s + 4 < 36) SCAN_ISSUE(par, s + 4); }
        LBAR();
      }
    }
#undef SCAN_ISSUE
#undef SCAN_WRITE
}

__device__ __forceinline__ void p4_readout(const Frame& F, int gw, int NGW, int brsel, int tend, int tbeg = 0) {
    const Args& A = *F.a;
    const bf16* Z = (const bf16*)(A.ws + WS_Z); const bf16* O = (const bf16*)A.out;
    const int nit = brsel < 0 ? 2 * tend : tend - tbeg;
    f32x4 nwt[2][2];
#pragma unroll
    for (int q = 0; q < 2; ++q) { const float* nw = (q ? A.in[I_GNW] : A.in[I_HNW]) + (8 * F.lane & 127); nwt[q][0] = *(const f32x4*)nw; nwt[q][1] = *(const f32x4*)(nw + 4); }
    u32x4 wf[2], wb[2]; u32x2 wg[2];
#define RO_LOAD(set, it_) do { const int br_ = brsel < 0 ? ((it_) & 1) : brsel, tok_ = brsel < 0 ? ((it_) >> 1) : tbeg + (it_); \
        wf[set] = *(const u32x4*)(O + ((size_t)(br_ * 2 + 0) * T + tok_) * 512 + 8 * F.lane); wb[set] = *(const u32x4*)(O + ((size_t)(br_ * 2 + 1) * T + tok_) * 512 + 8 * F.lane); \
        wg[set] = *(const u32x2*)((const unsigned char*)Z + (size_t)tok_ * (NZ * 2) + br_ * 512 + 8 * F.lane); } while (0)
    if (gw < nit) RO_LOAD(0, gw);
#pragma nounroll
    for (int it0 = gw; it0 < nit; it0 += 2 * NGW) {
#pragma unroll
      for (int par = 0; par < 2; ++par) { const int it = it0 + par * NGW;
        if (it < nit) {
            asm volatile("" :: "v"(wg[par]), "v"(wb[par]), "v"(wf[par]));
            __builtin_amdgcn_sched_barrier(0);
            if (it + NGW < nit) RO_LOAD(par ^ 1, it + NGW);
            __builtin_amdgcn_sched_barrier(0);
            const int br = brsel < 0 ? (it & 1) : brsel, tok = brsel < 0 ? (it >> 1) : tbeg + it;
            f32x4 a0, a1, b0, b1, g0, g1; pg8::unpack8(wf[par], a0, a1); pg8::unpack8(wb[par], b0, b1);
            { const f32x2 p0 = __builtin_amdgcn_cvt_pk_f32_fp8((int)wg[par].x, false), p1 = __builtin_amdgcn_cvt_pk_f32_fp8((int)wg[par].x, true), p2 = __builtin_amdgcn_cvt_pk_f32_fp8((int)wg[par].y, false), p3 = __builtin_amdgcn_cvt_pk_f32_fp8((int)wg[par].y, true);
              g0 = (f32x4){p0.x, p0.y, p1.x, p1.y}; g1 = (f32x4){p2.x, p2.y, p3.x, p3.y}; }
            a0 += b0; a1 += b1;
            float ss = (a0.x * a0.x + a0.y * a0.y) + (a0.z * a0.z + a0.w * a0.w) + (a1.x * a1.x + a1.y * a1.y) + (a1.z * a1.z + a1.w * a1.w);
            ss += dpp_mov<0x128>(ss, 0.f); ss += dpp_mov<0x124>(ss, 0.f); ss += dpp_mov<0x122>(ss, 0.f); ss += dpp_mov<0x121>(ss, 0.f);
            const float rstd = rsqrtf(ss * (1.f / 128.f) + EPS);
            const f32x4 n0 = br ? nwt[1][0] : nwt[0][0], n1 = br ? nwt[1][1] : nwt[0][1];
#pragma unroll
            for (int j = 0; j < 4; ++j) { a0[j] = a0[j] * rstd * n0[j] * g0[j]; a1[j] = a1[j] * rstd * n1[j] * g1[j]; }
            bf16* r = (bf16*)(A.ws + WS_RA) + (size_t)tok * 1024 + br * 512 + 8 * F.lane;
            *(u32x4*)r = pg8::pack8(a0, a1);
        } }
    }
#undef RO_LOAD
}

__device__ __forceinline__ void load_row_bf16(const bf16* p, int lane, f32x4 (&v)[4]) {
#pragma unroll
    for (int j = 0; j < 4; ++j) { const u32x2 w = *((const u32x2*)p + lane + 64 * j); v[j] = (f32x4){bflo(w.x), bfhi(w.x), bflo(w.y), bfhi(w.y)}; }
}
__device__ __forceinline__ void load_row_fp8(const unsigned char* p, int lane, f32x4 (&v)[4]) {
#pragma unroll
    for (int j = 0; j < 4; ++j) { const int w = *((const int*)p + lane + 64 * j); const f32x2 a = __builtin_amdgcn_cvt_pk_f32_fp8(w, false), b = __builtin_amdgcn_cvt_pk_f32_fp8(w, true); v[j] = (f32x4){a.x, a.y, b.x, b.y}; }
}
template <bool F8> __device__ __forceinline__ void load_row_act(const void* base, size_t row, int lane, f32x4 (&v)[4]) {
    if constexpr (F8) load_row_fp8((const unsigned char*)base + row * D, lane, v); else load_row_bf16((const bf16*)base + row * D, lane, v);
}
__device__ __forceinline__ float sumsq4(const f32x4 (&v)[4]) { float s = 0.f;
#pragma unroll
    for (int j = 0; j < 4; ++j) s += (v[j].x * v[j].x + v[j].y * v[j].y) + (v[j].z * v[j].z + v[j].w * v[j].w);
    return s; }
__device__ __forceinline__ void compute_x1(const Args& A, int tok, int lane, const float* md, f32x4 (&x1)[4]) {
    f32x4 mx[4]; load_row_act<kMixFp8>(A.ws + WS_MIXB, (size_t)tok, lane, mx);
    const float rstd = rsqrtf(wave_sum(sumsq4(mx)) * (1.f / D) + EPS);
#pragma unroll
    for (int j = 0; j < 4; ++j) { const int k = 4 * (lane + 64 * j);
        const f32x4 xv = *(const f32x4*)(A.in[I_X] + (size_t)tok * D + k), g = *(const f32x4*)(A.in[I_GPOSTMIX] + k), gt = *(const f32x4*)(md + 2048 + k);
        x1[j] = xv + gt * (mx[j] * rstd * g); }
}

__device__ __forceinline__ void p8_router(const Frame& F) {
    const Args& A = *F.a;
    constexpr int WP = 2064;
    LAS unsigned char* WL = F.lds;
    LAS unsigned char* HB = WL + 32 * WP;
    LAS float* LG = (LAS float*)(HB + 16 * WP);
    int* hist = (int*)((unsigned char*)F.lds + 32 * WP + 16 * WP + 16 * 33 * 4);
    const u32x4* wrb = (const u32x4*)(A.ws + WS_WRT);
#pragma unroll
    for (int q = 0; q < 8; ++q) { const int i = F.tid + NTHREADS * q; *(LAS u32x4*)(WL + (i >> 7) * WP + 16 * (i & 127)) = wrb[i]; }
    if (F.tid < NE) hist[F.tid] = 0;
    __syncthreads();
    const float* mod = (const float*)(A.ws + WS_MOD); unsigned char* h2b = (unsigned char*)(A.ws + WS_H2);
    int* topi = (int*)(A.ws + WS_TOPI); float* topp = (float*)(A.ws + WS_TOPP); int* lrank = (int*)(A.ws + WS_LRANK);
    static_assert(kMoeFp8, "the router phase writes fp8 h2 rows");
    if (F.vcu == 0 && F.wave == 0) {
#pragma unroll
        for (int j = 0; j < 4; ++j) *((unsigned*)(h2b + (size_t)T * D) + F.lane + 64 * j) = 0u; }
    const int l15 = F.lane & 15, g = F.lane >> 4;
    const float* md = mod + (size_t)((128 * F.vcu) / SEQ) * 6144;
    f32x4 cg[4], cgg[4], csh[4];
#pragma unroll
    for (int j = 0; j < 4; ++j) { const int k = 4 * (F.lane + 64 * j); cg[j] = *(const f32x4*)(A.in[I_GPOSTMIX] + k) * *(const f32x4*)(md + 2048 + k);
        cgg[j] = *(const f32x4*)(A.in[I_GPREFFN] + k) * (*(const f32x4*)(md + 4096 + k) + 1.f); csh[j] = *(const f32x4*)(md + 3072 + k); }
    const float bias = A.in[I_BR][16 * (F.wave & 1) + l15];
    u32x2 rm[2][2][4]; f32x4 rx[2][2][4];
#define RT_LOAD(set, r_) do { _Pragma("unroll") for (int q = 0; q < 2; ++q) { const size_t tok_ = (size_t)(128 * F.vcu + 16 * (r_) + 2 * F.wave + q); \
        _Pragma("unroll") for (int j = 0; j < 4; ++j) { rm[set][q][j] = *((const u32x2*)((const bf16*)(A.ws + WS_MIXB) + tok_ * D) + F.lane + 64 * j); rx[set][q][j] = *(const f32x4*)(A.in[I_X] + tok_ * D + 4 * (F.lane + 64 * j)); } } } while (0)
    static_assert(!kMixFp8, "the router phase reads bf16 mix rows");
    RT_LOAD(0, 0);
#pragma nounroll
    for (int r2 = 0; r2 < 8; r2 += 2) {
#pragma unroll
      for (int par = 0; par < 2; ++par) {
        const int r = r2 + par;
        const int base = 128 * F.vcu + 16 * r;
        asm volatile("" :: "v"(rx[par][1][3]), "v"(rm[par][1][3]));
        __builtin_amdgcn_sched_barrier(0);
        if (r + 1 < 8) RT_LOAD(par ^ 1, r + 1);
        __builtin_amdgcn_sched_barrier(0);
#pragma unroll
        for (int q = 0; q < 2; ++q) { const int row = 2 * F.wave + q, tok = base + row;
            f32x4 mx[4], x1[4];
#pragma unroll
            for (int j = 0; j < 4; ++j) mx[j] = (f32x4){bflo(rm[par][q][j].x), bfhi(rm[par][q][j].x), bflo(rm[par][q][j].y), bfhi(rm[par][q][j].y)};
            const float rstdm = rsqrtf(wave_sum(sumsq4(mx)) * (1.f / D) + EPS);
#pragma unroll
            for (int j = 0; j < 4; ++j) x1[j] = rx[par][q][j] + cg[j] * (mx[j] * rstdm);
            const float rstd = rsqrtf(wave_sum(sumsq4(x1)) * (1.f / D) + EPS);
#pragma unroll
            for (int j = 0; j < 4; ++j) {
                { u32x2 o; o.x = pk2(x1[j].x, x1[j].y); o.y = pk2(x1[j].z, x1[j].w); *((u32x2*)((bf16*)(A.ws + WS_X1B) + (size_t)tok * D) + F.lane + 64 * j) = o; }
                const f32x4 h = x1[j] * rstd * cgg[j] + csh[j];
                *((unsigned*)(h2b + (size_t)tok * D) + F.lane + 64 * j) = pk4_fp8(h.x, h.y, h.z, h.w);
                u32x2 o; o.x = pk2(h.x, h.y); o.y = pk2(h.z, h.w); *(LAS u32x2*)(HB + row * WP + 8 * (F.lane + 64 * j)) = o; } }
        LBAR();
        if (F.wave < 2) { const int n = F.wave; f32x4 acc = (f32x4){0.f, 0.f, 0.f, 0.f};
#pragma unroll 8
            for (int ks = 0; ks < 32; ++ks) { const bf16x8 a = *(const LAS bf16x8*)(HB + l15 * WP + 64 * ks + 16 * g), bb = *(const LAS bf16x8*)(WL + (16 * n + l15) * WP + 64 * ks + 16 * g);
                acc = __builtin_amdgcn_mfma_f32_16x16x32_bf16(a, bb, acc, 0, 0, 0); }
#pragma unroll
            for (int rr = 0; rr < 4; ++rr) LG[(4 * g + rr) * 33 + 16 * n + l15] = acc[rr] + bias; }
        LBAR();
        if (F.wave == 2 && F.lane < 16) { const int tok = base + F.lane;
            float v0 = -INFINITY, v1 = -INFINITY, v2 = -INFINITY, v3 = -INFINITY; int i0 = 0, i1 = 0, i2 = 0, i3 = 0;
#pragma unroll 8
            for (int e = 0; e < NE; ++e) { const float x = LG[F.lane * 33 + e]; const bool c0 = x > v0, c1 = x > v1, c2 = x > v2, c3 = x > v3;
                v3 = c3 ? (c2 ? v2 : x) : v3; i3 = c3 ? (c2 ? i2 : e) : i3; v2 = c2 ? (c1 ? v1 : x) : v2; i2 = c2 ? (c1 ? i1 : e) : i2;
                v1 = c1 ? (c0 ? v0 : x) : v1; i1 = c1 ? (c0 ? i0 : e) : i1; v0 = c0 ? x : v0; i0 = c0 ? e : i0; }
            const float e1 = __expf(v1 - v0), e2 = __expf(v2 - v0), e3 = __expf(v3 - v0), inv = 1.f / (1.f + e1 + e2 + e3);
            *(i32x4*)(topi + tok * 4) = (i32x4){i0, i1, i2, i3}; *(f32x4*)(topp + tok * 4) = (f32x4){inv, e1 * inv, e2 * inv, e3 * inv};
            i32x4 lr; lr.x = __hip_atomic_fetch_add(hist + i0, 1, __ATOMIC_RELAXED, __HIP_MEMORY_SCOPE_WORKGROUP); lr.y = __hip_atomic_fetch_add(hist + i1, 1, __ATOMIC_RELAXED, __HIP_MEMORY_SCOPE_WORKGROUP);
            lr.z = __hip_atomic_fetch_add(hist + i2, 1, __ATOMIC_RELAXED, __HIP_MEMORY_SCOPE_WORKGROUP); lr.w = __hip_atomic_fetch_add(hist + i3, 1, __ATOMIC_RELAXED, __HIP_MEMORY_SCOPE_WORKGROUP);
            *(i32x4*)(lrank + tok * 4) = lr; }
      }
    }
#undef RT_LOAD
    __syncthreads();
    if (F.tid < NE) { unsigned* gc = (unsigned*)(A.ws + WS_CTL) + CW_GCOUNT; const int basec = (int)__hip_atomic_fetch_add(gc + F.tid, (unsigned)hist[F.tid], RLX_AGENT);
        ((int*)(A.ws + WS_BLKBASE))[F.vcu * NE + F.tid] = basec; }
    __syncthreads();
}

__device__ __forceinline__ void p9_slots(const Frame& F) {
    const Args& A = *F.a;
    int* ps = (int*)((unsigned char*)F.lds); int* cn = ps + 64;
    const unsigned* gc = (const unsigned*)(A.ws + WS_CTL) + CW_GCOUNT;
    if (F.tid < NE) cn[F.tid] = (int)__hip_atomic_load(gc + F.tid, RLX_AGENT);
    __syncthreads();
    if (F.tid == 0) { int acc = 0; for (int e = 0; e < NE; ++e) { ps[e] = acc; acc += (cn[e] + 255) & ~255; } ps[NE] = acc; }
    __syncthreads();
    const int* topi = (const int*)(A.ws + WS_TOPI); const int* lrank = (const int*)(A.ws + WS_LRANK); const int* blkbase = (const int*)(A.ws + WS_BLKBASE);
    int* pslot = (int*)(A.ws + WS_PSLOT); int* tokslot = (int*)(A.ws + WS_TOKSLOT);
    for (int p = F.vcu * NTHREADS + F.tid; p < T * TOPK; p += F.G * NTHREADS) {
        const int tok = p >> 2, e = topi[p], slot = ps[e] + blkbase[(tok >> 7) * NE + e] + lrank[p];
        tokslot[slot] = tok; pslot[p] = slot; }
    if (F.vcu < NE) { const int e = F.vcu, pad = ((cn[e] + 255) & ~255); for (int i = cn[e] + F.tid; i < pad; i += NTHREADS) tokslot[ps[e] + i] = T; }
    if (F.vcu == NE) { const int ntile = ps[NE] >> 8; int* tile_e = (int*)(A.ws + WS_TILEE);
        for (int t = F.tid; t < MAXTILES; t += NTHREADS) { int e = 0; for (int q = 0; q < NE; ++q) if (t * 256 >= ps[q]) e = q; tile_e[t] = (t < ntile) ? e : 0; }
        if (F.tid == 0) ((int*)(A.ws + WS_CTL))[CW_NT] = ntile; }
    __syncthreads();
}

__device__ __forceinline__ void p12_final(const Frame& F) {
    const Args& A = *F.a;
    const int gw = F.vcu * NWAVES + F.wave, NGW = F.G * NWAVES;
    const float* mod = (const float*)(A.ws + WS_MOD); const bf16* Y = (const bf16*)(A.ws + WS_Y);
    const int* pslot = (const int*)(A.ws + WS_PSLOT); const float* topp = (const float*)(A.ws + WS_TOPP);
    constexpr int NTK = 4;
    for (int tok0 = gw; tok0 < T; tok0 += NTK * NGW) {
        int tok[NTK]; i32x4 sl[NTK]; f32x4 pw[NTK];
#pragma unroll
        for (int q = 0; q < NTK; ++q) { tok[q] = tok0 + q * NGW; sl[q] = *(const i32x4*)(pslot + tok[q] * 4); pw[q] = *(const f32x4*)(topp + tok[q] * 4); }
        f32x4 x1[NTK][4], f[NTK][4];
#pragma unroll
        for (int q = 0; q < NTK; ++q) { load_row_bf16((const bf16*)(A.ws + WS_X1B) + (size_t)tok[q] * D, F.lane, x1[q]);
#pragma unroll
            for (int j = 0; j < 4; ++j) f[q][j] = (f32x4){0.f, 0.f, 0.f, 0.f};
#pragma unroll
            for (int k = 0; k < 4; ++k) { f32x4 y[4]; load_row_act<kActFp8>(Y, (size_t)sl[q][k], F.lane, y);
#pragma unroll
                for (int j = 0; j < 4; ++j) f[q][j] += y[j] * pw[q][k]; } }
#pragma unroll
        for (int q = 0; q < NTK; ++q) { const float* md = mod + (size_t)(tok[q] / SEQ) * 6144;
            const float rstd = rsqrtf(wave_sum(sumsq4(f[q])) * (1.f / D) + EPS);
#pragma unroll
            for (int j = 0; j < 4; ++j) { const int k = 4 * (F.lane + 64 * j);
                const f32x4 g = *(const f32x4*)(A.in[I_GPOSTFFN] + k), gt = *(const f32x4*)(md + 5120 + k);
                *(f32x4*)(A.out + (size_t)tok[q] * D + k) = x1[q][j] + gt * (f[q][j] * rstd * g); } }
    }
}

constexpr int NPHASES = 12;
#ifndef GLA_RO_TOKENS
#define GLA_RO_TOKENS T
#endif
__global__ void __launch_bounds__(NTHREADS, 2) fwd_kernel(Args args) {
    extern __shared__ __attribute__((aligned(16))) unsigned char lds_raw[];
    Frame F; F.lds = (LAS unsigned char*)lds_raw; F.tid = threadIdx.x; F.lane = F.tid & 63; F.wave = __builtin_amdgcn_readfirstlane(F.tid >> 6);
    F.G = gridDim.x; { const int bx = blockIdx.x; F.vcu = (F.G % 8 == 0) ? (bx % 8) * (F.G / 8) + bx / 8 : bx; } F.a = &args;
    volatile LAS unsigned* MISC = (volatile LAS unsigned*)(F.lds + MISC_OFF);
    for (int u = F.tid; u < (LDS_BYTES - LDSCTL_OFF) / 4; u += NTHREADS) ((LAS unsigned*)(F.lds + LDSCTL_OFF))[u] = 0u;
    __syncthreads();
    unsigned char* ws = args.ws;
    unsigned* ctl = (unsigned*)(ws + WS_CTL);
    const int lo = args.ph_lo, hi = args.ph_hi;
    XcdBarrier bar; bar.bar = ctl + CW_BAR; bar.x = 0; bar.st = nullptr; bar.expect = 0;
    if (hi - lo > 1) bar = xcd_barrier_post(ctl + CW_BAR, MISC + 8, gridDim.x);
    const bool gla_fused = (lo == 0 && hi == NPHASES && F.G == 256);
    XcdBarrier bar2 = bar;
    if (gla_fused && F.vcu >= 128) bar2 = xcd_barrier_post(ctl + CW_BAR2, MISC + 16, 128u);
#define IN(k) (lo <= (k) && (k) < hi)
#define SEAM(k) do { if (IN(k) && IN((k) + 1)) xcd_barrier(bar); } while (0)
    const int bx = (int)blockIdx.x;

    if (IN(0)) { p0_prologue(F, gla_fused); } SEAM(0);
    if (IN(1)) { p1_prenorm(F); } SEAM(1);
    if (IN(2)) {
        const int nfirst = F.vcu & 1;
#pragma nounroll
        for (int pass = 0; pass < 3; ++pass) {
            if (pass == 1) { pg8::InprojOrder S{F.G, bx, (const char*)(ws + WS_HBF), (const char*)(ws + WS_WIN), (size_t)256 * 2048, (size_t)256 * 2048};
                pg8::EpiInproj E{(bf16*)(ws + WS_Z), ws, (float*)(ws + WS_EL), args.in[I_GKB], args.in[I_HLB], 0, 0, 1.f};
                pg8::gemm_phase<pg8::EpiInproj, pg8::InprojOrder, 0, true, false>(F.lds, 2048, S, E, nullptr, nullptr, S.A, S.B); }
            else { pg8::DenseOrder S; S.init(T, NT_LO * 256, IN_KB, F.G, bx, args.out, ws + WS_WIN_LO);
                if (pass == 0) S.hi = nfirst; else S.lo = nfirst;
                pg8::EpiInproj E{(bf16*)(ws + WS_Z), ws, (float*)(ws + WS_EL), args.in[I_GKB], args.in[I_HLB], TC / 256, NT_LAT, 1.f / IN_WSCALE};
                pg8::gemm_phase<pg8::EpiInproj, pg8::DenseOrder, kInFp8 ? 2 : 0, true, kInFp8, 1>(F.lds, IN_KB, S, E, nullptr, (const char*)args.out, S.A, S.B); }
        }
    } SEAM(2);
    if (IN(3)) {
        if (F.vcu < 128) scan_chain<128, true>(F, F.lds, F.vcu, F.wave, F.tid, (bf16*)args.out);
        else { scan_chain<64, false>(F, F.lds, F.vcu - 128, F.wave, F.tid, (bf16*)args.out + (size_t)2 * T * 512);
            if (gla_fused) { xcd_barrier(bar2); p4_readout(F, (F.vcu - 128) * NWAVES + F.wave, 128 * NWAVES, 1, GLA_RO_TOKENS);
                             __syncthreads(); p0_copies_uo(F, (F.vcu - 128) * NWAVES + F.wave, 128 * NWAVES); } }
    } SEAM(3);
    if (IN(4)) { if (gla_fused) { p4_readout(F, F.vcu * NWAVES + F.wave, F.G * NWAVES, 0, T); if (GLA_RO_TOKENS < T) p4_readout(F, F.vcu * NWAVES + F.wave, F.G * NWAVES, 1, T, GLA_RO_TOKENS); }
                 else p4_readout(F, F.vcu * NWAVES + F.wave, F.G * NWAVES, -1, T); } SEAM(4);
    if (IN(5)) {
        pg8::DenseOrder S; S.init(T, D, 2048, F.G, bx, ws + WS_RA, ws + WS_WUA);
        pg8::EpiMerge E{(const bf16*)(ws + WS_Z), (bf16*)args.out};
        pg8::gemm_phase<pg8::EpiMerge, pg8::DenseOrder, 0, true, false>(F.lds, 2048, S, E, nullptr, nullptr, S.A, S.B);
    } SEAM(5);
    if (IN(6)) {
        pg8::DenseOrder S; S.init(T, D, D * 2, F.G, bx, (const bf16*)args.out, ws + WS_WO);
        pg8::EpiStore<kMixFp8> E{(void*)(ws + WS_MIXB), D, 1.f};
        const bool conv_first = (F.vcu & 1) != 0;
        if (conv_first) { convert_expert_weights<0>(F); __syncthreads(); }
        pg8::gemm_phase<pg8::EpiStore<kMixFp8>, pg8::DenseOrder, 0, true, false>(F.lds, D * 2, S, E, nullptr, nullptr, S.A, S.B);
        if (!conv_first) { __syncthreads(); convert_expert_weights<0>(F); }
    } SEAM(6);
    if (IN(7)) { p8_router(F); } SEAM(7);
    if (IN(8)) { p9_slots(F); } SEAM(8);
    if (IN(9)) {
        const int ntile = __builtin_amdgcn_readfirstlane(((const int*)ctl)[CW_NT]);
        pg8::MoeOrder S{ntile, 8, F.G, bx, (const int*)(ws + WS_TILEE), (const char*)(ws + WS_WGU), (size_t)2048 * MOE_KB, (size_t)256 * MOE_KB, nullptr, nullptr, 0};
        pg8::EpiGateUp E{(bf16*)args.out, (bf16*)(ws + WS_HREST), args.in[I_BG], args.in[I_BU]};
        const bool conv_first = (F.vcu & 1) != 0;
        if (conv_first) { convert_expert_weights<1>(F); __syncthreads(); }
        pg8::gemm_phase<pg8::EpiGateUp, pg8::MoeOrder, 1, true, kMoeFp8>(F.lds, MOE_KB, S, E, (const int*)(ws + WS_TOKSLOT), (const char*)(ws + WS_H2), nullptr, S.B);
        if (!conv_first) { __syncthreads(); convert_expert_weights<1>(F); }
    } SEAM(9);
    if (IN(10)) {
        const int ntile = __builtin_amdgcn_readfirstlane(((const int*)ctl)[CW_NT]);
        pg8::MoeOrder S{ntile, 4, F.G, bx, (const int*)(ws + WS_TILEE), (const char*)(ws + WS_WD), (size_t)D * MOE_KB, (size_t)256 * MOE_KB, (const char*)args.out, (const char*)(ws + WS_HREST), (size_t)256 * MOE_KB};
        pg8::EpiDown E{(bf16*)(ws + WS_Y), args.in[I_BDN]};
        static_assert(kMoeFp8, "MoE operands are fp8");
        pg8::gemm_phase<pg8::EpiDown, pg8::MoeOrder, 2, true, true, 1>(F.lds, MOE_KB, S, E, nullptr, (const char*)(ws + WS_HREST), nullptr, S.B);
    } SEAM(10);
    if (IN(11)) { p12_final(F); }
#undef IN
#undef SEAM
}

extern "C" void kernel_launch(void* const* d_in, const int* in_sizes, int n_in, void* d_out, int out_size, void* d_ws, size_t ws_size, hipStream_t stream) {
    static int grid = 0;
    if (grid == 0) {
        if (n_in != 27 || out_size != T * D || ws_size < WS_END) { fprintf(stderr, "kernel_launch: unexpected shapes: n_in %d out %d ws %zu (need %zu)\n", n_in, out_size, ws_size, (size_t)WS_END); grid = -1; return; }
        int dev = 0, cus = 0, per_cu = 0;
        if (hipGetDevice(&dev) != hipSuccess || hipDeviceGetAttribute(&cus, hipDeviceAttributeMultiprocessorCount, dev) != hipSuccess) { grid = -1; return; }
        if (hipFuncSetAttribute((const void*)fwd_kernel, hipFuncAttributeMaxDynamicSharedMemorySize, LDS_BYTES) != hipSuccess) { fprintf(stderr, "kernel_launch: hipFuncSetAttribute failed\n"); grid = -1; return; }
        if (hipOccupancyMaxActiveBlocksPerMultiprocessor(&per_cu, (const void*)fwd_kernel, NTHREADS, LDS_BYTES) != hipSuccess || per_cu < 1) { fprintf(stderr, "kernel_launch: occupancy query says %d blocks per CU\n", per_cu); (void)hipGetLastError(); grid = -1; return; }
        grid = cus;
        if (grid > 256) grid = 256;
        if (grid % 8 != 0) grid -= grid % 8;
    }
    if (grid < 0) return;
    (void)hipMemsetAsync((char*)d_ws + WS_CTL, 0, CTL_ZERO_BYTES, stream);
    Args a{};
    for (int i = 0; i < 27; ++i) a.in[i] = (const float*)d_in[i];
    a.out = (float*)d_out; a.ws = (unsigned char*)d_ws;
    if (REPEAT_PHASE >= 0) {
        a.ph_lo = 0; a.ph_hi = REPEAT_PHASE + 1; hipLaunchKernelGGL(fwd_kernel, dim3(grid), dim3(NTHREADS), LDS_BYTES, stream, a);
        (void)hipMemsetAsync((char*)d_ws + WS_CTL + CW_BAR * 4, 0, XCD_BAR_WORDS * 4, stream);
        if (REPEAT_PHASE == 7) (void)hipMemsetAsync((char*)d_ws + WS_CTL + CW_GCOUNT * 4, 0, 256, stream);
        a.ph_lo = REPEAT_PHASE; a.ph_hi = NPHASES; hipLaunchKernelGGL(fwd_kernel, dim3(grid), dim3(NTHREADS), LDS_BYTES, stream, a); }
    else if (MK_N_LAUNCHES == 1) { a.ph_lo = 0; a.ph_hi = NPHASES; hipLaunchKernelGGL(fwd_kernel, dim3(grid), dim3(NTHREADS), LDS_BYTES, stream, a); }
    else for (int p = 0; p < NPHASES; ++p) { a.ph_lo = p; a.ph_hi = p + 1; hipLaunchKernelGGL(fwd_kernel, dim3(grid), dim3(NTHREADS), LDS_BYTES, stream, a); }
}
```
